# Optimizing an MI355X kernel written in HIP

```python
import math
import jax, jax.numpy as jnp
from jax import lax
import numpy as np

D_MODEL = 1024
BATCH = 4
SEQ = 8192
DEPTH = 1

D_MIX = D_MODEL
D_POOL = D_MIX // 2
POOL_WINDOWS = (2, 4, 8, 16)
N_POOL_GROUPS = len(POOL_WINDOWS)
POOL_GROUP = D_POOL // N_POOL_GROUPS
D_ATTN = D_MIX - D_POOL
HEAD_DIM = 64
N_ATTN_HEADS = D_ATTN // (2 * HEAD_DIM)
D_IN = D_POOL + 3 * D_ATTN
ROPE_THETA = 10000.0
Q_BLOCK = 128
LAMBDA_STD = 0.1
D_PLE = 256
N_KEYS = 128
N_EXPERTS = N_KEYS * N_KEYS
N_PEER_HEADS = 8
PEER_TOPK = 16
D_PEER_QUERY = 256
D_SUBKEY = D_PEER_QUERY // 2
PEER_CHUNK = 128
EPS = 1e-6

kernel_name = "hybrid_pool_diffattn_peer_block"


def rmsnorm(x, gain):
    xf = x.astype(jnp.float32)
    y = xf * lax.rsqrt(jnp.mean(xf * xf, axis=-1, keepdims=True) + EPS)
    return (y * gain.astype(jnp.float32)).astype(x.dtype)


def rope(t, positions):
    d = t.shape[-1]
    inv_freq = ROPE_THETA ** (-jnp.arange(0, d, 2, dtype=jnp.float32) / d)
    ang = positions.astype(jnp.float32)[..., None] * inv_freq
    cos = jnp.cos(ang)[:, :, None, None, :]
    sin = jnp.sin(ang)[:, :, None, None, :]
    tf = t.astype(jnp.float32)
    t1, t2 = tf[..., : d // 2], tf[..., d // 2:]
    return jnp.concatenate([t1 * cos - t2 * sin, t2 * cos + t1 * sin], axis=-1).astype(t.dtype)


def pool_mixer(z, pool_w, pool_scale):
    B, S, _ = z.shape
    zg = z.astype(jnp.float32).reshape(B, S, N_POOL_GROUPS, POOL_GROUP)
    csum = lax.cumsum(zg, axis=1)
    t = jnp.arange(1, S + 1, dtype=jnp.float32)
    outs = []
    for g, w in enumerate(POOL_WINDOWS):
        cg = csum[:, :, g]
        prev = jnp.pad(cg, ((0, 0), (w, 0), (0, 0)))[:, :S]
        cnt = jnp.minimum(t, float(w))[None, :, None]
        outs.append((cg - prev) / cnt - zg[:, :, g])
    m = jnp.stack(outs, axis=2).astype(z.dtype)
    y = jnp.einsum('bsgc,gce->bsge', m, pool_w).reshape(B, S, D_POOL)
    return y * pool_scale


def diff_attention(q, k, v, positions, q_norm, k_norm, lq1, lk1, lq2, lk2, subln, layer_idx):
    B, S, H, _, d = q.shape
    q = rope(rmsnorm(q, q_norm), positions)
    k = rope(rmsnorm(k, k_norm), positions)
    lam_init = 0.8 - 0.6 * math.exp(-0.3 * layer_idx)
    lam = (jnp.exp(jnp.sum(lq1.astype(jnp.float32) * lk1.astype(jnp.float32)))
           - jnp.exp(jnp.sum(lq2.astype(jnp.float32) * lk2.astype(jnp.float32))) + lam_init)
    scale = 1.0 / math.sqrt(d)
    nb = S // Q_BLOCK
    qb = q.reshape(B, nb, Q_BLOCK, H, 2, d).swapaxes(0, 1)
    kf = k.astype(jnp.float32)
    vf = v.astype(jnp.float32)
    key_pos = jnp.arange(S)

    def block(args):
        q_blk, bi = args
        s = jnp.einsum('bqhmd,bkhmd->bhmqk', q_blk.astype(jnp.float32), kf) * scale
        qpos = bi * Q_BLOCK + jnp.arange(Q_BLOCK)
        mask = key_pos[None, :] <= qpos[:, None]
        s = jnp.where(mask, s, -jnp.inf)
        pr = jax.nn.softmax(s, axis=-1)
        a = pr[:, :, 0] - lam * pr[:, :, 1]
        return jnp.einsum('bhqk,bkhe->bqhe', a, vf)

    o = lax.map(block, (qb, jnp.arange(nb)))
    o = o.swapaxes(0, 1).reshape(B, S, H, 2 * d)
    o = rmsnorm(o, subln) * (1.0 - lam_init)
    return o.reshape(B, S, H * 2 * d).astype(v.dtype)


def peer(xn, w_q, subkeys, expert_u, expert_v):
    B, S, D = xn.shape
    q = (xn @ w_q).reshape(B, S, N_PEER_HEADS, 2, D_SUBKEY)
    sc = jnp.einsum('bshmc,hmnc->bshmn', q.astype(jnp.float32), subkeys.astype(jnp.float32))
    v_half, i_half = lax.top_k(sc, PEER_TOPK)
    cand = v_half[..., 0, :, None] + v_half[..., 1, None, :]
    cidx = i_half[..., 0, :, None] * N_KEYS + i_half[..., 1, None, :]
    cand = cand.reshape(B, S, N_PEER_HEADS, PEER_TOPK * PEER_TOPK)
    cidx = cidx.reshape(B, S, N_PEER_HEADS, PEER_TOPK * PEER_TOPK)
    top_s, pos = lax.top_k(cand, PEER_TOPK)
    eidx = jnp.take_along_axis(cidx, pos, axis=-1)
    g = jax.nn.softmax(top_s, axis=-1)
    nc = (B * S) // PEER_CHUNK
    xc = xn.reshape(nc, PEER_CHUNK, D)
    ic = eidx.reshape(nc, PEER_CHUNK, N_PEER_HEADS * PEER_TOPK)
    gc = g.reshape(nc, PEER_CHUNK, N_PEER_HEADS * PEER_TOPK).astype(xn.dtype)

    def chunk(args):
        xt, it, gt = args
        u = jnp.take(expert_u, it, axis=0)
        a = jnp.einsum('tc,tec->te', xt, u)
        hid = jax.nn.gelu(a, approximate=False) * gt
        vv = jnp.take(expert_v, it, axis=0)
        return jnp.einsum('te,tec->tc', hid, vv)

    out = lax.map(chunk, (xc, ic, gc))
    return out.reshape(B, S, D)


def setup_inputs(seed: int = 0) -> dict:
    key = jax.random.key(seed)
    ks = jax.random.split(key, 24)
    f32 = jnp.float32
    nrm = lambda k, shape, std: jax.random.normal(k, shape, f32) * std
    gain = lambda k, shape: 1.0 + 0.02 * jax.random.normal(k, shape, f32)
    return {
        "x": jax.random.normal(ks[0], (BATCH, SEQ, D_MODEL), f32),
        "p": jax.random.normal(ks[1], (DEPTH, BATCH, SEQ, D_PLE), f32),
        "positions": jnp.broadcast_to(jnp.arange(SEQ, dtype=jnp.int32), (BATCH, SEQ)),
        "ln_mix": gain(ks[2], (DEPTH, D_MODEL)),
        "w_in": nrm(ks[3], (DEPTH, D_MODEL, D_IN), D_MODEL ** -0.5),
        "pool_w": nrm(ks[4], (DEPTH, N_POOL_GROUPS, POOL_GROUP, POOL_GROUP), POOL_GROUP ** -0.5),
        "pool_scale": gain(ks[5], (DEPTH, D_POOL)),
        "q_norm": gain(ks[6], (DEPTH, HEAD_DIM)),
        "k_norm": gain(ks[7], (DEPTH, HEAD_DIM)),
        "lambda_q1": nrm(ks[8], (DEPTH, HEAD_DIM), LAMBDA_STD),
        "lambda_k1": nrm(ks[9], (DEPTH, HEAD_DIM), LAMBDA_STD),
        "lambda_q2": nrm(ks[10], (DEPTH, HEAD_DIM), LAMBDA_STD),
        "lambda_k2": nrm(ks[11], (DEPTH, HEAD_DIM), LAMBDA_STD),
        "subln": gain(ks[12], (DEPTH, 2 * HEAD_DIM)),
        "w_o": nrm(ks[13], (DEPTH, D_MIX, D_MODEL), D_MIX ** -0.5),
        "ln_ffn": gain(ks[14], (DEPTH, D_MODEL)),
        "w_peer_q": nrm(ks[15], (DEPTH, D_MODEL, N_PEER_HEADS * D_PEER_QUERY), D_MODEL ** -0.5),
        "peer_subkeys": nrm(ks[16], (DEPTH, N_PEER_HEADS, 2, N_KEYS, D_SUBKEY), D_SUBKEY ** -0.5),
        "peer_u": nrm(ks[17], (DEPTH, N_EXPERTS, D_MODEL), D_MODEL ** -0.5),
        "peer_v": nrm(ks[18], (DEPTH, N_EXPERTS, D_MODEL), N_PEER_HEADS ** -0.5),
        "ln_pe": gain(ks[19], (DEPTH, D_MODEL)),
        "w_pe_gate": nrm(ks[20], (DEPTH, D_MODEL, D_MODEL), D_MODEL ** -0.5),
        "w_pe_proj": nrm(ks[21], (DEPTH, D_PLE, D_MODEL), D_PLE ** -0.5),
    }


def reference(x, p, positions, ln_mix, w_in, pool_w, pool_scale, q_norm, k_norm,
              lambda_q1, lambda_k1, lambda_q2, lambda_k2, subln, w_o, ln_ffn,
              w_peer_q, peer_subkeys, peer_u, peer_v, ln_pe, w_pe_gate, w_pe_proj):
    B, S, _ = x.shape
    h = x
    for i in range(DEPTH):
        xn = rmsnorm(h, ln_mix[i])
        z = xn @ w_in[i]
        z_pool = z[..., :D_POOL]
        zq = z[..., D_POOL:D_POOL + D_ATTN].reshape(B, S, N_ATTN_HEADS, 2, HEAD_DIM)
        zk = z[..., D_POOL + D_ATTN:D_POOL + 2 * D_ATTN].reshape(B, S, N_ATTN_HEADS, 2, HEAD_DIM)
        zv = z[..., D_POOL + 2 * D_ATTN:].reshape(B, S, N_ATTN_HEADS, 2 * HEAD_DIM)
        y_pool = pool_mixer(z_pool, pool_w[i], pool_scale[i])
        y_attn = diff_attention(zq, zk, zv, positions, q_norm[i], k_norm[i],
                                lambda_q1[i], lambda_k1[i], lambda_q2[i], lambda_k2[i],
                                subln[i], i)
        h = h + jnp.concatenate([y_pool, y_attn], axis=-1) @ w_o[i]
        h = h + peer(rmsnorm(h, ln_ffn[i]), w_peer_q[i], peer_subkeys[i], peer_u[i], peer_v[i])
        gate = jax.nn.sigmoid(rmsnorm(h, ln_pe[i]) @ w_pe_gate[i])
        h = h + gate * (p[i] @ w_pe_proj[i])
    return h
```

```cpp
#include <hip/hip_runtime.h>
#include <hip/hip_cooperative_groups.h>
#include <cstdio>
#include <cstdint>
#include <cmath>
namespace cg = cooperative_groups;

#ifndef MK_MULTI
#define MK_MULTI 1
#endif

#define LAS __attribute__((address_space(3)))
typedef unsigned short bf16_t;
typedef short bf16x8 __attribute__((ext_vector_type(8)));
typedef short s16x4 __attribute__((ext_vector_type(4)));
typedef float f32x4 __attribute__((ext_vector_type(4)));
typedef float f32x2 __attribute__((ext_vector_type(2)));
typedef float f32x16 __attribute__((ext_vector_type(16)));
typedef unsigned u32x4 __attribute__((ext_vector_type(4)));
typedef unsigned u32x2 __attribute__((ext_vector_type(2)));
typedef __bf16 bf16x2_t __attribute__((ext_vector_type(2)));
typedef _Float16 f16x8 __attribute__((ext_vector_type(8)));
typedef _Float16 f16x2 __attribute__((ext_vector_type(2)));

constexpr int M_TOK = 32768, DM = 1024, SEQ = 8192, NB = 4, ZLD = 2048, DPLE = 256;
constexpr float EPS = 1e-6f;
constexpr float QSCALE = 0.125f * 1.4426950408889634f;
constexpr size_t MiB = 1u << 20;
constexpr size_t WS_CTL = 0, CTL_BYTES = 1 * MiB;
constexpr size_t WS_ROWSS2 = 256 * 1024;
constexpr size_t WS_WIN = 1 * MiB, WS_WO = 5 * MiB, WS_WS = 7 * MiB, WS_WG = 11 * MiB, WS_WP = 13 * MiB, WS_RINV3 = 14 * MiB;
constexpr size_t WS_UT = 16 * MiB, WS_VT = 48 * MiB, WS_ACTB = 80 * MiB, WS_PB = 144 * MiB, WS_Z = 160 * MiB, WS_YCAT = 288 * MiB, WS_PP = 352 * MiB;
constexpr size_t WS_EIDX = 416 * MiB, WS_GATE = 432 * MiB, WS_END = 448 * MiB;
constexpr int LDS_BYTES = 147456;

__device__ __forceinline__ unsigned cvtpk(float lo, float hi) { f32x2 v = {lo, hi}; bf16x2_t b = __builtin_convertvector(v, bf16x2_t); return __builtin_bit_cast(unsigned, b); }
__device__ __forceinline__ float bflo(unsigned w) { return __uint_as_float(w << 16); }
__device__ __forceinline__ float bfhi(unsigned w) { return __uint_as_float(w & 0xffff0000u); }
__device__ __forceinline__ float wave_sum(float v) {
#pragma unroll
    for (int o = 1; o < 64; o <<= 1) v += __shfl_xor(v, o);
    return v;
}

namespace pg8 {
#define PG8_LAS __attribute__((address_space(3)))
constexpr int BM = 256, BK = 64, HALF = 128, HTB = HALF * BK * 2, STAGE_BYTES = 8 * HTB, NXCD = 8, WGM = 8;
__host__ __device__ __forceinline__ int lds_byte(int r, int c) { const int st = (r >> 4) * 2 + (c >> 5), rr = r & 15, cc = c & 31, ob = rr * 64 + cc * 2; return st * 1024 + (ob ^ (((ob >> 9) & 1) << 5)); }
__host__ __device__ __forceinline__ void stage_rc(int b, int& R, int& C) { const int st = b / 1024, sb = b % 1024, swz = sb ^ (((sb >> 9) & 1) << 5); R = (st >> 1) * 16 + swz / 64; C = (st & 1) * 32 + (swz % 64) / 2; }
__host__ __device__ __forceinline__ int perm32(int rho) { const int n = rho >> 4, i = rho & 15; return 8 * (i >> 2) + 4 * n + (i & 3); }
struct Unit { int pm, pn; };
struct Gemm { const bf16_t* A; const bf16_t* Bt; int M, N, K; };
struct StaticOrder {
    int nM, nN, nwg, G, c;
    __host__ __device__ void init(int M, int N, int G_, int c_) { nM = M / BM; nN = N / BM; nwg = nM * nN; G = G_; c = c_; }
    __host__ __device__ bool next(int i, Unit& u) const {
        const long L = (long)i * G + c; if (L >= nwg) return false;
        int wgid = (int)L; { const int q = nwg / NXCD, r = nwg % NXCD, xcd = wgid % NXCD, off = wgid / NXCD; wgid = (xcd < r ? xcd * (q + 1) : r * (q + 1) + (xcd - r) * q) + off; }
        const int nig = WGM * nN, gid = wgid / nig, fm = gid * WGM, gsz = (nM - fm) < WGM ? (nM - fm) : WGM;
        u.pm = fm + ((wgid % nig) % gsz); u.pn = (wgid % nig) / gsz; return true;
    }
    __device__ __forceinline__ void a_ready(const Unit&) const {}
    __device__ __forceinline__ void done(const Unit&) const {}
};
template <class Epi, class Sched, bool ALIGN_EPI = false, bool SP2 = false>
__device__ __forceinline__ void gemm_phase(PG8_LAS unsigned char* lds, const Gemm g, const Sched& S, const Epi& E) {
    const int tid = threadIdx.x, wid = __builtin_amdgcn_readfirstlane(tid >> 6), lane = tid & 63, wr = wid >> 2, wc = wid & 3, fr = lane & 15, fq = lane >> 4;
    const int K = g.K, nt = K / BK;
    unsigned voffA[2], voffB[2];
#pragma unroll
    for (int i = 0; i < 2; ++i) { int R, C; stage_rc(tid * 16 + i * 8192, R, C); const int Rb = Epi::PERM ? ((R & ~31) + perm32(R & 31)) : R;
        voffA[i] = (unsigned)(R * K + C) * 2u; voffB[i] = (unsigned)(Rb * K + C) * 2u; }
    const size_t kstep = (size_t)(BK * 2);
    const size_t hstep = (size_t)HALF * K * 2;
    const size_t tstep = 2 * hstep;
    const unsigned ldsw = (unsigned)wid * 1024u;
    const int aoff = lds_byte(wr * 64 + fr, fq * 8), boff = lds_byte(wc * 32 + fr, fq * 8);
#define PG8_SA(b, h) (((b) * 2 + (h)) * HTB)
#define PG8_SB(b, h) ((4 + (b) * 2 + (h)) * HTB)
#define PG8_STAGE(bufoff, gbase, voff) do { _Pragma("unroll") for (int _i = 0; _i < 2; ++_i) \
        __builtin_amdgcn_global_load_lds((const unsigned*)((const char*)(gbase) + (voff)[_i]), (PG8_LAS unsigned*)(lds + (bufoff) + ldsw + _i * 8192), 16, 0, 0); } while (0)
#define PG8_LDA(dst, b, h) do { _Pragma("unroll") for (int m = 0; m < 4; ++m) _Pragma("unroll") for (int k = 0; k < 2; ++k) dst[m][k] = *(const PG8_LAS bf16x8*)(lds + PG8_SA(b, h) + aoff + m * 2048 + k * 1024); } while (0)
#define PG8_LDB(dst, b, h) do { _Pragma("unroll") for (int n = 0; n < 2; ++n) _Pragma("unroll") for (int k = 0; k < 2; ++k) dst[n][k] = *(const PG8_LAS bf16x8*)(lds + PG8_SB(b, h) + boff + n * 2048 + k * 1024); } while (0)
#define PG8_MMA(ai, bj, At, Bt) do { __builtin_amdgcn_s_setprio(1); _Pragma("unroll") for (int m = 0; m < 4; ++m) _Pragma("unroll") for (int n = 0; n < 2; ++n) _Pragma("unroll") for (int k = 0; k < 2; ++k) \
        acc[ai][bj][m][n] = __builtin_amdgcn_mfma_f32_16x16x32_bf16(Bt[n][k], At[m][k], acc[ai][bj][m][n], 0, 0, 0); __builtin_amdgcn_s_setprio(0); } while (0)
#define PG8_WAIT_V(n) asm volatile("s_waitcnt vmcnt(" #n ")" ::: "memory")
#define PG8_WAIT_L(n) asm volatile("s_waitcnt lgkmcnt(" #n ")" ::: "memory")
#define PG8_BAR __builtin_amdgcn_s_barrier()
#define PG8_SCHED __builtin_amdgcn_sched_barrier(0)
    Unit cur, nxt; int ui = 0;
    if (!S.next(0, cur)) return;
    f32x4 acc[2][2][4][2];
#pragma unroll
    for (int a = 0; a < 2; ++a)
#pragma unroll
        for (int b = 0; b < 2; ++b)
#pragma unroll
            for (int m = 0; m < 4; ++m)
#pragma unroll
                for (int n = 0; n < 2; ++n) acc[a][b][m][n] = (f32x4){0.f, 0.f, 0.f, 0.f};
    bf16x8 At[4][2], B0[2][2], B1[2][2];
    const char* cA = (const char*)g.A + (size_t)cur.pm * tstep; const char* cB = (const char*)g.Bt + (size_t)cur.pn * tstep;
    S.a_ready(cur);
    if constexpr (SP2) {
        PG8_STAGE(PG8_SB(0, 0), cB, voffB); PG8_STAGE(PG8_SB(0, 1), cB + hstep, voffB); PG8_STAGE(PG8_SA(0, 0), cA, voffA); PG8_STAGE(PG8_SA(0, 1), cA + hstep, voffA);
        if (wr == 1) PG8_BAR;
        PG8_WAIT_V(2); PG8_BAR;
        PG8_STAGE(PG8_SB(1, 0), cB + kstep, voffB); PG8_STAGE(PG8_SA(1, 0), cA + kstep, voffA); PG8_STAGE(PG8_SB(1, 1), cB + hstep + kstep, voffB);
        PG8_WAIT_V(6); PG8_BAR;
    } else {
        PG8_STAGE(PG8_SB(0, 0), cB, voffB); PG8_STAGE(PG8_SA(0, 0), cA, voffA); PG8_STAGE(PG8_SB(0, 1), cB + hstep, voffB); PG8_STAGE(PG8_SA(0, 1), cA + hstep, voffA);
        if (wr == 1) PG8_BAR;
        PG8_WAIT_V(4); PG8_BAR;
        PG8_STAGE(PG8_SB(1, 0), cB + kstep, voffB); PG8_STAGE(PG8_SA(1, 0), cA + kstep, voffA); PG8_STAGE(PG8_SB(1, 1), cB + hstep + kstep, voffB);
        PG8_WAIT_V(6); PG8_BAR;
    }
    for (;;) {
        const bool has_next = S.next(ui + 1, nxt);
        const char* nA = has_next ? (const char*)g.A + (size_t)nxt.pm * tstep : cA; const char* nB = has_next ? (const char*)g.Bt + (size_t)nxt.pn * tstep : cB;
        for (int t = 0; t < nt; t += 2) {
            const bool last = (t == nt - 2);
            const char* a1 = cA + (size_t)(t + 1) * kstep;
            const char* a2 = last ? nA : cA + (size_t)(t + 2) * kstep; const char* b2 = last ? nB : cB + (size_t)(t + 2) * kstep;
            const char* a3 = a2 + kstep; const char* b3 = b2 + kstep;
            if (last && has_next) S.a_ready(nxt);
            if constexpr (SP2) {
            PG8_LDB(B0, 0, 0); PG8_LDB(B1, 0, 1); PG8_SCHED; PG8_LDA(At, 0, 0); PG8_STAGE(PG8_SA(1, 1), a1 + hstep, voffA);
            PG8_WAIT_V(8); PG8_WAIT_L(0); PG8_BAR; PG8_MMA(0, 0, At, B0); PG8_MMA(0, 1, At, B1); PG8_BAR; PG8_SCHED;
            PG8_LDA(At, 0, 1); PG8_STAGE(PG8_SB(0, 0), b2, voffB); PG8_STAGE(PG8_SB(0, 1), b2 + hstep, voffB); PG8_STAGE(PG8_SA(0, 0), a2, voffA);
            PG8_WAIT_V(8); PG8_WAIT_L(0); PG8_BAR; PG8_MMA(1, 0, At, B0); PG8_MMA(1, 1, At, B1); PG8_BAR; PG8_SCHED;
            PG8_LDB(B0, 1, 0); PG8_LDB(B1, 1, 1); PG8_SCHED; PG8_LDA(At, 1, 0); PG8_STAGE(PG8_SA(0, 1), a2 + hstep, voffA);
            PG8_WAIT_V(8); PG8_WAIT_L(0); PG8_BAR; PG8_MMA(0, 0, At, B0); PG8_MMA(0, 1, At, B1); PG8_BAR; PG8_SCHED;
            PG8_LDA(At, 1, 1); PG8_STAGE(PG8_SB(1, 0), b3, voffB); PG8_STAGE(PG8_SB(1, 1), b3 + hstep, voffB); PG8_STAGE(PG8_SA(1, 0), a3, voffA);
            PG8_WAIT_V(8); PG8_WAIT_L(0); PG8_BAR; PG8_MMA(1, 0, At, B0); PG8_MMA(1, 1, At, B1); PG8_BAR; PG8_SCHED;
            } else {
            PG8_LDB(B0, 0, 0); PG8_SCHED; PG8_LDA(At, 0, 0); PG8_STAGE(PG8_SA(1, 1), a1 + hstep, voffA);
            PG8_WAIT_L(8); PG8_BAR; PG8_WAIT_L(0); PG8_MMA(0, 0, At, B0); PG8_BAR; PG8_SCHED;
            PG8_LDB(B1, 0, 1); PG8_STAGE(PG8_SB(0, 0), b2, voffB);
            PG8_BAR; PG8_WAIT_L(0); PG8_MMA(0, 1, At, B1); PG8_BAR;
            PG8_LDA(At, 0, 1); PG8_STAGE(PG8_SA(0, 0), a2, voffA);
            PG8_BAR; PG8_WAIT_L(0); PG8_MMA(1, 0, At, B0); PG8_BAR; PG8_SCHED;
            PG8_STAGE(PG8_SB(0, 1), b2 + hstep, voffB);
            PG8_WAIT_V(6); PG8_BAR; PG8_MMA(1, 1, At, B1); PG8_BAR;
            PG8_LDB(B0, 1, 0); PG8_SCHED; PG8_LDA(At, 1, 0); PG8_STAGE(PG8_SA(0, 1), a2 + hstep, voffA);
            PG8_WAIT_L(8); PG8_BAR; PG8_WAIT_L(0); PG8_MMA(0, 0, At, B0); PG8_BAR; PG8_SCHED;
            PG8_LDB(B1, 1, 1); PG8_STAGE(PG8_SB(1, 0), b3, voffB);
            PG8_BAR; PG8_WAIT_L(0); PG8_MMA(0, 1, At, B1); PG8_BAR;
            PG8_LDA(At, 1, 1); PG8_STAGE(PG8_SA(1, 0), a3, voffA);
            PG8_BAR; PG8_WAIT_L(0); PG8_MMA(1, 0, At, B0); PG8_BAR; PG8_SCHED;
            PG8_STAGE(PG8_SB(1, 1), b3 + hstep, voffB);
            PG8_WAIT_V(6); PG8_BAR; PG8_MMA(1, 1, At, B1); PG8_BAR;
            }
        }
        if constexpr (ALIGN_EPI) { if (wr == 0) PG8_BAR; }
        if constexpr (!Epi::AFTER_DRAIN) { E(acc, cur, wr, wc, fr, fq); S.done(cur); }
        if (!has_next) break;
#pragma unroll
        for (int a = 0; a < 2; ++a)
#pragma unroll
            for (int b = 0; b < 2; ++b)
#pragma unroll
                for (int m = 0; m < 4; ++m)
#pragma unroll
                    for (int n = 0; n < 2; ++n) acc[a][b][m][n] = (f32x4){0.f, 0.f, 0.f, 0.f};
        cur = nxt; cA = nA; cB = nB; ++ui;
        if constexpr (ALIGN_EPI) { if (wr == 1) PG8_BAR; }
    }
    PG8_WAIT_V(0);
    if constexpr (!ALIGN_EPI) { if (wr == 0) PG8_BAR; }
    PG8_BAR;
#undef PG8_SA
#undef PG8_SB
#undef PG8_STAGE
#undef PG8_LDA
#undef PG8_LDB
#undef PG8_MMA
#undef PG8_WAIT_V
#undef PG8_WAIT_L
#undef PG8_BAR
#undef PG8_SCHED
}

struct EpiStoreBf16 {
    static constexpr bool PERM = true, AFTER_DRAIN = false;
    bf16_t* O; int ldc;
    __device__ __forceinline__ void operator()(const f32x4 (&acc)[2][2][4][2], const Unit& u, int wr, int wc, int fr, int fq) const {
        const int row0 = u.pm * BM + wr * 64 + fr, col0 = u.pn * BM + wc * 32 + 8 * fq;
#pragma unroll
        for (int ai = 0; ai < 2; ++ai)
#pragma unroll
            for (int m = 0; m < 4; ++m) { bf16_t* rowp = O + (size_t)(row0 + ai * HALF + m * 16) * ldc + col0;
#pragma unroll
                for (int bj = 0; bj < 2; ++bj) { const f32x4 v0 = acc[ai][bj][m][0], v1 = acc[ai][bj][m][1];
                    u32x4 w; w.x = cvtpk(v0[0], v0[1]); w.y = cvtpk(v0[2], v0[3]); w.z = cvtpk(v1[0], v1[1]); w.w = cvtpk(v1[2], v1[3]);
                    *(u32x4*)(rowp + bj * HALF) = w; } }
    }
};
struct EpiScores {
    static constexpr bool PERM = true, AFTER_DRAIN = false;
    _Float16* O; int ldc; const float* rowss;
    __device__ __forceinline__ void operator()(const f32x4 (&acc)[2][2][4][2], const Unit& u, int wr, int wc, int fr, int fq) const {
        const int row0 = u.pm * BM + wr * 64 + fr, col0 = u.pn * BM + wc * 32 + 8 * fq;
#pragma unroll
        for (int ai = 0; ai < 2; ++ai)
#pragma unroll
            for (int m = 0; m < 4; ++m) { const int row = row0 + ai * HALF + m * 16; const float ri = rsqrtf(rowss[row] * (1.0f / 1024.0f) + EPS);
                _Float16* rowp = O + (size_t)row * ldc + col0;
#pragma unroll
                for (int bj = 0; bj < 2; ++bj) { const f32x4 v0 = acc[ai][bj][m][0] * ri, v1 = acc[ai][bj][m][1] * ri;
                    f16x8 w = {(_Float16)v0[0], (_Float16)v0[1], (_Float16)v0[2], (_Float16)v0[3], (_Float16)v1[0], (_Float16)v1[1], (_Float16)v1[2], (_Float16)v1[3]};
                    *(f16x8*)(rowp + bj * HALF) = w; } }
    }
};
struct EpiWo {
    static constexpr bool PERM = false, AFTER_DRAIN = false;
    const float* X; float* H; bf16_t* HB; float* rowss;
    __device__ __forceinline__ void operator()(const f32x4 (&acc)[2][2][4][2], const Unit& u, int wr, int wc, int fr, int fq) const {
        const int row0 = u.pm * BM + wr * 64 + fr, col0 = u.pn * BM + wc * 32 + 4 * fq;
#pragma unroll
        for (int ai = 0; ai < 2; ++ai)
#pragma unroll
            for (int m = 0; m < 4; ++m) { const int row = row0 + ai * HALF + m * 16; const size_t off = (size_t)row * DM + col0; float ss = 0.f;
#pragma unroll
                for (int bj = 0; bj < 2; ++bj)
#pragma unroll
                    for (int n = 0; n < 2; ++n) { const size_t o2 = off + bj * HALF + n * 16; const f32x4 h = *(const f32x4*)(X + o2) + acc[ai][bj][m][n];
                        *(f32x4*)(H + o2) = h; u32x2 w; w.x = cvtpk(h[0], h[1]); w.y = cvtpk(h[2], h[3]); *(u32x2*)(HB + o2) = w;
                        ss += (h[0] * h[0] + h[1] * h[1]) + (h[2] * h[2] + h[3] * h[3]); }
                ss += __shfl_xor(ss, 16); ss += __shfl_xor(ss, 32);
                if (fq == 0) atomicAdd(rowss + row, ss); }
    }
};
struct EpiGate {
    static constexpr bool PERM = false, AFTER_DRAIN = false;
    float* HO; const bf16_t* PP; const float* rinv;
    __device__ __forceinline__ void operator()(const f32x4 (&acc)[2][2][4][2], const Unit& u, int wr, int wc, int fr, int fq) const {
        const int row0 = u.pm * BM + wr * 64 + fr, col0 = u.pn * BM + wc * 32 + 4 * fq;
#pragma unroll
        for (int ai = 0; ai < 2; ++ai)
#pragma unroll
            for (int m = 0; m < 4; ++m) { const int row = row0 + ai * HALF + m * 16; const size_t off = (size_t)row * DM + col0; const float ri = rinv[row];
#pragma unroll
                for (int bj = 0; bj < 2; ++bj)
#pragma unroll
                    for (int n = 0; n < 2; ++n) { const size_t o2 = off + bj * HALF + n * 16; const f32x4 h = *(const f32x4*)(HO + o2); const u32x2 pw = *(const u32x2*)(PP + o2);
                        const f32x4 a = acc[ai][bj][m][n] * ri; f32x4 o;
                        o[0] = h[0] + bflo(pw.x) / (1.0f + __expf(-a[0])); o[1] = h[1] + bfhi(pw.x) / (1.0f + __expf(-a[1]));
                        o[2] = h[2] + bflo(pw.y) / (1.0f + __expf(-a[2])); o[3] = h[3] + bfhi(pw.y) / (1.0f + __expf(-a[3]));
                        *(f32x4*)(HO + o2) = o; } }
    }
};
}

struct Params { const float* in[23]; float* out; unsigned char* ws; int ph_lo, ph_hi; };
enum { I_X = 0, I_P, I_POS, I_LNMIX, I_WIN, I_POOLW, I_POOLS, I_QN, I_KN, I_LQ1, I_LK1, I_LQ2, I_LK2, I_SUBLN, I_WO, I_LNFFN, I_WPQ, I_SUBK, I_PU, I_PV, I_LNPE, I_WG, I_WPP };

struct Ctx {
    LAS unsigned char* lds; int tid, lane, wave, G, vcu;
    const Params* p;
};

__device__ __forceinline__ void transpose_item(const float* W, int ldw, int coff, const float* gain, bf16_t* WT, int ldk, int roff, int nblk, LAS float* scr, int item, int lane) {
    const int kb = item / nblk, nb = item % nblk, k0 = 64 * kb, n0 = 32 * nb;
#pragma unroll 8
    for (int i = 0; i < 32; ++i) { const int kk = 2 * i + (lane >> 5); const float gsc = gain ? gain[k0 + kk] : 1.0f; scr[kk * 33 + (lane & 31)] = W[(size_t)(k0 + kk) * ldw + coff + n0 + (lane & 31)] * gsc; }
    asm volatile("s_waitcnt lgkmcnt(0)" ::: "memory");
    const int c = lane & 7;
#pragma unroll
    for (int j = 0; j < 4; ++j) { const int n = (lane >> 3) + 8 * j; const LAS float* s = scr + (8 * c) * 33 + n;
        u32x4 o; o.x = cvtpk(s[0 * 33], s[1 * 33]); o.y = cvtpk(s[2 * 33], s[3 * 33]); o.z = cvtpk(s[4 * 33], s[5 * 33]); o.w = cvtpk(s[6 * 33], s[7 * 33]);
        *(u32x4*)(WT + (size_t)(roff + n0 + n) * ldk + k0 + 8 * c) = o; }
    asm volatile("s_waitcnt lgkmcnt(0)" ::: "memory");
}

__device__ __forceinline__ void phase_prep(const Ctx& C) {
    const Params& P = *C.p; unsigned char* ws = P.ws; const int tid = C.tid, lane = C.lane;
    bf16_t* WinT = (bf16_t*)(ws + WS_WIN); bf16_t* WoT = (bf16_t*)(ws + WS_WO); bf16_t* WsT = (bf16_t*)(ws + WS_WS); bf16_t* WgT = (bf16_t*)(ws + WS_WG); bf16_t* WpT = (bf16_t*)(ws + WS_WP);
    {
        LAS float* As = (LAS float*)C.lds;
        LAS float* Bs = (LAS float*)(C.lds + 32768);
        for (int it = blockIdx.x; it < 320; it += C.G) {
            const bool pool = it < 64; const int j = pool ? it : it - 64; const int blk = j >> 4, k0 = (j & 15) * 64;
            const float* Asrc = (pool ? P.in[I_WIN] : P.in[I_WPQ]) + blk * 128;
            const float* Bsrc = (pool ? P.in[I_POOLW] : P.in[I_SUBK]) + (size_t)blk * 128 * 128;
#pragma unroll
            for (int i = 0; i < 4; ++i) { const int v = tid + 512 * i, r = v >> 5, c4 = v & 31; *(LAS f32x4*)(As + r * 128 + c4 * 4) = *(const f32x4*)(Asrc + (size_t)(k0 + r) * 2048 + c4 * 4); }
#pragma unroll 8
            for (int i = 0; i < 32; ++i) { const int idx = tid + 512 * i, r = idx >> 7, c = idx & 127; const float v = Bsrc[idx];
                if (pool) Bs[r * 129 + c] = v; else Bs[c * 129 + r] = v; }
            __syncthreads();
            const int n = tid & 127, kg = tid >> 7;
            float acc[16];
#pragma unroll
            for (int i = 0; i < 16; ++i) acc[i] = 0.f;
            for (int c = 0; c < 128; c += 4) {
                const float b0 = Bs[(c + 0) * 129 + n], b1 = Bs[(c + 1) * 129 + n], b2 = Bs[(c + 2) * 129 + n], b3 = Bs[(c + 3) * 129 + n];
#pragma unroll
                for (int i = 0; i < 16; ++i) { const f32x4 a = *(const LAS f32x4*)(As + (kg * 16 + i) * 128 + c); acc[i] += a[0] * b0 + a[1] * b1 + a[2] * b2 + a[3] * b3; }
            }
            const float cs = pool ? P.in[I_POOLS][blk * 128 + n] : 1.0f; const float* gain = pool ? P.in[I_LNMIX] : P.in[I_LNFFN];
            bf16_t* dst = (pool ? WinT : WsT) + (size_t)(blk * 128 + n) * 1024 + k0 + kg * 16;
            u32x4 o0, o1; float v[16];
#pragma unroll
            for (int i = 0; i < 16; ++i) v[i] = acc[i] * cs * gain[k0 + kg * 16 + i];
            o0.x = cvtpk(v[0], v[1]); o0.y = cvtpk(v[2], v[3]); o0.z = cvtpk(v[4], v[5]); o0.w = cvtpk(v[6], v[7]);
            o1.x = cvtpk(v[8], v[9]); o1.y = cvtpk(v[10], v[11]); o1.z = cvtpk(v[12], v[13]); o1.w = cvtpk(v[14], v[15]);
            *(u32x4*)dst = o0; *(u32x4*)(dst + 8) = o1;
            __syncthreads();
        }
    }
    {
        LAS float* scr = (LAS float*)(C.lds + C.wave * 8448);
        const int gw = C.vcu * 8 + C.wave, NGW = C.G * 8;
        constexpr int I1 = 16 * 48, I2 = 16 * 32, I3 = 16 * 32, I4 = 4 * 32;
        for (int it = gw; it < I1 + I2 + I3 + I4; it += NGW) {
            int r = it;
            if (r < I1) { transpose_item(P.in[I_WIN], 2048, 512, P.in[I_LNMIX], WinT, 1024, 512, 48, scr, r, lane); continue; } r -= I1;
            if (r < I2) { transpose_item(P.in[I_WO], 1024, 0, nullptr, WoT, 1024, 0, 32, scr, r, lane); continue; } r -= I2;
            if (r < I3) { transpose_item(P.in[I_WG], 1024, 0, P.in[I_LNPE], WgT, 1024, 0, 32, scr, r, lane); continue; } r -= I3;
            transpose_item(P.in[I_WPP], 1024, 0, nullptr, WpT, 256, 0, 32, scr, r, lane);
        }
        bf16_t* XB = (bf16_t*)(ws + WS_ACTB);
        for (int m = gw; m < M_TOK; m += NGW) {
            const f32x4* xr = (const f32x4*)(P.in[I_X] + (size_t)m * DM) + lane; f32x4 v[4]; float s = 0.f;
#pragma unroll
            for (int j = 0; j < 4; ++j) { v[j] = xr[64 * j]; s += (v[j][0] * v[j][0] + v[j][1] * v[j][1]) + (v[j][2] * v[j][2] + v[j][3] * v[j][3]); }
            const float ri = rsqrtf(wave_sum(s) * (1.0f / DM) + EPS);
            u32x2* o = (u32x2*)(XB + (size_t)m * DM) + lane;
#pragma unroll
            for (int j = 0; j < 4; ++j) { u32x2 w; w.x = cvtpk(v[j][0] * ri, v[j][1] * ri); w.y = cvtpk(v[j][2] * ri, v[j][3] * ri); o[64 * j] = w; }
        }
    }
    {
        const size_t gt = (size_t)C.vcu * 512 + tid, NT = (size_t)C.G * 512;
        const float* srcs[3] = {P.in[I_P], P.in[I_PU], P.in[I_PV]};
        bf16_t* dsts[3] = {(bf16_t*)(ws + WS_PB), (bf16_t*)(ws + WS_UT), (bf16_t*)(ws + WS_VT)};
        const size_t cnt[3] = {(size_t)M_TOK * DPLE / 8, (size_t)16384 * 1024 / 8, (size_t)16384 * 1024 / 8};
#pragma unroll
        for (int a = 0; a < 3; ++a) {
            const float* s = srcs[a]; bf16_t* d = dsts[a];
            for (size_t i = gt; i < cnt[a]; i += NT) { const f32x4 v0 = *(const f32x4*)(s + i * 8), v1 = *(const f32x4*)(s + i * 8 + 4);
                u32x4 w; w.x = cvtpk(v0[0], v0[1]); w.y = cvtpk(v0[2], v0[3]); w.z = cvtpk(v1[0], v1[1]); w.w = cvtpk(v1[2], v1[3]); *(u32x4*)(d + i * 8) = w; }
        }
    }
}

__device__ __forceinline__ void phase_rope_pool(const Ctx& C) {
    const Params& P = *C.p; unsigned char* ws = P.ws; const int lane = C.lane;
    bf16_t* Z = (bf16_t*)(ws + WS_Z); bf16_t* Y = (bf16_t*)(ws + WS_YCAT);
    const int gw = C.vcu * 8 + C.wave, NGW = C.G * 8;
    const int* pos = (const int*)P.in[I_POS];
    const int grp = lane >> 2, a = lane & 3; const bool isq = grp < 8;
    const float* gn = isq ? P.in[I_QN] : P.in[I_KN];
    float g1[8], g2[8], invf[8];
#pragma unroll
    for (int i = 0; i < 8; ++i) { g1[i] = gn[8 * a + i]; g2[i] = gn[32 + 8 * a + i]; invf[i] = exp2f(-(float)(2 * (8 * a + i)) * (13.287712379549449f / 64.0f)); }
    const float osc = isq ? QSCALE : 1.0f;
    for (int m = gw; m < M_TOK; m += NGW) {
        bf16_t* zp = Z + (size_t)m * ZLD + 512 + 64 * grp + 8 * a;
        const u32x4 w1 = *(const u32x4*)zp, w2 = *(const u32x4*)(zp + 32);
        float t1[8], t2[8];
        t1[0] = bflo(w1.x); t1[1] = bfhi(w1.x); t1[2] = bflo(w1.y); t1[3] = bfhi(w1.y); t1[4] = bflo(w1.z); t1[5] = bfhi(w1.z); t1[6] = bflo(w1.w); t1[7] = bfhi(w1.w);
        t2[0] = bflo(w2.x); t2[1] = bfhi(w2.x); t2[2] = bflo(w2.y); t2[3] = bfhi(w2.y); t2[4] = bflo(w2.z); t2[5] = bfhi(w2.z); t2[6] = bflo(w2.w); t2[7] = bfhi(w2.w);
        float ss = 0.f;
#pragma unroll
        for (int i = 0; i < 8; ++i) ss += t1[i] * t1[i] + t2[i] * t2[i];
        ss += __shfl_xor(ss, 1); ss += __shfl_xor(ss, 2);
        const float ri = rsqrtf(ss * (1.0f / 64.0f) + EPS) ;
        const float fp = (float)pos[m];
        float o1[8], o2[8];
#pragma unroll
        for (int i = 0; i < 8; ++i) {
            const float ang = fp * invf[i]; float tr = ang * 0.15915494309189535f; tr = tr - floorf(tr);
            const float sn = __builtin_amdgcn_sinf(tr), cs = __builtin_amdgcn_cosf(tr);
            const float x1 = t1[i] * ri * g1[i], x2 = t2[i] * ri * g2[i];
            o1[i] = (x1 * cs - x2 * sn) * osc; o2[i] = (x2 * cs + x1 * sn) * osc;
        }
        u32x4 r1, r2;
        r1.x = cvtpk(o1[0], o1[1]); r1.y = cvtpk(o1[2], o1[3]); r1.z = cvtpk(o1[4], o1[5]); r1.w = cvtpk(o1[6], o1[7]);
        r2.x = cvtpk(o2[0], o2[1]); r2.y = cvtpk(o2[2], o2[3]); r2.z = cvtpk(o2[4], o2[5]); r2.w = cvtpk(o2[6], o2[7]);
        *(u32x4*)zp = r1; *(u32x4*)(zp + 32) = r2;
    }
    const int w = 2 << (lane >> 4);
    for (int m = gw; m < M_TOK; m += NGW) {
        const int s = m & (SEQ - 1);
        const bf16_t* zp = Z + (size_t)m * ZLD + 8 * lane;
        float acc[8], self[8];
#pragma unroll
        for (int i = 0; i < 8; ++i) acc[i] = 0.f;
        for (int i = 0; i < 16; ++i) {
            if (i < w && s - i >= 0) { const u32x4 v = *(const u32x4*)(zp - (size_t)i * ZLD);
                float t[8] = {bflo(v.x), bfhi(v.x), bflo(v.y), bfhi(v.y), bflo(v.z), bfhi(v.z), bflo(v.w), bfhi(v.w)};
#pragma unroll
                for (int q = 0; q < 8; ++q) { acc[q] += t[q]; if (i == 0) self[q] = t[q]; } }
        }
        const float rc = 1.0f / (float)((s + 1) < w ? (s + 1) : w);
        u32x4 o; o.x = cvtpk(acc[0] * rc - self[0], acc[1] * rc - self[1]); o.y = cvtpk(acc[2] * rc - self[2], acc[3] * rc - self[3]);
        o.z = cvtpk(acc[4] * rc - self[4], acc[5] * rc - self[5]); o.w = cvtpk(acc[6] * rc - self[6], acc[7] * rc - self[7]);
        *(u32x4*)(Y + (size_t)m * DM + 8 * lane) = o;
    }
}

namespace att {
constexpr int SLOT = 32768, KB = 8192;
typedef short v4i16_t __attribute__((ext_vector_type(4)));
__device__ __forceinline__ int crow(int r, int hi) { return (r & 3) + 8 * (r >> 2) + 4 * hi; }
__device__ __forceinline__ s16x4 vtr(const LAS unsigned char* p) { return __builtin_bit_cast(s16x4, __builtin_amdgcn_ds_read_tr16_b64_v4i16((LAS v4i16_t*)p)); }
__device__ __forceinline__ float swapadd(float v) { auto rr = __builtin_amdgcn_permlane32_swap(__float_as_uint(v), __float_as_uint(v), false, false); return __uint_as_float(rr[0]) + __uint_as_float(rr[1]); }
__device__ __forceinline__ float swapmax(float v) { auto rr = __builtin_amdgcn_permlane32_swap(__float_as_uint(v), __float_as_uint(v), false, false); return fmaxf(__uint_as_float(rr[0]), __uint_as_float(rr[1])); }

__device__ __forceinline__ void attn_unit(int b, int h, int qb, const bf16_t* Z, bf16_t* Y, const float* subln, float lam, LAS unsigned char* lds) {
    const int tid = threadIdx.x, lane = tid & 63, r32 = lane & 31, hi = lane >> 5; const int wid = __builtin_amdgcn_readfirstlane(tid >> 6);
    const size_t rowbase = (size_t)b * SEQ; const int q0 = qb * 256, NT = 4 * qb + 4;
    const int qabs = q0 + wid * 32 + r32;
    LAS unsigned char* qlds = lds + 2 * SLOT + wid * 8192 + lane * 16;
    { const bf16_t* Qw = Z + (rowbase + qabs) * ZLD + 512 + h * 128;
#pragma unroll
      for (int m = 0; m < 2; ++m)
#pragma unroll
          for (int d0 = 0; d0 < 4; ++d0) *(LAS bf16x8*)(qlds + (m * 4 + d0) * 1024) = *(const bf16x8*)(Qw + m * 64 + d0 * 16 + hi * 8); }
    const bf16_t* ksrc = Z + (rowbase + lane) * ZLD + 1024 + h * 128 + wid * 8;
    const bf16_t* vsrc = Z + (rowbase + ((tid & 255) >> 2)) * ZLD + 1536 + h * 128 + (tid >> 8) * 32 + (tid & 3) * 8;
    const unsigned wbase = (unsigned)wid * 1024u;
#define ATT_DMA(t, slot) do { const size_t ro_ = (size_t)(t) * 64 * ZLD; \
        __builtin_amdgcn_global_load_lds((const unsigned*)(ksrc + ro_), (LAS unsigned*)(lds + (slot) + wbase), 16, 0, 0); \
        __builtin_amdgcn_global_load_lds((const unsigned*)(ksrc + ro_ + 64), (LAS unsigned*)(lds + (slot) + KB + wbase), 16, 0, 0); \
        __builtin_amdgcn_global_load_lds((const unsigned*)(vsrc + ro_), (LAS unsigned*)(lds + (slot) + 2 * KB + wbase), 16, 0, 0); \
        __builtin_amdgcn_global_load_lds((const unsigned*)(vsrc + ro_ + 64), (LAS unsigned*)(lds + (slot) + 3 * KB + wbase), 16, 0, 0); } while (0)
    f32x16 o[2][4];
#pragma unroll
    for (int m = 0; m < 2; ++m)
#pragma unroll
        for (int d = 0; d < 4; ++d)
#pragma unroll
            for (int r = 0; r < 16; ++r) o[m][d][r] = 0.f;
    float mref[2] = {-1e30f, -1e30f}, lsum[2] = {0.f, 0.f};
    const int koff = hi * 1024 + r32 * 16;
    const int voff = ((lane >> 4) & 1) * 32 + (lane & 3) * 8 + (4 * hi + ((lane & 15) >> 2)) * 64;
    ATT_DMA(0, 0);
    __syncthreads();
    for (int t = 0; t < NT; ++t) {
        const int slot = (t & 1) * SLOT;
        if (t + 1 < NT) ATT_DMA(t + 1, SLOT - slot);
        const bool band = t >= NT - 4;
#pragma unroll
        for (int m = 0; m < 2; ++m) {
#pragma unroll
            for (int hf = 0; hf < 2; ++hf) {
                f32x16 p0;
#pragma unroll
                for (int r = 0; r < 16; ++r) p0[r] = 0.f;
                const LAS unsigned char* kb = lds + slot + m * KB + koff + hf * 512;
#pragma unroll
                for (int d0 = 0; d0 < 4; ++d0) { const bf16x8 b0 = *(const LAS bf16x8*)(kb + d0 * 2048); const bf16x8 qf = *(const LAS bf16x8*)(qlds + (m * 4 + d0) * 1024);
                    p0 = __builtin_amdgcn_mfma_f32_32x32x16_bf16(b0, qf, p0, 0, 0, 0); }
                if (band) {
                    const int kb0 = 64 * t + 32 * hf + 4 * hi;
#pragma unroll
                    for (int r = 0; r < 16; ++r) { const int kv = kb0 + (r & 3) + 8 * (r >> 2); if (kv > qabs) p0[r] = -INFINITY; }
                }
                float rm = fmaxf(p0[0], p0[1]);
#pragma unroll
                for (int r = 2; r < 16; ++r) rm = fmaxf(rm, p0[r]);
                rm = swapmax(rm);
                if (__any(rm - mref[m] > 8.0f)) {
                    const float mn = fmaxf(mref[m], rm), al = exp2f(mref[m] - mn);
                    mref[m] = mn; lsum[m] *= al;
#pragma unroll
                    for (int d = 0; d < 4; ++d)
#pragma unroll
                        for (int r = 0; r < 16; ++r) o[m][d][r] *= al;
                }
                const float mr = mref[m]; float ls = 0.f;
#pragma unroll
                for (int r = 0; r < 16; ++r) { p0[r] = __builtin_amdgcn_exp2f(p0[r] - mr); ls += p0[r]; }
                lsum[m] += ls;
                u32x4 pw[2];
                pw[0] = (u32x4){cvtpk(p0[0], p0[1]), cvtpk(p0[2], p0[3]), cvtpk(p0[4], p0[5]), cvtpk(p0[6], p0[7])};
                pw[1] = (u32x4){cvtpk(p0[8], p0[9]), cvtpk(p0[10], p0[11]), cvtpk(p0[12], p0[13]), cvtpk(p0[14], p0[15])};
                const LAS unsigned char* vb = lds + slot + 2 * KB + voff + hf * 2048;
#pragma unroll
                for (int d = 0; d < 4; ++d)
#pragma unroll
                    for (int ks = 0; ks < 2; ++ks) {
                        const s16x4 lo = vtr(vb + d * 4096 + ks * 1024), hh = vtr(vb + d * 4096 + ks * 1024 + 512);
                        const bf16x8 vf = {lo[0], lo[1], lo[2], lo[3], hh[0], hh[1], hh[2], hh[3]};
                        o[m][d] = __builtin_amdgcn_mfma_f32_32x32x16_bf16(vf, __builtin_bit_cast(bf16x8, pw[ks]), o[m][d], 0, 0, 0);
                    }
            }
        }
        __syncthreads();
    }
#undef ATT_DMA
    const float i0 = 1.0f / swapadd(lsum[0]), i1 = lam / swapadd(lsum[1]);
    float ss = 0.f;
#pragma unroll
    for (int d = 0; d < 4; ++d)
#pragma unroll
        for (int r = 0; r < 16; ++r) { const float v = o[0][d][r] * i0 - o[1][d][r] * i1; o[0][d][r] = v; ss += v * v; }
    ss = swapadd(ss);
    const float rn = rsqrtf(ss * (1.0f / 128.0f) + EPS) * 0.8f;
    bf16_t* yp = Y + (rowbase + qabs) * DM + 512 + h * 128;
#pragma unroll
    for (int d = 0; d < 4; ++d)
#pragma unroll
        for (int rq = 0; rq < 4; ++rq) { const int dc = 32 * d + 8 * rq + 4 * hi; const f32x4 g = *(const f32x4*)(subln + dc);
            u32x2 w; w.x = cvtpk(o[0][d][4 * rq] * rn * g[0], o[0][d][4 * rq + 1] * rn * g[1]); w.y = cvtpk(o[0][d][4 * rq + 2] * rn * g[2], o[0][d][4 * rq + 3] * rn * g[3]);
            *(u32x2*)(yp + dc) = w; }
}
}

__device__ __forceinline__ void phase_attn(const Ctx& C) {
    const Params& P = *C.p; unsigned char* ws = P.ws;
    const bf16_t* Z = (const bf16_t*)(ws + WS_Z); bf16_t* Y = (bf16_t*)(ws + WS_YCAT);
    const float d1 = wave_sum(P.in[I_LQ1][C.lane] * P.in[I_LK1][C.lane]), d2 = wave_sum(P.in[I_LQ2][C.lane] * P.in[I_LK2][C.lane]);
    const float lam = expf(d1) - expf(d2) + 0.2f;
    for (int pi = C.vcu; pi < 256; pi += C.G) {
        const int bh = pi >> 4, s = pi & 15;
        att::attn_unit(bh >> 2, bh & 3, 31 - s, Z, Y, P.in[I_SUBLN], lam, C.lds);
        att::attn_unit(bh >> 2, bh & 3, s, Z, Y, P.in[I_SUBLN], lam, C.lds);
    }
}

__device__ __forceinline__ unsigned mono(float f) { const unsigned u = __float_as_uint(f); return (u & 0x80000000u) ? ~u : (u | 0x80000000u); }
__device__ __forceinline__ float unmono(unsigned u) { return __uint_as_float((u & 0x80000000u) ? (u & 0x7fffffffu) : ~u); }
template <class T> __device__ __forceinline__ void sort16_desc(T (&a)[16]) {
#pragma unroll
    for (int k = 2; k <= 16; k <<= 1)
#pragma unroll
        for (int j = k >> 1; j > 0; j >>= 1)
#pragma unroll
            for (int i = 0; i < 16; ++i) { const int l = i ^ j; if (l > i) { const bool desc = ((i & k) == 0) || (k == 16); const T mx = a[i] > a[l] ? a[i] : a[l], mn = a[i] > a[l] ? a[l] : a[i]; a[i] = desc ? mx : mn; a[l] = desc ? mn : mx; } }
}
template <class T> __device__ __forceinline__ void merge16_desc(T (&a)[16], const T (&b)[16]) {
#pragma unroll
    for (int i = 0; i < 16; ++i) a[i] = a[i] > b[15 - i] ? a[i] : b[15 - i];
#pragma unroll
    for (int j = 8; j > 0; j >>= 1)
#pragma unroll
        for (int i = 0; i < 16; ++i) { const int l = i ^ j; if (l > i) { const T mx = a[i] > a[l] ? a[i] : a[l], mn = a[i] > a[l] ? a[l] : a[i]; a[i] = mx; a[l] = mn; } }
}
__device__ __forceinline__ void top16_of_128(const _Float16* sc, unsigned (&a)[16]) {
#pragma unroll 1
    for (int g = 0; g < 8; ++g) {
        const f16x8 h0 = *(const f16x8*)(sc + 16 * g), h1 = *(const f16x8*)(sc + 16 * g + 8);
        unsigned b[16];
#pragma unroll
        for (int i = 0; i < 8; ++i) { b[i] = (mono((float)h0[i]) & ~127u) | (unsigned)(127 - (16 * g + i)); b[8 + i] = (mono((float)h1[i]) & ~127u) | (unsigned)(127 - (16 * g + 8 + i)); }
        sort16_desc(b);
        if (g == 0) {
#pragma unroll
            for (int i = 0; i < 16; ++i) a[i] = b[i];
        } else merge16_desc(a, b);
    }
}
typedef unsigned long long u64;
__device__ __forceinline__ void phase_topk(const Ctx& C) {
    const Params& P = *C.p; unsigned char* ws = P.ws;
    const _Float16* SC = (const _Float16*)(ws + WS_Z); int* EI = (int*)(ws + WS_EIDX); float* GT = (float*)(ws + WS_GATE);
    const int gt = C.vcu * 512 + C.tid, NT = C.G * 512;
    for (int it = gt; it < M_TOK * 8; it += NT) {
        const _Float16* sc = SC + (size_t)it * 256;
        unsigned a0[16], a1[16];
        top16_of_128(sc, a0); top16_of_128(sc + 128, a1);
        float v0[16], v1[16]; unsigned e0[16], e1[16];
#pragma unroll
        for (int i = 0; i < 16; ++i) { v0[i] = unmono(a0[i] & ~127u); v1[i] = unmono(a1[i] & ~127u); e0[i] = (127u - (a0[i] & 127u)) << 7; e1[i] = 127u - (a1[i] & 127u); }
#define CAND(i, j) ((((u64)mono(v0[i] + v1[j])) << 32) | (u64)(((255u - (unsigned)((i) * 16 + (j))) << 16) | e0[i] | e1[j]))
        u64 a[16], bq[16];
#pragma unroll
        for (int j = 0; j < 16; ++j) a[j] = CAND(0, j);
#pragma unroll
        for (int i = 0; i < 15; ++i) bq[i] = CAND(i + 1, 0);
        bq[15] = 0ull; merge16_desc(a, bq);
#pragma unroll
        for (int i = 0; i < 16; ++i) bq[i] = 0ull;
#pragma unroll
        for (int j = 1; j < 8; ++j) bq[j - 1] = CAND(1, j);
        merge16_desc(a, bq);
#pragma unroll
        for (int i = 0; i < 16; ++i) bq[i] = 0ull;
#pragma unroll
        for (int i = 2; i < 8; ++i) bq[i - 2] = CAND(i, 1);
        merge16_desc(a, bq);
#pragma unroll
        for (int i = 0; i < 16; ++i) bq[i] = 0ull;
        bq[0] = CAND(2, 2); bq[1] = CAND(2, 3); bq[2] = CAND(2, 4); bq[3] = CAND(3, 2); bq[4] = CAND(4, 2); bq[5] = CAND(3, 3);
        sort16_desc(bq); merge16_desc(a, bq);
#undef CAND
        float sv[16]; const float smax = unmono((unsigned)(a[0] >> 32)); float den = 0.f;
#pragma unroll
        for (int i = 0; i < 16; ++i) { sv[i] = __expf(unmono((unsigned)(a[i] >> 32)) - smax); den += sv[i]; }
        const float rd = 1.0f / den;
        int* eo = EI + (size_t)it * 16; float* go = GT + (size_t)it * 16;
#pragma unroll
        for (int q = 0; q < 4; ++q) {
            *(u32x4*)(eo + 4 * q) = (u32x4){(unsigned)a[4 * q] & 0x3fffu, (unsigned)a[4 * q + 1] & 0x3fffu, (unsigned)a[4 * q + 2] & 0x3fffu, (unsigned)a[4 * q + 3] & 0x3fffu};
            *(f32x4*)(go + 4 * q) = (f32x4){sv[4 * q] * rd, sv[4 * q + 1] * rd, sv[4 * q + 2] * rd, sv[4 * q + 3] * rd};
        }
    }
}

__device__ __forceinline__ float dot16(const float (&x)[16], const u32x4 wa, const u32x4 wb) {
    float s0 = x[0] * bflo(wa.x), s1 = x[1] * bfhi(wa.x);
    s0 += x[2] * bflo(wa.y); s1 += x[3] * bfhi(wa.y); s0 += x[4] * bflo(wa.z); s1 += x[5] * bfhi(wa.z); s0 += x[6] * bflo(wa.w); s1 += x[7] * bfhi(wa.w);
    s0 += x[8] * bflo(wb.x); s1 += x[9] * bfhi(wb.x); s0 += x[10] * bflo(wb.y); s1 += x[11] * bfhi(wb.y); s0 += x[12] * bflo(wb.z); s1 += x[13] * bfhi(wb.z); s0 += x[14] * bflo(wb.w); s1 += x[15] * bfhi(wb.w);
    return s0 + s1;
}
__device__ __forceinline__ void axpy16(float (&o)[16], float s, const u32x4 wa, const u32x4 wb) {
    o[0] += s * bflo(wa.x); o[1] += s * bfhi(wa.x); o[2] += s * bflo(wa.y); o[3] += s * bfhi(wa.y); o[4] += s * bflo(wa.z); o[5] += s * bfhi(wa.z); o[6] += s * bflo(wa.w); o[7] += s * bfhi(wa.w);
    o[8] += s * bflo(wb.x); o[9] += s * bfhi(wb.x); o[10] += s * bflo(wb.y); o[11] += s * bfhi(wb.y); o[12] += s * bflo(wb.z); o[13] += s * bfhi(wb.z); o[14] += s * bflo(wb.w); o[15] += s * bfhi(wb.w);
}
__device__ __forceinline__ void phase_gather(const Ctx& C) {
    const Params& P = *C.p; unsigned char* ws = P.ws; const int lane = C.lane;
    float* H = P.out; bf16_t* HB = (bf16_t*)(ws + WS_ACTB); const float* rowss = (const float*)(ws + WS_CTL + WS_ROWSS2); float* rinv3 = (float*)(ws + WS_RINV3);
    const bf16_t* UT = (const bf16_t*)(ws + WS_UT); const bf16_t* VT = (const bf16_t*)(ws + WS_VT);
    const int* EI = (const int*)(ws + WS_EIDX); const float* GT = (const float*)(ws + WS_GATE);
    const int gw = C.vcu * 8 + C.wave, NGW = C.G * 8;
    float gn[16];
    { const f32x4 a = *(const f32x4*)(P.in[I_LNFFN] + 8 * lane), b = *(const f32x4*)(P.in[I_LNFFN] + 8 * lane + 4), c = *(const f32x4*)(P.in[I_LNFFN] + 512 + 8 * lane), d = *(const f32x4*)(P.in[I_LNFFN] + 512 + 8 * lane + 4);
#pragma unroll
      for (int i = 0; i < 4; ++i) { gn[i] = a[i]; gn[4 + i] = b[i]; gn[8 + i] = c[i]; gn[12 + i] = d[i]; } }
    const int el = 8 * (lane & 7) + (lane >> 3);
    for (int tok = gw; tok < M_TOK; tok += NGW) {
        float hv[16], xn[16], out[16];
        { const float* hp = H + (size_t)tok * DM + 8 * lane; const f32x4 a = *(const f32x4*)hp, b = *(const f32x4*)(hp + 4), c = *(const f32x4*)(hp + 512), d = *(const f32x4*)(hp + 516);
#pragma unroll
          for (int i = 0; i < 4; ++i) { hv[i] = a[i]; hv[4 + i] = b[i]; hv[8 + i] = c[i]; hv[12 + i] = d[i]; } }
        const float ri = rsqrtf(rowss[tok] * (1.0f / 1024.0f) + EPS);
#pragma unroll
        for (int i = 0; i < 16; ++i) { xn[i] = hv[i] * ri * gn[i]; out[i] = 0.f; }
#pragma unroll 1
        for (int bt = 0; bt < 2; ++bt) {
            const int eidx = EI[(size_t)tok * 128 + bt * 64 + el]; const float gate = GT[(size_t)tok * 128 + bt * 64 + el];
            float aval = 0.f;
#pragma unroll 1
            for (int r = 0; r < 8; ++r) {
                float part[8];
#pragma unroll
                for (int i = 0; i < 8; ++i) { const int e = __builtin_amdgcn_readlane(eidx, i * 8 + r); const bf16_t* row = UT + (size_t)e * DM + 8 * lane;
                    const u32x4 wa = *(const u32x4*)row, wb = *(const u32x4*)(row + 512); part[i] = dot16(xn, wa, wb); }
                float p4[4], p2[2], p1;
                const bool b5 = lane & 32, b4 = lane & 16, b3 = lane & 8;
#pragma unroll
                for (int i = 0; i < 4; ++i) { const float keep = b5 ? part[4 + i] : part[i], send = b5 ? part[i] : part[4 + i]; p4[i] = keep + __shfl_xor(send, 32); }
#pragma unroll
                for (int i = 0; i < 2; ++i) { const float keep = b4 ? p4[2 + i] : p4[i], send = b4 ? p4[i] : p4[2 + i]; p2[i] = keep + __shfl_xor(send, 16); }
                { const float keep = b3 ? p2[1] : p2[0], send = b3 ? p2[0] : p2[1]; p1 = keep + __shfl_xor(send, 8); }
                p1 += __shfl_xor(p1, 4); p1 += __shfl_xor(p1, 2); p1 += __shfl_xor(p1, 1);
                if ((lane & 7) == r) aval = p1;
            }
            const float hid = 0.5f * aval * (1.0f + erff(aval * 0.70710678118654752f)) * gate;
#pragma unroll 1
            for (int r = 0; r < 8; ++r) {
#pragma unroll
                for (int i = 0; i < 8; ++i) { const int e = __builtin_amdgcn_readlane(eidx, i * 8 + r); const float s = __int_as_float(__builtin_amdgcn_readlane(__float_as_int(hid), i * 8 + r));
                    const bf16_t* row = VT + (size_t)e * DM + 8 * lane; const u32x4 wa = *(const u32x4*)row, wb = *(const u32x4*)(row + 512); axpy16(out, s, wa, wb); }
            }
        }
        float ss = 0.f;
#pragma unroll
        for (int i = 0; i < 16; ++i) {
#if !defined(DBG_ZERO) || DBG_ZERO != 1
            hv[i] += out[i];
#endif
            ss += hv[i] * hv[i]; }
        ss = wave_sum(ss);
        float* hp = H + (size_t)tok * DM + 8 * lane; bf16_t* bp = HB + (size_t)tok * DM + 8 * lane;
        *(f32x4*)hp = (f32x4){hv[0], hv[1], hv[2], hv[3]}; *(f32x4*)(hp + 4) = (f32x4){hv[4], hv[5], hv[6], hv[7]};
        *(f32x4*)(hp + 512) = (f32x4){hv[8], hv[9], hv[10], hv[11]}; *(f32x4*)(hp + 516) = (f32x4){hv[12], hv[13], hv[14], hv[15]};
        *(u32x4*)bp = (u32x4){cvtpk(hv[0], hv[1]), cvtpk(hv[2], hv[3]), cvtpk(hv[4], hv[5]), cvtpk(hv[6], hv[7])};
        *(u32x4*)(bp + 512) = (u32x4){cvtpk(hv[8], hv[9]), cvtpk(hv[10], hv[11]), cvtpk(hv[12], hv[13]), cvtpk(hv[14], hv[15])};
        if (lane == 0) rinv3[tok] = rsqrtf(ss * (1.0f / 1024.0f) + EPS);
    }
}

constexpr int N_PHASES = 9;
__global__ void __launch_bounds__(512, 2) mk_fwd(Params prm) {
    extern __shared__ __attribute__((aligned(16))) unsigned char lds_raw[];
    Ctx C; C.lds = (LAS unsigned char*)lds_raw; C.tid = threadIdx.x; C.lane = C.tid & 63; C.wave = __builtin_amdgcn_readfirstlane(C.tid >> 6);
    C.G = gridDim.x; { const int bx = blockIdx.x; C.vcu = (C.G % 8 == 0) ? (bx % 8) * (C.G / 8) + bx / 8 : bx; }
    C.p = &prm;
    unsigned char* ws = prm.ws;
    const int lo = prm.ph_lo, hi = prm.ph_hi;
#define IN(k) (lo <= (k) && (k) < hi)
#define SEAM(k) do { if (IN(k) && IN((k) + 1)) { cg::this_grid().sync(); } } while (0)
    bf16_t* ACTB = (bf16_t*)(ws + WS_ACTB); bf16_t* Z = (bf16_t*)(ws + WS_Z); bf16_t* YC = (bf16_t*)(ws + WS_YCAT); bf16_t* PPB = (bf16_t*)(ws + WS_PP);
    float* rowss2 = (float*)(ws + WS_CTL + WS_ROWSS2);
    if (IN(0)) { phase_prep(C); __syncthreads(); }
    SEAM(0);
    if (IN(1)) {
        { pg8::Gemm g{ACTB, (const bf16_t*)(ws + WS_WIN), M_TOK, 2048, 1024}; pg8::StaticOrder S; S.init(M_TOK, 2048, C.G, (int)blockIdx.x); pg8::EpiStoreBf16 E{Z, ZLD};
          pg8::gemm_phase<pg8::EpiStoreBf16, pg8::StaticOrder, true, true>(C.lds, g, S, E); }
        { pg8::Gemm g{(const bf16_t*)(ws + WS_PB), (const bf16_t*)(ws + WS_WP), M_TOK, 1024, 256}; pg8::StaticOrder S; S.init(M_TOK, 1024, C.G, (int)blockIdx.x); pg8::EpiStoreBf16 E{PPB, DM};
          pg8::gemm_phase<pg8::EpiStoreBf16, pg8::StaticOrder, true, true>(C.lds, g, S, E); }
    }
    SEAM(1);
    if (IN(2)) phase_rope_pool(C);
    SEAM(2);
    if (IN(3)) phase_attn(C);
    SEAM(3);
    if (IN(4)) { pg8::Gemm g{YC, (const bf16_t*)(ws + WS_WO), M_TOK, 1024, 1024}; pg8::StaticOrder S; S.init(M_TOK, 1024, C.G, (int)blockIdx.x); pg8::EpiWo E{prm.in[I_X], prm.out, ACTB, rowss2};
        pg8::gemm_phase<pg8::EpiWo, pg8::StaticOrder, true, true>(C.lds, g, S, E); }
    SEAM(4);
    if (IN(5)) { pg8::Gemm g{ACTB, (const bf16_t*)(ws + WS_WS), M_TOK, 2048, 1024}; pg8::StaticOrder S; S.init(M_TOK, 2048, C.G, (int)blockIdx.x); pg8::EpiScores E{(_Float16*)(ws + WS_Z), ZLD, rowss2};
        pg8::gemm_phase<pg8::EpiScores, pg8::StaticOrder, true, true>(C.lds, g, S, E); }
    SEAM(5);
    if (IN(6)) phase_topk(C);
    SEAM(6);
    if (IN(7)) phase_gather(C);
    SEAM(7);
    if (IN(8)) { pg8::Gemm g{ACTB, (const bf16_t*)(ws + WS_WG), M_TOK, 1024, 1024}; pg8::StaticOrder S; S.init(M_TOK, 1024, C.G, (int)blockIdx.x); pg8::EpiGate E{prm.out, PPB, (const float*)(ws + WS_RINV3)};
        pg8::gemm_phase<pg8::EpiGate, pg8::StaticOrder, true, true>(C.lds, g, S, E); }
#undef IN
#undef SEAM
}

extern "C" void kernel_launch(void* const* d_in, const int* in_sizes, int n_in, void* d_out, int out_size, void* d_ws, size_t ws_size, hipStream_t stream) {
    static int grid = 0;
    if (grid == 0) {
        if (n_in != 23 || in_sizes[0] != M_TOK * DM || out_size != M_TOK * DM || ws_size < WS_END) { fprintf(stderr, "kernel_launch: unexpected shapes (n_in %d in0 %d out %d ws %zu)\n", n_in, n_in > 0 ? in_sizes[0] : -1, out_size, ws_size); grid = -1; return; }
        int dev = 0, cus = 0, per_cu = 0;
        hipGetDevice(&dev); hipDeviceGetAttribute(&cus, hipDeviceAttributeMultiprocessorCount, dev);
        hipFuncSetAttribute((const void*)mk_fwd, hipFuncAttributeMaxDynamicSharedMemorySize, LDS_BYTES);
        hipOccupancyMaxActiveBlocksPerMultiprocessor(&per_cu, (const void*)mk_fwd, 512, LDS_BYTES);
        if (per_cu < 1) { fprintf(stderr, "kernel_launch: occupancy query says %d blocks per CU\n", per_cu); per_cu = 1; }
        (void)hipGetLastError();
        grid = cus;
    }
    if (grid < 0) return;
    hipMemsetAsync((char*)d_ws + WS_CTL, 0, CTL_BYTES, stream);
    Params prm{};
    for (int i = 0; i < 23; ++i) prm.in[i] = (const float*)d_in[i];
    prm.out = (float*)d_out; prm.ws = (unsigned char*)d_ws;
#if MK_MULTI
    for (int ph = 0; ph < N_PHASES; ++ph) { prm.ph_lo = ph; prm.ph_hi = ph + 1; hipLaunchKernelGGL(mk_fwd, dim3(grid), dim3(512), LDS_BYTES, stream, prm); }
#else
    prm.ph_lo = 0; prm.ph_hi = N_PHASES;
    void* args[] = {&prm};
    hipError_t e = hipLaunchCooperativeKernel((const void*)mk_fwd, dim3(grid), dim3(512), args, LDS_BYTES, stream);
    if (e != hipSuccess) fprintf(stderr, "cooperative launch failed: %s (grid %d)\n", hipGetErrorString(e), grid);
#endif
}
```

```cpp
#include <hip/hip_runtime.h>
#include <hip/hip_cooperative_groups.h>
#include <cstdio>
#include <cstdint>
#include <cmath>
namespace cg = cooperative_groups;

#ifndef MK_COOP_SYNC0
#define MK_COOP_SYNC0 1
#endif
#ifndef MK_MULTI
#define MK_MULTI 0
#endif

#ifndef PROBE_ATTN2
#define PROBE_ATTN2 0
#endif
#ifndef PROBE_G1
#define PROBE_G1 0
#endif
#ifndef PROBE_G5
#define PROBE_G5 0
#endif
#ifndef PROBE_PREP
#define PROBE_PREP 0
#endif
#ifndef PROBE_ATTN
#define PROBE_ATTN 0
#endif
#ifndef PROBE_TOPK
#define PROBE_TOPK 0
#endif
#ifndef PROBE_GATHER
#define PROBE_GATHER 0
#endif
#ifndef PROBE_SYNC
#define PROBE_SYNC 0
#endif
#define LAS __attribute__((address_space(3)))
typedef unsigned short bf16_t;
typedef short bf16x8 __attribute__((ext_vector_type(8)));
typedef short s16x4 __attribute__((ext_vector_type(4)));
typedef float f32x4 __attribute__((ext_vector_type(4)));
typedef float f32x2 __attribute__((ext_vector_type(2)));
typedef float f32x16 __attribute__((ext_vector_type(16)));
typedef unsigned u32x4 __attribute__((ext_vector_type(4)));
typedef unsigned u32x2 __attribute__((ext_vector_type(2)));
typedef __bf16 bf16x2_t __attribute__((ext_vector_type(2)));
typedef _Float16 f16x8 __attribute__((ext_vector_type(8)));
typedef _Float16 f16x2 __attribute__((ext_vector_type(2)));

constexpr int M_TOK = 32768, DM = 1024, SEQ = 8192, NB = 4, ZLD = 2048, DPLE = 256;
constexpr float EPS = 1e-6f;
constexpr float U4SCALE = 64.0f, V4SCALE = 5.656854249f;
constexpr float QSCALE = 0.125f * 1.4426950408889634f;
constexpr size_t MiB = 1u << 20;
constexpr size_t WS_CTL = 0, CTL_BYTES = 1 * MiB;
constexpr size_t WS_ROWSS2 = 256 * 1024;
constexpr size_t WS_WIN = 1 * MiB, WS_WO = 5 * MiB, WS_WS = 7 * MiB, WS_WG = 11 * MiB, WS_WP = 13 * MiB, WS_RINV3 = 14 * MiB;
constexpr size_t WS_UT = 16 * MiB, WS_VT = 48 * MiB, WS_ACTB = 80 * MiB, WS_PB = 144 * MiB, WS_Z = 160 * MiB, WS_YCAT = 288 * MiB, WS_PP = 352 * MiB;
constexpr size_t WS_EIDX = 416 * MiB, WS_GATE = 432 * MiB, WS_CST = 448 * MiB, WS_END = 452 * MiB;
constexpr int LDS_BYTES = 147456;

__device__ __forceinline__ unsigned cvtpk(float lo, float hi) { f32x2 v = {lo, hi}; bf16x2_t b = __builtin_convertvector(v, bf16x2_t); return __builtin_bit_cast(unsigned, b); }
__device__ __forceinline__ float bflo(unsigned w) { return __uint_as_float(w << 16); }
__device__ __forceinline__ float bfhi(unsigned w) { return __uint_as_float(w & 0xffff0000u); }
__device__ __forceinline__ unsigned pack_i8(const f32x4 v) {
    int a = __float2int_rn(v[0]), b = __float2int_rn(v[1]), c = __float2int_rn(v[2]), d = __float2int_rn(v[3]);
    a = a < -127 ? -127 : (a > 127 ? 127 : a); b = b < -127 ? -127 : (b > 127 ? 127 : b); c = c < -127 ? -127 : (c > 127 ? 127 : c); d = d < -127 ? -127 : (d > 127 ? 127 : d);
    return ((unsigned)a & 0xffu) | (((unsigned)b & 0xffu) << 8) | (((unsigned)c & 0xffu) << 16) | ((unsigned)d << 24);
}
__device__ __forceinline__ unsigned pack_u4x8(const f32x4 a, const f32x4 b) {
    unsigned w = 0;
#pragma unroll
    for (int i = 0; i < 4; ++i) { int lo = __float2int_rn(a[i]), hi = __float2int_rn(b[i]); lo = lo < -8 ? -8 : (lo > 7 ? 7 : lo); hi = hi < -8 ? -8 : (hi > 7 ? 7 : hi);
        w |= ((unsigned)(lo + 8) | ((unsigned)(hi + 8) << 4)) << (8 * i); }
    return w;
}
__device__ __forceinline__ float wave_sum(float v) {
#pragma unroll
    for (int o = 1; o < 64; o <<= 1) v += __shfl_xor(v, o);
    return v;
}

namespace pg8 {
#define PG8_LAS __attribute__((address_space(3)))
constexpr int BM = 256, BK = 64, HALF = 128, HTB = HALF * BK * 2, STAGE_BYTES = 8 * HTB, NXCD = 8, WGM = 8;
__host__ __device__ __forceinline__ int lds_byte(int r, int c) { const int st = (r >> 4) * 2 + (c >> 5), rr = r & 15, cc = c & 31, ob = rr * 64 + cc * 2; return st * 1024 + (ob ^ (((ob >> 9) & 1) << 5)); }
__host__ __device__ __forceinline__ void stage_rc(int b, int& R, int& C) { const int st = b / 1024, sb = b % 1024, swz = sb ^ (((sb >> 9) & 1) << 5); R = (st >> 1) * 16 + swz / 64; C = (st & 1) * 32 + (swz % 64) / 2; }
__host__ __device__ __forceinline__ int perm32(int rho) { const int n = rho >> 4, i = rho & 15; return 8 * (i >> 2) + 4 * n + (i & 3); }
struct Unit { int pm, pn; };
struct Gemm { const bf16_t* A; const bf16_t* Bt; int M, N, K; };
struct StaticOrder {
    int nM, nN, nwg, G, c;
    __host__ __device__ void init(int M, int N, int G_, int c_) { nM = M / BM; nN = N / BM; nwg = nM * nN; G = G_; c = c_; }
    __host__ __device__ bool next(int i, Unit& u) const {
        const long L = (long)i * G + c; if (L >= nwg) return false;
        int wgid = (int)L; { const int q = nwg / NXCD, r = nwg % NXCD, xcd = wgid % NXCD, off = wgid / NXCD; wgid = (xcd < r ? xcd * (q + 1) : r * (q + 1) + (xcd - r) * q) + off; }
        const int nig = WGM * nN, gid = wgid / nig, fm = gid * WGM, gsz = (nM - fm) < WGM ? (nM - fm) : WGM;
        u.pm = fm + ((wgid % nig) % gsz); u.pn = (wgid % nig) / gsz; return true;
    }
    __device__ __forceinline__ void a_ready(const Unit&) const {}
    __device__ __forceinline__ void done(const Unit&) const {}
};
template <class Epi, class Sched, bool ALIGN_EPI = false, bool SP2 = false>
__device__ __forceinline__ void gemm_phase(PG8_LAS unsigned char* lds, const Gemm g, const Sched& S, const Epi& E) {
    int tid = threadIdx.x; asm volatile("" : "+v"(tid));
    const int wid = __builtin_amdgcn_readfirstlane(tid >> 6), lane = tid & 63, wr = wid >> 2, wc = wid & 3, fr = lane & 15, fq = lane >> 4;
    const int K = g.K, nt = K / BK;
    unsigned voffA[2], voffB[2];
#pragma unroll
    for (int i = 0; i < 2; ++i) { int R, C; stage_rc(tid * 16 + i * 8192, R, C); const int Rb = Epi::PAIRMAP ? (64 * (R >> 5) + perm32(R & 31)) : Epi::PERM ? ((R & ~31) + perm32(R & 31)) : R;
        voffA[i] = (unsigned)(R * K + C) * 2u; voffB[i] = (unsigned)(Rb * K + C) * 2u; }
    const size_t hstepB = (size_t)(Epi::PAIRMAP ? 32 : HALF) * K * 2;
    const size_t kstep = (size_t)(BK * 2);
    const size_t hstep = (size_t)HALF * K * 2;
    const size_t tstep = 2 * hstep;
    const unsigned ldsw = (unsigned)wid * 1024u;
    const int aoff = lds_byte(wr * 64 + fr, fq * 8), boff = lds_byte(wc * 32 + fr, fq * 8);
#define PG8_SA(b, h) (((b) * 2 + (h)) * HTB)
#define PG8_SB(b, h) ((4 + (b) * 2 + (h)) * HTB)
#define PG8_STAGE(bufoff, gbase, voff) do { _Pragma("unroll") for (int _i = 0; _i < 2; ++_i) \
        __builtin_amdgcn_global_load_lds((const unsigned*)((const char*)(gbase) + (voff)[_i]), (PG8_LAS unsigned*)(lds + (bufoff) + ldsw + _i * 8192), 16, 0, 0); } while (0)
#define PG8_LDA(dst, b, h) do { _Pragma("unroll") for (int m = 0; m < 4; ++m) _Pragma("unroll") for (int k = 0; k < 2; ++k) dst[m][k] = *(const PG8_LAS bf16x8*)(lds + PG8_SA(b, h) + aoff + m * 2048 + k * 1024); } while (0)
#define PG8_LDB(dst, b, h) do { _Pragma("unroll") for (int n = 0; n < 2; ++n) _Pragma("unroll") for (int k = 0; k < 2; ++k) dst[n][k] = *(const PG8_LAS bf16x8*)(lds + PG8_SB(b, h) + boff + n * 2048 + k * 1024); } while (0)
#define PG8_MMA(ai, bj, At, Bt) do { __builtin_amdgcn_s_setprio(1); _Pragma("unroll") for (int m = 0; m < 4; ++m) _Pragma("unroll") for (int n = 0; n < 2; ++n) _Pragma("unroll") for (int k = 0; k < 2; ++k) \
        acc[ai][bj][m][n] = __builtin_amdgcn_mfma_f32_16x16x32_bf16(Bt[n][k], At[m][k], acc[ai][bj][m][n], 0, 0, 0); __builtin_amdgcn_s_setprio(0); } while (0)
#define PG8_WAIT_V(n) asm volatile("s_waitcnt vmcnt(" #n ")" ::: "memory")
#define PG8_WAIT_L(n) asm volatile("s_waitcnt lgkmcnt(" #n ")" ::: "memory")
#define PG8_BAR __builtin_amdgcn_s_barrier()
#define PG8_SCHED __builtin_amdgcn_sched_barrier(0)
    Unit cur, nxt; int ui = 0;
    if (!S.next(0, cur)) return;
    f32x4 acc[2][2][4][2];
#pragma unroll
    for (int a = 0; a < 2; ++a)
#pragma unroll
        for (int b = 0; b < 2; ++b)
#pragma unroll
            for (int m = 0; m < 4; ++m)
#pragma unroll
                for (int n = 0; n < 2; ++n) acc[a][b][m][n] = (f32x4){0.f, 0.f, 0.f, 0.f};
    bf16x8 At[4][2], B0[2][2], B1[2][2];
    const char* cA = (const char*)g.A + (size_t)cur.pm * tstep; const char* cB = (const char*)g.Bt + (size_t)cur.pn * tstep;
    S.a_ready(cur);
    if constexpr (SP2) {
        PG8_STAGE(PG8_SB(0, 0), cB, voffB); PG8_STAGE(PG8_SB(0, 1), cB + hstepB, voffB); PG8_STAGE(PG8_SA(0, 0), cA, voffA); PG8_STAGE(PG8_SA(0, 1), cA + hstep, voffA);
        if (wr == 1) PG8_BAR;
        PG8_WAIT_V(2); PG8_BAR;
        PG8_STAGE(PG8_SB(1, 0), cB + kstep, voffB); PG8_STAGE(PG8_SA(1, 0), cA + kstep, voffA); PG8_STAGE(PG8_SB(1, 1), cB + hstepB + kstep, voffB);
        PG8_WAIT_V(6); PG8_BAR;
    } else {
        PG8_STAGE(PG8_SB(0, 0), cB, voffB); PG8_STAGE(PG8_SA(0, 0), cA, voffA); PG8_STAGE(PG8_SB(0, 1), cB + hstepB, voffB); PG8_STAGE(PG8_SA(0, 1), cA + hstep, voffA);
        if (wr == 1) PG8_BAR;
        PG8_WAIT_V(4); PG8_BAR;
        PG8_STAGE(PG8_SB(1, 0), cB + kstep, voffB); PG8_STAGE(PG8_SA(1, 0), cA + kstep, voffA); PG8_STAGE(PG8_SB(1, 1), cB + hstepB + kstep, voffB);
        PG8_WAIT_V(6); PG8_BAR;
    }
    for (;;) {
        const bool has_next = S.next(ui + 1, nxt);
        const char* nA = has_next ? (const char*)g.A + (size_t)nxt.pm * tstep : cA; const char* nB = has_next ? (const char*)g.Bt + (size_t)nxt.pn * tstep : cB;
#pragma unroll 1
        for (int t = 0; t < nt; t += 2) {
            const bool last = (t == nt - 2);
            const char* a1 = cA + (size_t)(t + 1) * kstep;
            const char* a2 = last ? nA : cA + (size_t)(t + 2) * kstep; const char* b2 = last ? nB : cB + (size_t)(t + 2) * kstep;
            const char* a3 = a2 + kstep; const char* b3 = b2 + kstep;
            if (last && has_next) S.a_ready(nxt);
            if constexpr (SP2) {
            PG8_LDB(B0, 0, 0); PG8_LDB(B1, 0, 1); PG8_SCHED; PG8_LDA(At, 0, 0); PG8_STAGE(PG8_SA(1, 1), a1 + hstep, voffA);
            PG8_WAIT_V(8); PG8_WAIT_L(0); PG8_BAR; PG8_MMA(0, 0, At, B0); PG8_MMA(0, 1, At, B1); PG8_BAR; PG8_SCHED;
            PG8_LDA(At, 0, 1); PG8_STAGE(PG8_SB(0, 0), b2, voffB); PG8_STAGE(PG8_SB(0, 1), b2 + hstepB, voffB); PG8_STAGE(PG8_SA(0, 0), a2, voffA);
            PG8_WAIT_V(8); PG8_WAIT_L(0); PG8_BAR; PG8_MMA(1, 0, At, B0); PG8_MMA(1, 1, At, B1); PG8_BAR; PG8_SCHED;
            PG8_LDB(B0, 1, 0); PG8_LDB(B1, 1, 1); PG8_SCHED; PG8_LDA(At, 1, 0); PG8_STAGE(PG8_SA(0, 1), a2 + hstep, voffA);
            PG8_WAIT_V(8); PG8_WAIT_L(0); PG8_BAR; PG8_MMA(0, 0, At, B0); PG8_MMA(0, 1, At, B1); PG8_BAR; PG8_SCHED;
            PG8_LDA(At, 1, 1); PG8_STAGE(PG8_SB(1, 0), b3, voffB); PG8_STAGE(PG8_SB(1, 1), b3 + hstepB, voffB); PG8_STAGE(PG8_SA(1, 0), a3, voffA);
            PG8_WAIT_V(8); PG8_WAIT_L(0); PG8_BAR; PG8_MMA(1, 0, At, B0); PG8_MMA(1, 1, At, B1); PG8_BAR; PG8_SCHED;
            } else {
            PG8_LDB(B0, 0, 0); PG8_SCHED; PG8_LDA(At, 0, 0); PG8_STAGE(PG8_SA(1, 1), a1 + hstep, voffA);
            PG8_WAIT_L(8); PG8_BAR; PG8_WAIT_L(0); PG8_MMA(0, 0, At, B0); PG8_BAR; PG8_SCHED;
            PG8_LDB(B1, 0, 1); PG8_STAGE(PG8_SB(0, 0), b2, voffB);
            PG8_BAR; PG8_WAIT_L(0); PG8_MMA(0, 1, At, B1); PG8_BAR;
            PG8_LDA(At, 0, 1); PG8_STAGE(PG8_SA(0, 0), a2, voffA);
            PG8_BAR; PG8_WAIT_L(0); PG8_MMA(1, 0, At, B0); PG8_BAR; PG8_SCHED;
            PG8_STAGE(PG8_SB(0, 1), b2 + hstepB, voffB);
            PG8_WAIT_V(6); PG8_BAR; PG8_MMA(1, 1, At, B1); PG8_BAR;
            PG8_LDB(B0, 1, 0); PG8_SCHED; PG8_LDA(At, 1, 0); PG8_STAGE(PG8_SA(0, 1), a2 + hstep, voffA);
            PG8_WAIT_L(8); PG8_BAR; PG8_WAIT_L(0); PG8_MMA(0, 0, At, B0); PG8_BAR; PG8_SCHED;
            PG8_LDB(B1, 1, 1); PG8_STAGE(PG8_SB(1, 0), b3, voffB);
            PG8_BAR; PG8_WAIT_L(0); PG8_MMA(0, 1, At, B1); PG8_BAR;
            PG8_LDA(At, 1, 1); PG8_STAGE(PG8_SA(1, 0), a3, voffA);
            PG8_BAR; PG8_WAIT_L(0); PG8_MMA(1, 0, At, B0); PG8_BAR; PG8_SCHED;
            PG8_STAGE(PG8_SB(1, 1), b3 + hstepB, voffB);
            PG8_WAIT_V(6); PG8_BAR; PG8_MMA(1, 1, At, B1); PG8_BAR;
            }
        }
        if constexpr (ALIGN_EPI) { if (wr == 0) PG8_BAR; }
        if constexpr (!Epi::AFTER_DRAIN) { E(acc, cur, wr, wc, fr, fq); S.done(cur); }
        if (!has_next) break;
#pragma unroll
        for (int a = 0; a < 2; ++a)
#pragma unroll
            for (int b = 0; b < 2; ++b)
#pragma unroll
                for (int m = 0; m < 4; ++m)
#pragma unroll
                    for (int n = 0; n < 2; ++n) acc[a][b][m][n] = (f32x4){0.f, 0.f, 0.f, 0.f};
        cur = nxt; cA = nA; cB = nB; ++ui;
        if constexpr (ALIGN_EPI) { if (wr == 1) PG8_BAR; }
    }
    PG8_WAIT_V(0);
    if constexpr (!ALIGN_EPI) { if (wr == 0) PG8_BAR; }
    PG8_BAR;
#undef PG8_SA
#undef PG8_SB
#undef PG8_STAGE
#undef PG8_LDA
#undef PG8_LDB
#undef PG8_MMA
#undef PG8_WAIT_V
#undef PG8_WAIT_L
#undef PG8_BAR
#undef PG8_SCHED
}

struct EpiStoreBf16 {
    static constexpr bool PERM = true, AFTER_DRAIN = false, PAIRMAP = false;
    bf16_t* O; int ldc;
    __device__ __forceinline__ void operator()(const f32x4 (&acc)[2][2][4][2], const Unit& u, int wr, int wc, int fr, int fq) const {
        const int row0 = u.pm * BM + wr * 64 + fr, col0 = u.pn * BM + wc * 32 + 8 * fq;
#pragma unroll
        for (int ai = 0; ai < 2; ++ai)
#pragma unroll
            for (int m = 0; m < 4; ++m) { bf16_t* rowp = O + (size_t)(row0 + ai * HALF + m * 16) * ldc + col0;
#pragma unroll
                for (int bj = 0; bj < 2; ++bj) { const f32x4 v0 = acc[ai][bj][m][0], v1 = acc[ai][bj][m][1];
                    u32x4 w; w.x = cvtpk(v0[0], v0[1]); w.y = cvtpk(v0[2], v0[3]); w.z = cvtpk(v1[0], v1[1]); w.w = cvtpk(v1[2], v1[3]);
                    *(u32x4*)(rowp + bj * HALF) = w; } }
    }
};
typedef _Float16 hf2 __attribute__((ext_vector_type(2)));
struct EpiZ {
    static constexpr bool PERM = true, AFTER_DRAIN = false, PAIRMAP = true;
    bf16_t* O; int ldc; const float* qn; const float* kn; const unsigned* cst;
    __device__ __forceinline__ void operator()(const f32x4 (&acc)[2][2][4][2], const Unit& u, int wr, int wc, int fr, int fq) const {
        asm volatile("" : "+v"(fr), "+v"(fq));
        const int row0 = u.pm * BM + wr * 64 + fr, col0 = u.pn * BM + wc * 64 + 8 * fq;
        const int kind = u.pn >> 1;
        if (kind == 0 || kind == 3) {
#pragma unroll
            for (int ai = 0; ai < 2; ++ai)
#pragma unroll
                for (int m = 0; m < 4; ++m) { bf16_t* rowp = O + (size_t)(row0 + ai * HALF + m * 16) * ldc + col0;
#pragma unroll
                    for (int bj = 0; bj < 2; ++bj) { const f32x4 v0 = acc[ai][bj][m][0], v1 = acc[ai][bj][m][1];
                        u32x4 w; w.x = cvtpk(v0[0], v0[1]); w.y = cvtpk(v0[2], v0[3]); w.z = cvtpk(v1[0], v1[1]); w.w = cvtpk(v1[2], v1[3]);
                        *(u32x4*)(rowp + bj * 32) = w; } }
            return;
        }
        const float* gn = kind == 1 ? qn : kn; const float osc = kind == 1 ? QSCALE : 1.0f;
        float g1[8], g2[8];
#pragma unroll
        for (int t = 0; t < 8; ++t) { g1[t] = gn[8 * fq + t] * osc; g2[t] = gn[32 + 8 * fq + t] * osc; }
        const unsigned* cp = cst + (size_t)row0 * 32 + 8 * fq;
        u32x4 c0 = *(const u32x4*)cp, c1 = *(const u32x4*)(cp + 4);
#pragma unroll
        for (int it = 0; it < 8; ++it) {
            const int ai = it >> 2, m = it & 3, row = row0 + ai * HALF + m * 16;
            u32x4 n0 = c0, n1 = c1;
            if (it < 7) { const unsigned* np = cp + (size_t)(((it + 1) >> 2) * HALF + ((it + 1) & 3) * 16) * 32; n0 = *(const u32x4*)np; n1 = *(const u32x4*)(np + 4); }
            const unsigned cw[8] = {c0.x, c0.y, c0.z, c0.w, c1.x, c1.y, c1.z, c1.w};
            float t1[8], t2[8];
#pragma unroll
            for (int t = 0; t < 8; ++t) { t1[t] = acc[ai][0][m][t >> 2][t & 3]; t2[t] = acc[ai][1][m][t >> 2][t & 3]; }
            float ss = 0.f;
#pragma unroll
            for (int t = 0; t < 8; ++t) ss += t1[t] * t1[t] + t2[t] * t2[t];
            ss += __shfl_xor(ss, 16); ss += __shfl_xor(ss, 32);
            const float ri = rsqrtf(ss * (1.0f / 64.0f) + EPS);
            float o1[8], o2[8];
#pragma unroll
            for (int t = 0; t < 8; ++t) {
                const hf2 cs2 = __builtin_bit_cast(hf2, cw[t]); const float cs = (float)cs2[0], sn = (float)cs2[1];
                const float x1 = t1[t] * (ri * g1[t]), x2 = t2[t] * (ri * g2[t]);
                o1[t] = x1 * cs - x2 * sn; o2[t] = x2 * cs + x1 * sn;
            }
            bf16_t* rowp = O + (size_t)row * ldc + col0;
            *(u32x4*)rowp = (u32x4){cvtpk(o1[0], o1[1]), cvtpk(o1[2], o1[3]), cvtpk(o1[4], o1[5]), cvtpk(o1[6], o1[7])};
            *(u32x4*)(rowp + 32) = (u32x4){cvtpk(o2[0], o2[1]), cvtpk(o2[2], o2[3]), cvtpk(o2[4], o2[5]), cvtpk(o2[6], o2[7])};
            __builtin_amdgcn_sched_barrier(0);
            c0 = n0; c1 = n1;
        }
    }
};
struct EpiScores {
    static constexpr bool PERM = true, AFTER_DRAIN = false, PAIRMAP = false;
    _Float16* O; int ldc; const float* rowss;
    __device__ __forceinline__ void operator()(const f32x4 (&acc)[2][2][4][2], const Unit& u, int wr, int wc, int fr, int fq) const {
        const int row0 = u.pm * BM + wr * 64 + fr, col0 = u.pn * BM + wc * 32 + 8 * fq;
#pragma unroll
        for (int ai = 0; ai < 2; ++ai)
#pragma unroll
            for (int m = 0; m < 4; ++m) { const int row = row0 + ai * HALF + m * 16; const float ri = rsqrtf(rowss[row] * (1.0f / 1024.0f) + EPS);
                _Float16* rowp = O + (size_t)row * ldc + col0;
#pragma unroll
                for (int bj = 0; bj < 2; ++bj) { const f32x4 v0 = acc[ai][bj][m][0] * ri, v1 = acc[ai][bj][m][1] * ri;
                    f16x8 w = {(_Float16)v0[0], (_Float16)v0[1], (_Float16)v0[2], (_Float16)v0[3], (_Float16)v1[0], (_Float16)v1[1], (_Float16)v1[2], (_Float16)v1[3]};
                    *(f16x8*)(rowp + bj * HALF) = w; } }
    }
};
struct EpiWo {
    static constexpr bool PERM = false, AFTER_DRAIN = false, PAIRMAP = false;
    const float* X; bf16_t* HB; float* rowss;
    __device__ __forceinline__ void operator()(const f32x4 (&acc)[2][2][4][2], const Unit& u, int wr, int wc, int fr, int fq) const {
        const int row0 = u.pm * BM + wr * 64 + fr, col0 = u.pn * BM + wc * 32 + 4 * fq;
#pragma unroll
        for (int ai = 0; ai < 2; ++ai)
#pragma unroll
            for (int m = 0; m < 4; ++m) { const int row = row0 + ai * HALF + m * 16; const size_t off = (size_t)row * DM + col0; float ss = 0.f;
#pragma unroll
                for (int bj = 0; bj < 2; ++bj)
#pragma unroll
                    for (int n = 0; n < 2; ++n) { const size_t o2 = off + bj * HALF + n * 16; const f32x4 h = *(const f32x4*)(X + o2) + acc[ai][bj][m][n];
                        u32x2 w; w.x = cvtpk(h[0], h[1]); w.y = cvtpk(h[2], h[3]); *(u32x2*)(HB + o2) = w;
                        ss += (h[0] * h[0] + h[1] * h[1]) + (h[2] * h[2] + h[3] * h[3]); }
                ss += __shfl_xor(ss, 16); ss += __shfl_xor(ss, 32);
                if (fq == 0) atomicAdd(rowss + row, ss); }
    }
};
struct EpiGate {
    static constexpr bool PERM = false, AFTER_DRAIN = false, PAIRMAP = false;
    float* HO; const bf16_t* HB; const bf16_t* PP; const float* rinv;
    __device__ __forceinline__ void operator()(const f32x4 (&acc)[2][2][4][2], const Unit& u, int wr, int wc, int fr, int fq) const {
        const int row0 = u.pm * BM + wr * 64 + fr, col0 = u.pn * BM + wc * 32 + 4 * fq;
#pragma unroll
        for (int ai = 0; ai < 2; ++ai)
#pragma unroll
            for (int m = 0; m < 4; ++m) { const int row = row0 + ai * HALF + m * 16; const size_t off = (size_t)row * DM + col0; const float ri = rinv[row];
#pragma unroll
                for (int bj = 0; bj < 2; ++bj)
#pragma unroll
                    for (int n = 0; n < 2; ++n) { const size_t o2 = off + bj * HALF + n * 16; const u32x2 hw = *(const u32x2*)(HB + o2); const f32x4 h = {bflo(hw.x), bfhi(hw.x), bflo(hw.y), bfhi(hw.y)}; const u32x2 pw = *(const u32x2*)(PP + o2);
                        const f32x4 a = acc[ai][bj][m][n] * ri; f32x4 o;
                        o[0] = h[0] + bflo(pw.x) / (1.0f + __expf(-a[0])); o[1] = h[1] + bfhi(pw.x) / (1.0f + __expf(-a[1]));
                        o[2] = h[2] + bflo(pw.y) / (1.0f + __expf(-a[2])); o[3] = h[3] + bfhi(pw.y) / (1.0f + __expf(-a[3]));
                        *(f32x4*)(HO + o2) = o; } }
    }
};
}

#define XB_TMO      128
#define XB_XCNT(j)  (256  + 64 * (j))
#define XB_XSUB(j)  (1280 + 64 * (j))
#define XB_XGEN(j)  (2304 + 64 * (j))
#define XB_TOP      3328
#define XB_TOPGEN   3392
#define XCD_BAR_WORDS 3456
#define XB_SPIN_CAP (1u << 18)
__device__ __forceinline__ unsigned xb_ld(unsigned* p)              { return __hip_atomic_load(p, __ATOMIC_RELAXED, __HIP_MEMORY_SCOPE_AGENT); }
__device__ __forceinline__ unsigned xb_add(unsigned* p, unsigned v) { return __hip_atomic_fetch_add(p, v, __ATOMIC_RELAXED, __HIP_MEMORY_SCOPE_AGENT); }
__device__ __forceinline__ unsigned xb_xcc_id() { return (unsigned)__builtin_amdgcn_s_getreg((3 << 11) | 20) & 0xFu; }
#define XB_SPIN(cond, bar) do { unsigned _sp = 0; while (cond) { __builtin_amdgcn_s_sleep(1); \
    if ((++_sp & 255u) == 0u) { if (xb_ld(&(bar)[XB_TMO])) break; if (_sp > XB_SPIN_CAP) { atomicAdd(&(bar)[XB_TMO], 1u); break; } } } } while (0)
struct XcdBarrier { unsigned* bar; unsigned x; volatile LAS unsigned* st; };
__device__ __forceinline__ XcdBarrier xcd_barrier_post(unsigned* bar, volatile LAS unsigned* st) {
    XcdBarrier b; b.bar = bar; b.x = xb_xcc_id(); b.st = st;
    if (threadIdx.x == 0) (void)xb_add(&bar[XB_XCNT(b.x)], 1u);
    return b;
}
__device__ __forceinline__ void xcd_barrier_complete(unsigned* bar, unsigned x, unsigned& nloc, unsigned& nx) {
    const unsigned G = gridDim.x * gridDim.y * gridDim.z;
    unsigned sum, cnt, mine, sp = 0u;
    for (;;) {
        sum = 0u; cnt = 0u; mine = 0u;
#pragma unroll
        for (unsigned j = 0; j < 16; ++j) { const unsigned c = xb_ld(&bar[XB_XCNT(j)]); sum += c; cnt += (c > 0u) ? 1u : 0u; mine = (j == x) ? c : mine; }
        if (sum == G) break;
        __builtin_amdgcn_s_sleep(1);
        if ((++sp & 255u) == 0u) { if (xb_ld(&bar[XB_TMO])) break; if (sp > XB_SPIN_CAP) { atomicAdd(&bar[XB_TMO], 1u); break; } }
    }
    nloc = mine > 0u ? mine : 1u; nx = cnt > 0u ? cnt : 1u;
}
__device__ __forceinline__ void xcd_barrier(const XcdBarrier& b) {
    asm volatile("s_waitcnt vmcnt(0)" ::: "memory");
    __syncthreads();
    if (threadIdx.x == 0) {
        unsigned* bar = b.bar;
        __builtin_amdgcn_s_waitcnt(0);
        unsigned nloc = b.st[0], nx = b.st[1];
        if (nloc == 0u) { xcd_barrier_complete(bar, b.x, nloc, nx); b.st[0] = nloc; b.st[1] = nx; }
        const unsigned old = xb_add(&bar[XB_XSUB(b.x)], 1u);
        const unsigned gen = old / nloc;
        if (old + 1u == (gen + 1u) * nloc) {
            __builtin_amdgcn_fence(__ATOMIC_RELEASE, "agent");
            asm volatile("s_waitcnt vmcnt(0)" ::: "memory");
            const unsigned og = xb_add(&bar[XB_TOP], 1u);
            const unsigned tg = og / nx;
            if (og + 1u == (tg + 1u) * nx) xb_add(&bar[XB_TOPGEN], 1u);
            else XB_SPIN(xb_ld(&bar[XB_TOPGEN]) == tg, bar);
            __builtin_amdgcn_fence(__ATOMIC_ACQUIRE, "agent");
            xb_add(&bar[XB_XGEN(b.x)], 1u);
            asm volatile("s_waitcnt vmcnt(0)" ::: "memory");
        } else {
            XB_SPIN(xb_ld(&bar[XB_XGEN(b.x)]) == gen, bar);
            __builtin_amdgcn_fence(__ATOMIC_ACQUIRE, "agent");
            asm volatile("s_waitcnt vmcnt(0)" ::: "memory");
        }
    }
    __syncthreads();
}

struct Params { const float* in[23]; float* out; unsigned char* ws; int ph_lo, ph_hi; };
enum { I_X = 0, I_P, I_POS, I_LNMIX, I_WIN, I_POOLW, I_POOLS, I_QN, I_KN, I_LQ1, I_LK1, I_LQ2, I_LK2, I_SUBLN, I_WO, I_LNFFN, I_WPQ, I_SUBK, I_PU, I_PV, I_LNPE, I_WG, I_WPP };

struct Ctx {
    LAS unsigned char* lds; int tid, lane, wave, G, vcu;
    const Params* p;
};

__device__ __forceinline__ void transpose_item(const float* W, int ldw, int coff, const float* gain, bf16_t* WT, int ldk, int roff, int nblk, LAS float* scr, int item, int lane) {
    const int kb = item / nblk, nb = item % nblk, k0 = 64 * kb, n0 = 32 * nb;
#pragma unroll 8
    for (int i = 0; i < 32; ++i) { const int kk = 2 * i + (lane >> 5); const float gsc = gain ? gain[k0 + kk] : 1.0f; scr[kk * 33 + (lane & 31)] = W[(size_t)(k0 + kk) * ldw + coff + n0 + (lane & 31)] * gsc; }
    asm volatile("s_waitcnt lgkmcnt(0)" ::: "memory");
    const int c = lane & 7;
#pragma unroll
    for (int j = 0; j < 4; ++j) { const int n = (lane >> 3) + 8 * j; const LAS float* s = scr + (8 * c) * 33 + n;
        u32x4 o; o.x = cvtpk(s[0 * 33], s[1 * 33]); o.y = cvtpk(s[2 * 33], s[3 * 33]); o.z = cvtpk(s[4 * 33], s[5 * 33]); o.w = cvtpk(s[6 * 33], s[7 * 33]);
        *(u32x4*)(WT + (size_t)(roff + n0 + n) * ldk + k0 + 8 * c) = o; }
    asm volatile("s_waitcnt lgkmcnt(0)" ::: "memory");
}

template <int ROWS, bool POOL> __device__ __forceinline__ void fold_items(const Ctx& C) {
    const Params& P = *C.p; unsigned char* ws = P.ws; const int tid = C.tid;
    bf16_t* WinT = (bf16_t*)(ws + WS_WIN); bf16_t* WsT = (bf16_t*)(ws + WS_WS);
    constexpr int KT = 1024 / ROWS, NIT = (POOL ? 4 : 16) * KT, RPT = ROWS / 4;
    LAS float* As = (LAS float*)C.lds;
    LAS float* Bs = (LAS float*)(C.lds + 32768);
    for (int it = blockIdx.x; it < NIT; it += C.G) {
        const int blk = it / KT, k0 = (it % KT) * ROWS;
        const float* Asrc = (POOL ? P.in[I_WIN] : P.in[I_WPQ]) + blk * 128;
        const float* Bsrc = (POOL ? P.in[I_POOLW] : P.in[I_SUBK]) + (size_t)blk * 128 * 128;
#pragma unroll
        for (int i = 0; i < ROWS / 16; ++i) { const int v = tid + 512 * i, r = v >> 5, c4 = v & 31; *(LAS f32x4*)(As + r * 128 + c4 * 4) = *(const f32x4*)(Asrc + (size_t)(k0 + r) * 2048 + c4 * 4); }
        { f32x4 bv[8];
#pragma unroll
          for (int i = 0; i < 8; ++i) bv[i] = *(const f32x4*)(Bsrc + 4 * (tid + 512 * i));
#pragma unroll
          for (int i = 0; i < 8; ++i) { const int idx = 4 * (tid + 512 * i), r = idx >> 7, c = idx & 127;
#pragma unroll
              for (int q = 0; q < 4; ++q) { if (POOL) Bs[r * 129 + c + q] = bv[i][q]; else Bs[(c + q) * 129 + r] = bv[i][q]; } } }
        __syncthreads();
        const int n = tid & 127, kg = tid >> 7;
        float acc[RPT];
#pragma unroll
        for (int i = 0; i < RPT; ++i) acc[i] = 0.f;
        for (int c = 0; c < 128; c += 4) {
            const float b0 = Bs[(c + 0) * 129 + n], b1 = Bs[(c + 1) * 129 + n], b2 = Bs[(c + 2) * 129 + n], b3 = Bs[(c + 3) * 129 + n];
#pragma unroll
            for (int i = 0; i < RPT; ++i) { const f32x4 a = *(const LAS f32x4*)(As + (kg * RPT + i) * 128 + c); acc[i] += a[0] * b0 + a[1] * b1 + a[2] * b2 + a[3] * b3; }
        }
        const float cs = POOL ? P.in[I_POOLS][blk * 128 + n] : 1.0f; const float* gain = POOL ? P.in[I_LNMIX] : P.in[I_LNFFN];
        bf16_t* dst = (POOL ? WinT : WsT) + (size_t)(blk * 128 + n) * 1024 + k0 + kg * RPT;
        float v[RPT];
#pragma unroll
        for (int i = 0; i < RPT; ++i) v[i] = acc[i] * cs * gain[k0 + kg * RPT + i];
#pragma unroll
        for (int i = 0; i < RPT; i += 4) *(u32x2*)(dst + i) = (u32x2){cvtpk(v[i], v[i + 1]), cvtpk(v[i + 2], v[i + 3])};
        __syncthreads();
    }
}

__device__ __forceinline__ void phase_prep(const Ctx& C) {
    const Params& P = *C.p; unsigned char* ws = P.ws; const int tid = C.tid, lane = C.lane;
    bf16_t* WinT = (bf16_t*)(ws + WS_WIN); bf16_t* WoT = (bf16_t*)(ws + WS_WO); bf16_t* WsT = (bf16_t*)(ws + WS_WS); bf16_t* WgT = (bf16_t*)(ws + WS_WG); bf16_t* WpT = (bf16_t*)(ws + WS_WP);
    fold_items<16, true>(C);
    {
        LAS float* scr = (LAS float*)(C.lds + C.wave * 8448);
        const int gw = C.vcu * 8 + C.wave, NGW = C.G * 8;
        constexpr int I1 = 16 * 48, I2 = 16 * 32, I3 = 16 * 32, I4 = 4 * 32;
        for (int it = gw; it < I1 + I2 + I3 + I4; it += NGW) {
            int r = it;
            if (r < I1) { transpose_item(P.in[I_WIN], 2048, 512, P.in[I_LNMIX], WinT, 1024, 512, 48, scr, r, lane); continue; } r -= I1;
            if (r < I2) { transpose_item(P.in[I_WO], 1024, 0, nullptr, WoT, 1024, 0, 32, scr, r, lane); continue; } r -= I2;
            if (r < I3) { transpose_item(P.in[I_WG], 1024, 0, P.in[I_LNPE], WgT, 1024, 0, 32, scr, r, lane); continue; } r -= I3;
            transpose_item(P.in[I_WPP], 1024, 0, nullptr, WpT, 256, 0, 32, scr, r, lane);
        }
        bf16_t* XB = (bf16_t*)(ws + WS_ACTB);
        for (int m0 = gw; m0 < M_TOK; m0 += 4 * NGW) {
            f32x4 v[4][4]; float s[4];
#pragma unroll
            for (int q = 0; q < 4; ++q) { const int m = m0 + q * NGW; const f32x4* xr = (const f32x4*)(P.in[I_X] + (size_t)(m < M_TOK ? m : m0) * DM) + lane;
#pragma unroll
                for (int j = 0; j < 4; ++j) v[q][j] = xr[64 * j]; }
#pragma unroll
            for (int q = 0; q < 4; ++q) { s[q] = 0.f;
#pragma unroll
                for (int j = 0; j < 4; ++j) s[q] += (v[q][j][0] * v[q][j][0] + v[q][j][1] * v[q][j][1]) + (v[q][j][2] * v[q][j][2] + v[q][j][3] * v[q][j][3]); }
#pragma unroll
            for (int q = 0; q < 4; ++q) { const int m = m0 + q * NGW; if (m >= M_TOK) break;
                const float ri = rsqrtf(wave_sum(s[q]) * (1.0f / DM) + EPS);
                u32x2* o = (u32x2*)(XB + (size_t)m * DM) + lane;
#pragma unroll
                for (int j = 0; j < 4; ++j) { u32x2 w; w.x = cvtpk(v[q][j][0] * ri, v[q][j][1] * ri); w.y = cvtpk(v[q][j][2] * ri, v[q][j][3] * ri); o[64 * j] = w; } }
        }
    }
    {
        const size_t gt = (size_t)C.vcu * 512 + tid, NT = (size_t)C.G * 512;
        { const float* s = P.in[I_P]; bf16_t* d = (bf16_t*)(ws + WS_PB); const size_t n = (size_t)M_TOK * DPLE / 8;
          for (size_t i0 = gt; i0 < n; i0 += 4 * NT) { f32x4 v0[4], v1[4];
#pragma unroll
              for (int q = 0; q < 4; ++q) { const size_t i = i0 + q * NT < n ? i0 + q * NT : i0; v0[q] = *(const f32x4*)(s + i * 8); v1[q] = *(const f32x4*)(s + i * 8 + 4); }
#pragma unroll
              for (int q = 0; q < 4; ++q) { const size_t i = i0 + q * NT; if (i >= n) break;
                  u32x4 w; w.x = cvtpk(v0[q][0], v0[q][1]); w.y = cvtpk(v0[q][2], v0[q][3]); w.z = cvtpk(v1[q][0], v1[q][1]); w.w = cvtpk(v1[q][2], v1[q][3]); *(u32x4*)(d + i * 8) = w; } } }
        { const float* s = P.in[I_PV]; unsigned char* d = ws + WS_UT; const size_t n = (size_t)16384 * 1024 / 16;
          for (size_t i0 = gt; i0 < n; i0 += 2 * NT) { f32x4 v[2][4];
#pragma unroll
              for (int q = 0; q < 2; ++q) { const size_t i = i0 + q * NT < n ? i0 + q * NT : i0;
#pragma unroll
                  for (int c = 0; c < 4; ++c) v[q][c] = *(const f32x4*)(s + i * 16 + 4 * c) * V4SCALE; }
#pragma unroll
              for (int q = 0; q < 2; ++q) { const size_t i = i0 + q * NT; if (i >= n) break; u32x2 o;
#pragma unroll
                  for (int c = 0; c < 2; ++c) { unsigned w = 0;
                      w = __builtin_amdgcn_cvt_scalef32_pk_fp4_f32(w, v[q][2 * c][0], v[q][2 * c][1], 1.0f, 0); w = __builtin_amdgcn_cvt_scalef32_pk_fp4_f32(w, v[q][2 * c][2], v[q][2 * c][3], 1.0f, 1);
                      w = __builtin_amdgcn_cvt_scalef32_pk_fp4_f32(w, v[q][2 * c + 1][0], v[q][2 * c + 1][1], 1.0f, 2); w = __builtin_amdgcn_cvt_scalef32_pk_fp4_f32(w, v[q][2 * c + 1][2], v[q][2 * c + 1][3], 1.0f, 3); o[c] = w; }
                  *(u32x2*)(d + (i >> 6) * 1024 + 512 + (i & 63) * 8) = o; } } }
        { const int* pos = (const int*)P.in[I_POS]; unsigned* cst = (unsigned*)(ws + WS_CST);
          for (size_t i = gt; i < (size_t)M_TOK * 4; i += NT) { const int m = (int)(i >> 2), a = (int)(i & 3); const float fp = (float)pos[m]; unsigned w[8];
#pragma unroll
              for (int t = 0; t < 8; ++t) { const float invf = exp2f(-(float)(2 * (8 * a + t)) * (13.287712379549449f / 64.0f)); float tr = fp * invf * 0.15915494309189535f; tr = tr - floorf(tr);
                  const pg8::hf2 cs = {(_Float16)__builtin_amdgcn_cosf(tr), (_Float16)__builtin_amdgcn_sinf(tr)}; w[t] = __builtin_bit_cast(unsigned, cs); }
              *(u32x4*)(cst + i * 8) = (u32x4){w[0], w[1], w[2], w[3]}; *(u32x4*)(cst + i * 8 + 4) = (u32x4){w[4], w[5], w[6], w[7]}; } }
        { const float* s = P.in[I_PU]; unsigned char* d = ws + WS_UT; const size_t n = (size_t)16384 * 1024 / 16; const float* gn = P.in[I_LNFFN];
          for (size_t i0 = gt; i0 < n; i0 += 2 * NT) { f32x4 v[2][4];
#pragma unroll
              for (int q = 0; q < 2; ++q) { const size_t i = i0 + q * NT < n ? i0 + q * NT : i0;
#pragma unroll
                  for (int c = 0; c < 4; ++c) v[q][c] = *(const f32x4*)(s + i * 16 + 4 * c) * *(const f32x4*)(gn + (i & 63) * 16 + 4 * c) * U4SCALE; }
#pragma unroll
              for (int q = 0; q < 2; ++q) { const size_t i = i0 + q * NT; if (i >= n) break; u32x2 o;
#pragma unroll
                  for (int c = 0; c < 2; ++c) { unsigned w = 0;
                      w = __builtin_amdgcn_cvt_scalef32_pk_fp4_f32(w, v[q][2 * c][0], v[q][2 * c][1], 1.0f, 0); w = __builtin_amdgcn_cvt_scalef32_pk_fp4_f32(w, v[q][2 * c][2], v[q][2 * c][3], 1.0f, 1);
                      w = __builtin_amdgcn_cvt_scalef32_pk_fp4_f32(w, v[q][2 * c + 1][0], v[q][2 * c + 1][1], 1.0f, 2); w = __builtin_amdgcn_cvt_scalef32_pk_fp4_f32(w, v[q][2 * c + 1][2], v[q][2 * c + 1][3], 1.0f, 3); o[c] = w; }
                  *(u32x2*)(d + (i >> 6) * 1024 + (i & 63) * 8) = o; } } }
    }
}

__device__ __forceinline__ void phase_rope_pool(const Ctx& C) {
    fold_items<64, false>(C);
    const Params& P = *C.p; unsigned char* ws = P.ws; const int lane = C.lane;
    bf16_t* Z = (bf16_t*)(ws + WS_Z); bf16_t* Y = (bf16_t*)(ws + WS_YCAT);
    const int gw = C.vcu * 8 + C.wave, NGW = C.G * 8;
    constexpr int RP_ROWS = 16;
    const int w = 2 << (lane >> 4);
    for (int mb = gw * RP_ROWS; mb < M_TOK; mb += NGW * RP_ROWS) {
        const int s0 = mb & (SEQ - 1);
        const bf16_t* zp0 = Z + (size_t)mb * ZLD + 8 * lane;
        float acc[8];
#pragma unroll
        for (int i = 0; i < 8; ++i) acc[i] = 0.f;
        { u32x4 pv[15];
#pragma unroll
          for (int i = 1; i < 16; ++i) pv[i - 1] = (i < w && s0 - i >= 0) ? *(const u32x4*)(zp0 - (size_t)i * ZLD) : (u32x4){0u, 0u, 0u, 0u};
#pragma unroll
          for (int i = 0; i < 15; ++i) { acc[0] += bflo(pv[i].x); acc[1] += bfhi(pv[i].x); acc[2] += bflo(pv[i].y); acc[3] += bfhi(pv[i].y); acc[4] += bflo(pv[i].z); acc[5] += bfhi(pv[i].z); acc[6] += bflo(pv[i].w); acc[7] += bfhi(pv[i].w); } }
#pragma unroll 1
        for (int r4 = 0; r4 < RP_ROWS; r4 += 4) {
            u32x4 cv[4], ov[4];
#pragma unroll
            for (int q = 0; q < 4; ++q) { const int r = r4 + q; cv[q] = *(const u32x4*)(zp0 + (size_t)r * ZLD);
                ov[q] = (s0 + r - w + 1 >= 0) ? *(const u32x4*)(zp0 + ((long)r - w + 1) * ZLD) : (u32x4){0u, 0u, 0u, 0u}; }
#pragma unroll
            for (int q = 0; q < 4; ++q) { const int r = r4 + q, s = s0 + r;
                const float c[8] = {bflo(cv[q].x), bfhi(cv[q].x), bflo(cv[q].y), bfhi(cv[q].y), bflo(cv[q].z), bfhi(cv[q].z), bflo(cv[q].w), bfhi(cv[q].w)};
                const float od[8] = {bflo(ov[q].x), bfhi(ov[q].x), bflo(ov[q].y), bfhi(ov[q].y), bflo(ov[q].z), bfhi(ov[q].z), bflo(ov[q].w), bfhi(ov[q].w)};
                const float rc = 1.0f / (float)((s + 1) < w ? (s + 1) : w);
                float ov8[8];
#pragma unroll
                for (int i = 0; i < 8; ++i) { acc[i] += c[i]; ov8[i] = acc[i] * rc - c[i]; acc[i] -= od[i]; }
                u32x4 o; o.x = cvtpk(ov8[0], ov8[1]); o.y = cvtpk(ov8[2], ov8[3]); o.z = cvtpk(ov8[4], ov8[5]); o.w = cvtpk(ov8[6], ov8[7]);
                *(u32x4*)(Y + (size_t)(mb + r) * DM + 8 * lane) = o; }
        }
    }
}

namespace att {
constexpr int SLOT = 32768, KB = 8192;
typedef short v4i16_t __attribute__((ext_vector_type(4)));
__device__ __forceinline__ int crow(int r, int hi) { return (r & 3) + 8 * (r >> 2) + 4 * hi; }
__device__ __forceinline__ s16x4 vtr(const LAS unsigned char* p) { return __builtin_bit_cast(s16x4, __builtin_amdgcn_ds_read_tr16_b64_v4i16((LAS v4i16_t*)p)); }
__device__ __forceinline__ void glds16(const void* gsrc, unsigned lds_dst) { unsigned keep;
    asm volatile("s_mov_b32 %0, m0\n\ts_mov_b32 m0, %2\n\ts_nop 0\n\tglobal_load_lds_dwordx4 %1, off\n\ts_mov_b32 m0, %0" : "=&s"(keep) : "v"(gsrc), "s"(lds_dst) : "memory"); }
__device__ __forceinline__ float swapadd(float v) { auto rr = __builtin_amdgcn_permlane32_swap(__float_as_uint(v), __float_as_uint(v), false, false); return __uint_as_float(rr[0]) + __uint_as_float(rr[1]); }
__device__ __forceinline__ float swapmax(float v) { auto rr = __builtin_amdgcn_permlane32_swap(__float_as_uint(v), __float_as_uint(v), false, false); return fmaxf(__uint_as_float(rr[0]), __uint_as_float(rr[1])); }

template <bool BOUNDED> __device__ __forceinline__ void attn_unit(int b, int h, int qb, const bf16_t* Z, bf16_t* Y, const float* subln, float lam, LAS unsigned char* lds) {
    const int tid = threadIdx.x, lane = tid & 63, r32 = lane & 31, hi = lane >> 5; const int wid = __builtin_amdgcn_readfirstlane(tid >> 6);
    const int m = wid >> 2, wq = wid & 3;
    const size_t rowbase = (size_t)b * SEQ; const int q0 = qb * 128, NT = 2 * qb + 2;
    const int qabs = q0 + wq * 32 + r32;
    bf16x8 qr[4];
    { const bf16_t* Qw = Z + (rowbase + qabs) * ZLD + 512 + h * 128 + m * 64;
#pragma unroll
      for (int d0 = 0; d0 < 4; ++d0) qr[d0] = *(const bf16x8*)(Qw + d0 * 16 + hi * 8); }
    const bf16_t* Zbh = Z + rowbase * ZLD + h * 128;
    unsigned kog[2], vog[2];
#pragma unroll
    for (int j = 0; j < 2; ++j) { const unsigned r = 8u * wid + 4u * j + (lane >> 4), cp = lane & 15;
        kog[j] = r * ZLD + 1024u + 8u * (cp ^ (r & 15u)); vog[j] = r * ZLD + 1536u + 8u * (cp ^ (((r & 3u) << 2) | ((r >> 2) & 3u))); }
    const unsigned wbase = (unsigned)wid * 2048u;
    const unsigned lds0 = (unsigned)(uintptr_t)lds;
#define ATT_DMA(t, slot) do { const bf16_t* zt_ = Zbh + (size_t)(t) * 64 * ZLD; const unsigned d_ = (unsigned)__builtin_amdgcn_readfirstlane(lds0 + (slot) + wbase); \
        glds16(zt_ + kog[0], d_); glds16(zt_ + kog[1], d_ + 1024); glds16(zt_ + vog[0], d_ + 2 * KB); glds16(zt_ + vog[1], d_ + 2 * KB + 1024); } while (0)
    f32x16 o[4];
#pragma unroll
    for (int d = 0; d < 4; ++d)
#pragma unroll
        for (int r = 0; r < 16; ++r) o[d][r] = 0.f;
    float mref = -1e30f, lsum = 0.f;
    int koffs[4], voffs[4][2];
#pragma unroll
    for (int d0 = 0; d0 < 4; ++d0) koffs[d0] = r32 * 256 + (((m * 8 + 2 * d0 + hi) ^ (r32 & 15)) * 16);
    { const int L2 = (lane >> 2) & 3, a = (lane >> 4) & 1, bb = (lane & 3) >> 1;
#pragma unroll
      for (int d = 0; d < 4; ++d)
#pragma unroll
          for (int h2 = 0; h2 < 2; ++h2) voffs[d][h2] = 2 * KB + 256 * (8 * h2 + 4 * hi + L2) + 16 * ((((d ^ L2) & 3) << 2) | (((2 * a + bb) ^ (2 * h2 + hi)) & 3)) + 8 * (lane & 1); }
    ATT_DMA(0, 0); ATT_DMA(1, SLOT);
    asm volatile("s_waitcnt vmcnt(4)" ::: "memory");
    __syncthreads();
    int slot = 0, slot2 = 2 * SLOT;
    for (int t = 0; t < NT; ++t) {
        if (t + 2 < NT) ATT_DMA(t + 2, slot2);
        const bool band = t >= NT - 2;
        bf16x8 kf[8];
        { const LAS unsigned char* kb = lds + slot;
#pragma unroll
          for (int d0 = 0; d0 < 4; ++d0) { kf[2 * d0] = *(const LAS bf16x8*)(kb + koffs[d0]); kf[2 * d0 + 1] = *(const LAS bf16x8*)(kb + koffs[d0] + 8192); } }
        __builtin_amdgcn_sched_barrier(0);
        f32x16 p0, p1;
#pragma unroll
        for (int r = 0; r < 16; ++r) { p0[r] = 0.f; p1[r] = 0.f; }
#pragma unroll
        for (int d0 = 0; d0 < 4; ++d0) { p0 = __builtin_amdgcn_mfma_f32_32x32x16_bf16(kf[2 * d0], qr[d0], p0, 0, 0, 0); p1 = __builtin_amdgcn_mfma_f32_32x32x16_bf16(kf[2 * d0 + 1], qr[d0], p1, 0, 0, 0); }
        const LAS unsigned char* vb = lds + slot;
        s16x4 loA[8], hhA[8], loB[8], hhB[8];
#pragma unroll
        for (int i = 0; i < 8; ++i) { const int d = (i >> 2), ks = i & 3; loA[i] = vtr(vb + voffs[d][0] + ks * 4096); hhA[i] = vtr(vb + voffs[d][1] + ks * 4096); }
        __builtin_amdgcn_sched_barrier(0);
        if (band) {
            const int kb0 = 64 * t + 4 * hi;
#pragma unroll
            for (int r = 0; r < 16; ++r) { const int kv = kb0 + (r & 3) + 8 * (r >> 2); if (kv > qabs) p0[r] = -INFINITY; if (kv + 32 > qabs) p1[r] = -INFINITY; }
        }
        float ls = 0.f;
        if constexpr (BOUNDED) {
#pragma unroll
            for (int r = 0; r < 16; ++r) { p0[r] = __builtin_amdgcn_exp2f(p0[r]); p1[r] = __builtin_amdgcn_exp2f(p1[r]); ls += p0[r] + p1[r]; }
        } else {
            float rm = fmaxf(p0[0], p1[0]);
#pragma unroll
            for (int r = 1; r < 16; ++r) rm = fmaxf(rm, fmaxf(p0[r], p1[r]));
            rm = swapmax(rm);
            if (__any(rm - mref > 8.0f)) {
                const float mn = fmaxf(mref, rm), al = exp2f(mref - mn);
                mref = mn; lsum *= al;
#pragma unroll
                for (int d = 0; d < 4; ++d)
#pragma unroll
                    for (int r = 0; r < 16; ++r) o[d][r] *= al;
            }
#pragma unroll
            for (int r = 0; r < 16; ++r) { p0[r] = __builtin_amdgcn_exp2f(p0[r] - mref); p1[r] = __builtin_amdgcn_exp2f(p1[r] - mref); ls += p0[r] + p1[r]; }
        }
        lsum += ls;
        u32x4 pw[4];
        pw[0] = (u32x4){cvtpk(p0[0], p0[1]), cvtpk(p0[2], p0[3]), cvtpk(p0[4], p0[5]), cvtpk(p0[6], p0[7])};
        pw[1] = (u32x4){cvtpk(p0[8], p0[9]), cvtpk(p0[10], p0[11]), cvtpk(p0[12], p0[13]), cvtpk(p0[14], p0[15])};
        pw[2] = (u32x4){cvtpk(p1[0], p1[1]), cvtpk(p1[2], p1[3]), cvtpk(p1[4], p1[5]), cvtpk(p1[6], p1[7])};
        pw[3] = (u32x4){cvtpk(p1[8], p1[9]), cvtpk(p1[10], p1[11]), cvtpk(p1[12], p1[13]), cvtpk(p1[14], p1[15])};
        __builtin_amdgcn_sched_barrier(0);
#pragma unroll
        for (int i = 0; i < 8; ++i) { const int d = 2 + (i >> 2), ks = i & 3; loB[i] = vtr(vb + voffs[d][0] + ks * 4096); hhB[i] = vtr(vb + voffs[d][1] + ks * 4096); }
        __builtin_amdgcn_sched_barrier(0);
#pragma unroll
        for (int i = 0; i < 8; ++i) { const int d = (i >> 2), ks = i & 3;
            const bf16x8 vf = {loA[i][0], loA[i][1], loA[i][2], loA[i][3], hhA[i][0], hhA[i][1], hhA[i][2], hhA[i][3]};
            o[d] = __builtin_amdgcn_mfma_f32_32x32x16_bf16(vf, __builtin_bit_cast(bf16x8, pw[ks]), o[d], 0, 0, 0); }
#pragma unroll
        for (int i = 0; i < 8; ++i) { const int d = 2 + (i >> 2), ks = i & 3;
            const bf16x8 vf = {loB[i][0], loB[i][1], loB[i][2], loB[i][3], hhB[i][0], hhB[i][1], hhB[i][2], hhB[i][3]};
            o[d] = __builtin_amdgcn_mfma_f32_32x32x16_bf16(vf, __builtin_bit_cast(bf16x8, pw[ks]), o[d], 0, 0, 0); }
        if (t + 2 < NT) asm volatile("s_waitcnt vmcnt(4)" ::: "memory"); else asm volatile("s_waitcnt vmcnt(0)" ::: "memory");
        __syncthreads();
        slot2 = slot; slot = (slot == 2 * SLOT) ? 0 : slot + SLOT;
    }
#undef ATT_DMA
    const float inv = 1.0f / swapadd(lsum);
    LAS float* xch = (LAS float*)(lds + wq * 16384);
    if (m == 1) {
        const float sc = inv * lam;
#pragma unroll
        for (int d = 0; d < 4; ++d)
#pragma unroll
            for (int r = 0; r < 16; ++r) xch[(d * 16 + r) * 64 + lane] = o[d][r] * sc;
    }
    __syncthreads();
    if (m == 0) {
        float ss = 0.f;
#pragma unroll
        for (int d = 0; d < 4; ++d)
#pragma unroll
            for (int r = 0; r < 16; ++r) { const float v = o[d][r] * inv - xch[(d * 16 + r) * 64 + lane]; o[d][r] = v; ss += v * v; }
        ss = swapadd(ss);
        const float rn = rsqrtf(ss * (1.0f / 128.0f) + EPS) * 0.8f;
        bf16_t* yp = Y + (rowbase + qabs) * DM + 512 + h * 128;
#pragma unroll
        for (int d = 0; d < 4; ++d)
#pragma unroll
            for (int rq = 0; rq < 4; ++rq) { const int dc = 32 * d + 8 * rq + 4 * hi; const f32x4 g = *(const f32x4*)(subln + dc);
                u32x2 w; w.x = cvtpk(o[d][4 * rq] * rn * g[0], o[d][4 * rq + 1] * rn * g[1]); w.y = cvtpk(o[d][4 * rq + 2] * rn * g[2], o[d][4 * rq + 3] * rn * g[3]);
                *(u32x2*)(yp + dc) = w; }
    }
    __syncthreads();
}

__device__ __forceinline__ void attn_unit_pipe(int b, int h, int qb, const bf16_t* Z, bf16_t* Y, const float* subln, float lam, LAS unsigned char* lds) {
    int tid = threadIdx.x; asm volatile("" : "+v"(tid));
    const int lane = tid & 63, r32 = lane & 31, hi = lane >> 5; const int wid = __builtin_amdgcn_readfirstlane(tid >> 6);
    const int m = wid >> 2, wq = wid & 3;
    const size_t rowbase = (size_t)b * SEQ; const int q0 = qb * 128, NT = 2 * qb + 2;
    const int qabs = q0 + wq * 32 + r32;
    bf16x8 qr[4];
    { const bf16_t* Qw = Z + (rowbase + qabs) * ZLD + 512 + h * 128 + m * 64;
#pragma unroll
      for (int d0 = 0; d0 < 4; ++d0) qr[d0] = *(const bf16x8*)(Qw + d0 * 16 + hi * 8); }
    const bf16_t* Zbh = Z + rowbase * ZLD + h * 128;
    unsigned kog[2], vog[2];
#pragma unroll
    for (int j = 0; j < 2; ++j) { const unsigned r = 8u * wid + 4u * j + (lane >> 4), cp = lane & 15;
        kog[j] = r * ZLD + 1024u + 8u * (cp ^ (r & 15u)); vog[j] = r * ZLD + 1536u + 8u * (cp ^ (((r & 3u) << 2) | ((r >> 2) & 3u))); }
    const unsigned wbase = (unsigned)wid * 2048u;
    const unsigned lds0 = (unsigned)(uintptr_t)lds;
#define ATP_DMA(t) do { const bf16_t* zt_ = Zbh + (size_t)(t) * 64 * ZLD; const unsigned d_ = (unsigned)__builtin_amdgcn_readfirstlane(lds0 + ((t) & 3) * SLOT + wbase); \
        glds16(zt_ + kog[0], d_); glds16(zt_ + kog[1], d_ + 1024); glds16(zt_ + vog[0], d_ + 2 * KB); glds16(zt_ + vog[1], d_ + 2 * KB + 1024); } while (0)
    f32x16 o[4];
#pragma unroll
    for (int d = 0; d < 4; ++d)
#pragma unroll
        for (int r = 0; r < 16; ++r) o[d][r] = 0.f;
    float lsum = 0.f;
    const int kbase = r32 * 256 + (((m * 8 + hi) ^ (r32 & 15)) * 16);
    int vbase[2];
    { const int L2 = (lane >> 2) & 3, a = (lane >> 4) & 1, bb = (lane & 3) >> 1;
#pragma unroll
      for (int h2 = 0; h2 < 2; ++h2) vbase[h2] = 2 * KB + 256 * (8 * h2 + 4 * hi + L2) + 16 * ((L2 << 2) | (((2 * a + bb) ^ (2 * h2 + hi)) & 3)) + 8 * (lane & 1); }
#define ATP_PIN(x) asm volatile("" : "+v"(x))
#define ATP_SB() __builtin_amdgcn_sched_barrier(0)
#define ATP_MASK(C0, C1, t) do { if ((t) >= NT - 2) { const int kb0_ = 64 * (t) + 4 * hi; \
        _Pragma("unroll") for (int r = 0; r < 16; ++r) { const int kv = kb0_ + (r & 3) + 8 * (r >> 2); if (kv > qabs) C0[r] = -INFINITY; if (kv + 32 > qabs) C1[r] = -INFINITY; } } } while (0)
#define ATP_KLOAD(t) do { const LAS unsigned char* kb_ = lds + ((t) & 3) * SLOT; \
        _Pragma("unroll") for (int d0 = 0; d0 < 4; ++d0) { kf[2 * d0] = *(const LAS bf16x8*)(kb_ + (kbase ^ (32 * d0))); kf[2 * d0 + 1] = *(const LAS bf16x8*)(kb_ + (kbase ^ (32 * d0)) + 8192); } } while (0)
#define ATP_VLOAD(vf, vb, d) do { _Pragma("unroll") for (int ks = 0; ks < 4; ++ks) { const s16x4 lo_ = vtr((vb) + (vbase[0] ^ (64 * (d))) + ks * 4096), hh_ = vtr((vb) + (vbase[1] ^ (64 * (d))) + ks * 4096); \
        vf[ks] = (bf16x8){lo_[0], lo_[1], lo_[2], lo_[3], hh_[0], hh_[1], hh_[2], hh_[3]}; } } while (0)
#define ATP_WAIT(t) do { if ((t) + 2 < NT) asm volatile("s_waitcnt vmcnt(4)" ::: "memory"); else asm volatile("s_waitcnt vmcnt(0)" ::: "memory"); __syncthreads(); } while (0)
    bf16x8 kf[8], vfA[4], vfB[4]; u32x4 pw[4];
    f32x16 pA0, pA1, pB0, pB1;
    ATP_DMA(0); ATP_DMA(1);
    asm volatile("s_waitcnt vmcnt(4)" ::: "memory");
    __syncthreads();
    if (2 < NT) ATP_DMA(2);
    ATP_KLOAD(0); ATP_SB();
#pragma unroll
    for (int r = 0; r < 16; ++r) { pA0[r] = 0.f; pA1[r] = 0.f; }
#pragma unroll
    for (int d0 = 0; d0 < 4; ++d0) { pA0 = __builtin_amdgcn_mfma_f32_32x32x16_bf16(kf[2 * d0], qr[d0], pA0, 0, 0, 0); pA1 = __builtin_amdgcn_mfma_f32_32x32x16_bf16(kf[2 * d0 + 1], qr[d0], pA1, 0, 0, 0); }
    ATP_MASK(pA0, pA1, 0);
#pragma unroll
    for (int r = 0; r < 16; ++r) { pA0[r] = __builtin_amdgcn_exp2f(pA0[r]); pA1[r] = __builtin_amdgcn_exp2f(pA1[r]); }
    ATP_WAIT(0);
#define ATP_GAPA(i, C0, C1, P0, P1) do { \
        if ((i) & 1) { C1 = __builtin_amdgcn_mfma_f32_32x32x16_bf16(kf[i], qr[(i) >> 1], C1, 0, 0, 0); ATP_PIN(C1); } else { C0 = __builtin_amdgcn_mfma_f32_32x32x16_bf16(kf[i], qr[(i) >> 1], C0, 0, 0, 0); ATP_PIN(C0); } \
        if ((i) < 4) { sacc += (P0[4 * (i)] + P0[4 * (i) + 1]) + (P0[4 * (i) + 2] + P0[4 * (i) + 3]); pw[(i) >> 1][2 * ((i) & 1)] = cvtpk(P0[4 * (i)], P0[4 * (i) + 1]); pw[(i) >> 1][2 * ((i) & 1) + 1] = cvtpk(P0[4 * (i) + 2], P0[4 * (i) + 3]); } \
        else { sacc += (P1[4 * ((i) - 4)] + P1[4 * ((i) - 4) + 1]) + (P1[4 * ((i) - 4) + 2] + P1[4 * ((i) - 4) + 3]); pw[(i) >> 1][2 * ((i) & 1)] = cvtpk(P1[4 * ((i) - 4)], P1[4 * ((i) - 4) + 1]); pw[(i) >> 1][2 * ((i) & 1) + 1] = cvtpk(P1[4 * ((i) - 4) + 2], P1[4 * ((i) - 4) + 3]); } \
        ATP_PIN(sacc); ATP_PIN(pw[(i) >> 1]); ATP_SB(); } while (0)
#define ATP_GAPB(vf, d, ks, X, e0) do { o[d] = __builtin_amdgcn_mfma_f32_32x32x16_bf16(vf[ks], __builtin_bit_cast(bf16x8, pw[ks]), o[d], 0, 0, 0); \
        X[e0] = __builtin_amdgcn_exp2f(X[e0]); X[(e0) + 1] = __builtin_amdgcn_exp2f(X[(e0) + 1]); ATP_PIN(X); ATP_SB(); } while (0)
#define ATP_STEP(C0, C1, P0, P1, t) do { \
        if ((t) + 2 < NT) ATP_DMA((t) + 2); \
        ATP_KLOAD(t); ATP_SB(); \
        const LAS unsigned char* vb_ = lds + (((t) - 1) & 3) * SLOT; \
        _Pragma("unroll") for (int r = 0; r < 16; ++r) { C0[r] = 0.f; C1[r] = 0.f; } \
        float sacc = 0.f; \
        ATP_GAPA(0, C0, C1, P0, P1); ATP_GAPA(1, C0, C1, P0, P1); ATP_GAPA(2, C0, C1, P0, P1); ATP_GAPA(3, C0, C1, P0, P1); \
        ATP_GAPA(4, C0, C1, P0, P1); ATP_GAPA(5, C0, C1, P0, P1); ATP_GAPA(6, C0, C1, P0, P1); ATP_GAPA(7, C0, C1, P0, P1); \
        lsum += sacc; \
        ATP_VLOAD(vfA, vb_, 0); ATP_VLOAD(vfB, vb_, 1); ATP_SB(); \
        ATP_MASK(C0, C1, t); ATP_SB(); \
        ATP_GAPB(vfA, 0, 0, C0, 0); ATP_GAPB(vfA, 0, 1, C0, 2); ATP_GAPB(vfA, 0, 2, C0, 4); ATP_GAPB(vfA, 0, 3, C0, 6); \
        ATP_VLOAD(vfA, vb_, 2); ATP_SB(); \
        ATP_GAPB(vfB, 1, 0, C0, 8); ATP_GAPB(vfB, 1, 1, C0, 10); ATP_GAPB(vfB, 1, 2, C0, 12); ATP_GAPB(vfB, 1, 3, C0, 14); \
        ATP_VLOAD(vfB, vb_, 3); ATP_SB(); \
        ATP_GAPB(vfA, 2, 0, C1, 0); ATP_GAPB(vfA, 2, 1, C1, 2); ATP_GAPB(vfA, 2, 2, C1, 4); ATP_GAPB(vfA, 2, 3, C1, 6); \
        ATP_GAPB(vfB, 3, 0, C1, 8); ATP_GAPB(vfB, 3, 1, C1, 10); ATP_GAPB(vfB, 3, 2, C1, 12); ATP_GAPB(vfB, 3, 3, C1, 14); \
        ATP_WAIT(t); } while (0)
    int t = 1;
    for (; t + 1 < NT; t += 2) { ATP_STEP(pB0, pB1, pA0, pA1, t); ATP_STEP(pA0, pA1, pB0, pB1, t + 1); }
    ATP_STEP(pB0, pB1, pA0, pA1, t);
    { float sacc = 0.f;
#pragma unroll
      for (int r = 0; r < 16; ++r) sacc += pB0[r] + pB1[r];
      lsum += sacc;
      pw[0] = (u32x4){cvtpk(pB0[0], pB0[1]), cvtpk(pB0[2], pB0[3]), cvtpk(pB0[4], pB0[5]), cvtpk(pB0[6], pB0[7])};
      pw[1] = (u32x4){cvtpk(pB0[8], pB0[9]), cvtpk(pB0[10], pB0[11]), cvtpk(pB0[12], pB0[13]), cvtpk(pB0[14], pB0[15])};
      pw[2] = (u32x4){cvtpk(pB1[0], pB1[1]), cvtpk(pB1[2], pB1[3]), cvtpk(pB1[4], pB1[5]), cvtpk(pB1[6], pB1[7])};
      pw[3] = (u32x4){cvtpk(pB1[8], pB1[9]), cvtpk(pB1[10], pB1[11]), cvtpk(pB1[12], pB1[13]), cvtpk(pB1[14], pB1[15])};
      const LAS unsigned char* vb_ = lds + ((NT - 1) & 3) * SLOT;
#pragma unroll
      for (int d = 0; d < 4; ++d) { ATP_VLOAD(vfA, vb_, d);
#pragma unroll
          for (int ks = 0; ks < 4; ++ks) o[d] = __builtin_amdgcn_mfma_f32_32x32x16_bf16(vfA[ks], __builtin_bit_cast(bf16x8, pw[ks]), o[d], 0, 0, 0); } }
    __syncthreads();
#undef ATP_DMA
#undef ATP_PIN
#undef ATP_SB
#undef ATP_MASK
#undef ATP_KLOAD
#undef ATP_VLOAD
#undef ATP_WAIT
#undef ATP_GAPA
#undef ATP_GAPB
#undef ATP_STEP
    const float inv = 1.0f / swapadd(lsum);
    LAS float* xch = (LAS float*)(lds + wq * 16384);
    if (m == 1) {
        const float sc = inv * lam;
#pragma unroll
        for (int d = 0; d < 4; ++d)
#pragma unroll
            for (int r = 0; r < 16; ++r) xch[(d * 16 + r) * 64 + lane] = o[d][r] * sc;
    }
    __syncthreads();
    if (m == 0) {
        float ss = 0.f;
#pragma unroll
        for (int d = 0; d < 4; ++d)
#pragma unroll
            for (int r = 0; r < 16; ++r) { const float v = o[d][r] * inv - xch[(d * 16 + r) * 64 + lane]; o[d][r] = v; ss += v * v; }
        ss = swapadd(ss);
        const float rn = rsqrtf(ss * (1.0f / 128.0f) + EPS) * 0.8f;
        bf16_t* yp = Y + (rowbase + qabs) * DM + 512 + h * 128;
#pragma unroll
        for (int d = 0; d < 4; ++d)
#pragma unroll
            for (int rq = 0; rq < 4; ++rq) { const int dc = 32 * d + 8 * rq + 4 * hi; const f32x4 g = *(const f32x4*)(subln + dc);
                u32x2 w; w.x = cvtpk(o[d][4 * rq] * rn * g[0], o[d][4 * rq + 1] * rn * g[1]); w.y = cvtpk(o[d][4 * rq + 2] * rn * g[2], o[d][4 * rq + 3] * rn * g[3]);
                *(u32x2*)(yp + dc) = w; }
    }
    __syncthreads();
}
}

__device__ __forceinline__ void phase_attn(const Ctx& C) {
    const Params& P = *C.p; unsigned char* ws = P.ws;
    const bf16_t* Z = (const bf16_t*)(ws + WS_Z); bf16_t* Y = (bf16_t*)(ws + WS_YCAT);
    const float d1 = wave_sum(P.in[I_LQ1][C.lane] * P.in[I_LK1][C.lane]), d2 = wave_sum(P.in[I_LQ2][C.lane] * P.in[I_LK2][C.lane]);
    const float lam = expf(d1) - expf(d2) + 0.2f;
    float gq = fabsf(P.in[I_QN][C.lane]), gk = fabsf(P.in[I_KN][C.lane]);
#pragma unroll
    for (int o = 1; o < 64; o <<= 1) { gq = fmaxf(gq, __shfl_xor(gq, o)); gk = fmaxf(gk, __shfl_xor(gk, o)); }
    const bool bounded = 8.0f * 1.4426950408889634f * gq * gk <= 40.0f;
#pragma unroll 1
    for (int rep = 0; rep <= PROBE_ATTN2; ++rep)
#pragma unroll 1
    for (int pi = C.vcu; pi < 512; pi += C.G) {
        const int bh = pi >> 5, s = pi & 31;
        if (bounded) {
#pragma unroll 1
            for (int u = 0; u < 2; ++u) att::attn_unit_pipe(bh >> 2, bh & 3, u ? s : 63 - s, Z, Y, P.in[I_SUBLN], lam, C.lds);
        } else {
#pragma unroll 1
            for (int u = 0; u < 2; ++u) att::attn_unit<false>(bh >> 2, bh & 3, u ? s : 63 - s, Z, Y, P.in[I_SUBLN], lam, C.lds);
        }
    }
}

__device__ __forceinline__ unsigned mono(float f) { const unsigned u = __float_as_uint(f); return (u & 0x80000000u) ? ~u : (u | 0x80000000u); }
__device__ __forceinline__ float unmono(unsigned u) { return __uint_as_float((u & 0x80000000u) ? (u & 0x7fffffffu) : ~u); }
template <class T> __device__ __forceinline__ void sort16_desc(T (&a)[16]) {
#define CE(i, j) { const T mx = a[i] > a[j] ? a[i] : a[j], mn = a[i] > a[j] ? a[j] : a[i]; a[i] = mx; a[j] = mn; }
    CE(0, 13) CE(1, 12) CE(2, 15) CE(3, 14) CE(4, 8) CE(5, 6) CE(7, 11) CE(9, 10)
    CE(0, 5) CE(1, 7) CE(2, 9) CE(3, 4) CE(6, 13) CE(8, 14) CE(10, 15) CE(11, 12)
    CE(0, 1) CE(2, 3) CE(4, 5) CE(6, 8) CE(7, 9) CE(10, 11) CE(12, 13) CE(14, 15)
    CE(0, 2) CE(1, 3) CE(4, 10) CE(5, 11) CE(6, 7) CE(8, 9) CE(12, 14) CE(13, 15)
    CE(1, 2) CE(3, 12) CE(4, 6) CE(5, 7) CE(8, 10) CE(9, 11) CE(13, 14)
    CE(1, 4) CE(2, 6) CE(5, 8) CE(7, 10) CE(9, 13) CE(11, 14)
    CE(2, 4) CE(3, 6) CE(9, 12) CE(11, 13)
    CE(3, 5) CE(6, 8) CE(7, 9) CE(10, 12)
    CE(3, 4) CE(5, 6) CE(7, 8) CE(9, 10) CE(11, 12)
    CE(6, 7) CE(8, 9)
#undef CE
}
template <class T> __device__ __forceinline__ void merge16_desc(T (&a)[16], const T (&b)[16]) {
#pragma unroll
    for (int i = 0; i < 16; ++i) a[i] = a[i] > b[15 - i] ? a[i] : b[15 - i];
#pragma unroll
    for (int j = 8; j > 0; j >>= 1)
#pragma unroll
        for (int i = 0; i < 16; ++i) { const int l = i ^ j; if (l > i) { const T mx = a[i] > a[l] ? a[i] : a[l], mn = a[i] > a[l] ? a[l] : a[i]; a[i] = mx; a[l] = mn; } }
}
__device__ __forceinline__ void top16_of_128(const _Float16* sc, unsigned (&a)[16]) {
    f16x8 n0 = *(const f16x8*)sc, n1 = *(const f16x8*)(sc + 8);
#pragma unroll 1
    for (int g = 0; g < 8; ++g) {
        const f16x8 h0 = n0, h1 = n1;
        { const int gn = g < 7 ? g + 1 : 7; n0 = *(const f16x8*)(sc + 16 * gn); n1 = *(const f16x8*)(sc + 16 * gn + 8); }
        unsigned b[16];
#pragma unroll
        for (int i = 0; i < 8; ++i) { b[i] = (mono((float)h0[i]) & ~127u) | (unsigned)(127 - (16 * g + i)); b[8 + i] = (mono((float)h1[i]) & ~127u) | (unsigned)(127 - (16 * g + 8 + i)); }
        sort16_desc(b);
        if (g == 0) {
#pragma unroll
            for (int i = 0; i < 16; ++i) a[i] = b[i];
        } else merge16_desc(a, b);
    }
}
typedef unsigned long long u64;
__device__ __forceinline__ void phase_topk(const Ctx& C) {
    const Params& P = *C.p; unsigned char* ws = P.ws;
    const _Float16* SC = (const _Float16*)(ws + WS_Z); int* EI = (int*)(ws + WS_EIDX); float* GT = (float*)(ws + WS_GATE);
    const int gt = C.vcu * 512 + C.tid, NT = C.G * 512;
    for (int it = gt; it < M_TOK * 8; it += NT) {
        const _Float16* sc = SC + (size_t)it * 256;
        unsigned a0[16], a1[16];
        top16_of_128(sc, a0); top16_of_128(sc + 128, a1);
        float v0[16], v1[16]; unsigned e0[16], e1[16];
#pragma unroll
        for (int i = 0; i < 16; ++i) { v0[i] = unmono(a0[i] & ~127u); v1[i] = unmono(a1[i] & ~127u); e0[i] = (127u - (a0[i] & 127u)) << 7; e1[i] = 127u - (a1[i] & 127u); }
#define CAND(i, j) ((((u64)mono(v0[i] + v1[j])) << 32) | (u64)(((255u - (unsigned)((i) * 16 + (j))) << 16) | e0[i] | e1[j]))
        u64 a[16], bq[16];
#pragma unroll
        for (int j = 0; j < 16; ++j) a[j] = CAND(0, j);
#pragma unroll
        for (int i = 0; i < 15; ++i) bq[i] = CAND(i + 1, 0);
        bq[15] = 0ull; merge16_desc(a, bq);
#pragma unroll
        for (int i = 0; i < 16; ++i) bq[i] = 0ull;
#pragma unroll
        for (int j = 1; j < 8; ++j) bq[j - 1] = CAND(1, j);
        merge16_desc(a, bq);
#pragma unroll
        for (int i = 0; i < 16; ++i) bq[i] = 0ull;
#pragma unroll
        for (int i = 2; i < 8; ++i) bq[i - 2] = CAND(i, 1);
        merge16_desc(a, bq);
#pragma unroll
        for (int i = 0; i < 16; ++i) bq[i] = 0ull;
        bq[0] = CAND(2, 2); bq[1] = CAND(2, 3); bq[2] = CAND(2, 4); bq[3] = CAND(3, 2); bq[4] = CAND(4, 2); bq[5] = CAND(3, 3);
        sort16_desc(bq); merge16_desc(a, bq);
#undef CAND
        float sv[16]; const float smax = unmono((unsigned)(a[0] >> 32)); float den = 0.f;
#pragma unroll
        for (int i = 0; i < 16; ++i) { sv[i] = __expf(unmono((unsigned)(a[i] >> 32)) - smax); den += sv[i]; }
        const float rd = 1.0f / den;
        int* eo = EI + (size_t)it * 16; float* go = GT + (size_t)it * 16;
#pragma unroll
        for (int q = 0; q < 4; ++q) {
            *(u32x4*)(eo + 4 * q) = (u32x4){(unsigned)a[4 * q] & 0x3fffu, (unsigned)a[4 * q + 1] & 0x3fffu, (unsigned)a[4 * q + 2] & 0x3fffu, (unsigned)a[4 * q + 3] & 0x3fffu};
            *(f32x4*)(go + 4 * q) = (f32x4){sv[4 * q] * rd, sv[4 * q + 1] * rd, sv[4 * q + 2] * rd, sv[4 * q + 3] * rd};
        }
    }
}

constexpr int GT_T = 8;
typedef _Float16 h16x2 __attribute__((ext_vector_type(2)));
typedef int v4i_t __attribute__((ext_vector_type(4)));
typedef int v8i_t __attribute__((ext_vector_type(8)));
__device__ __forceinline__ f32x4 mx4(const v4i_t a, const v4i_t b, const f32x4 c) {
    const v8i_t A = {a[0], a[1], a[2], a[3], 0, 0, 0, 0}, B = {b[0], b[1], b[2], b[3], 0, 0, 0, 0};
    return __builtin_amdgcn_mfma_scale_f32_16x16x128_f8f6f4(A, B, c, 4, 4, 0, 0x7f7f7f7f, 0, 0x7f7f7f7f);
}
__device__ __forceinline__ float gelu_erf(float a) {
    const float x = a * 0.70710678118654752f, ax = fabsf(x);
    const float t = __builtin_amdgcn_rcpf(fmaf(0.3275911f, ax, 1.0f));
    const float pl = t * fmaf(t, fmaf(t, fmaf(t, fmaf(t, 1.061405429f, -1.453152027f), 1.421413741f), -0.284496736f), 0.254829592f);
    const float er = fmaf(-pl, __builtin_amdgcn_exp2f(-1.4426950408889634f * x * x), 1.0f);
    return 0.5f * a * (1.0f + copysignf(er, x));
}
__device__ __forceinline__ unsigned pkmax16(unsigned a, unsigned b) { typedef unsigned short us2 __attribute__((ext_vector_type(2))); return __builtin_bit_cast(unsigned, __builtin_elementwise_max(__builtin_bit_cast(us2, a), __builtin_bit_cast(us2, b))); }
__device__ __forceinline__ void phase_gather(const Ctx& C, bool dry = false) {
    const Params& P = *C.p; unsigned char* ws = P.ws; const int lane = C.lane;
    bf16_t* HB = (bf16_t*)(ws + WS_ACTB); const float* rowss = (const float*)(ws + WS_CTL + WS_ROWSS2); float* rinv3 = (float*)(ws + WS_RINV3);
    bf16_t* HBW = dry ? (bf16_t*)(ws + WS_YCAT) : HB; float* R3W = dry ? (float*)(ws + WS_WIN) : rinv3;
    const auto rsT = __builtin_amdgcn_make_buffer_rsrc((void*)(ws + WS_UT), 0, 16 << 20, 0x00020000);
    const int* EI = (const int*)(ws + WS_EIDX); const float* GT = (const float*)(ws + WS_GATE);
    constexpr int WLDS = 9216;
    LAS u32x2* sl = (LAS u32x2*)(C.lds + C.wave * WLDS);
    LAS float* gl = (LAS float*)(C.lds + C.wave * WLDS + 1024);
    LAS int* el = (LAS int*)(C.lds + C.wave * WLDS + 5120);
    const unsigned lane16 = 16u * (unsigned)lane;
    const int mi = lane & 15, mg = lane >> 4;
    const bool xsel = mi < 8 && mg == (mi >> 1), nodd = lane & 1;
    for (int tok0 = (C.vcu * 8 + C.wave) * GT_T; tok0 < M_TOK; tok0 += C.G * 8 * GT_T) {
        h16x2 op[GT_T][8];
#pragma unroll
        for (int j = 0; j < GT_T; ++j) {
            const int tok = tok0 + j;
            const int e0 = EI[(size_t)tok * 128 + lane], e1 = EI[(size_t)tok * 128 + 64 + lane]; const float g0 = GT[(size_t)tok * 128 + lane], g1 = GT[(size_t)tok * 128 + 64 + lane];
            int pos0 = 0, pos1 = 0, base = 0;
#pragma unroll
            for (int b = 0; b < 16; ++b) {
                const bool q0 = (e0 >> 10) == b, q1 = (e1 >> 10) == b;
                const unsigned long long m0 = __ballot(q0), m1 = __ballot(q1);
                const int c0 = __builtin_popcountll(m0), c1 = __builtin_popcountll(m1);
                const int r0 = __builtin_amdgcn_mbcnt_hi((unsigned)(m0 >> 32), __builtin_amdgcn_mbcnt_lo((unsigned)m0, 0u));
                const int r1 = __builtin_amdgcn_mbcnt_hi((unsigned)(m1 >> 32), __builtin_amdgcn_mbcnt_lo((unsigned)m1, 0u));
                if (q0) pos0 = base + r0;
                if (q1) pos1 = base + c0 + r1;
                base += c0 + c1;
            }
            sl[pos0] = (u32x2){(unsigned)e0, __float_as_uint(g0)}; sl[pos1] = (u32x2){(unsigned)e1, __float_as_uint(g1)};
            const u32x2 a = sl[lane], b = sl[64 + lane];
            gl[j * 128 + lane] = __uint_as_float(a.y); gl[j * 128 + 64 + lane] = __uint_as_float(b.y);
            el[j * 128 + lane] = (int)a.x; el[j * 128 + 64 + lane] = (int)b.x;
        }
        v4i_t xb1[8], xb2[8]; float ascl;
        {
            const int tok = tok0 + (lane & 7); const bf16_t* hp = HB + (size_t)tok * DM + 32 * mg;
            unsigned mx = 0u;
#pragma unroll
            for (int st = 0; st < 8; ++st)
#pragma unroll
                for (int c = 0; c < 4; ++c) { const u32x4 hw = *(const u32x4*)(hp + 128 * st + 8 * c);
                    mx = pkmax16(mx, pkmax16(pkmax16(hw.x & 0x7fff7fffu, hw.y & 0x7fff7fffu), pkmax16(hw.z & 0x7fff7fffu, hw.w & 0x7fff7fffu))); }
            float am = __uint_as_float(((mx & 0xffffu) > (mx >> 16) ? (mx & 0xffffu) : (mx >> 16)) << 16);
            am = fmaxf(am, __shfl_xor(am, 16)); am = fmaxf(am, __shfl_xor(am, 32)); am = fmaxf(am, 1e-30f);
            const float sc = 6.0f / am;
            ascl = am * (1.0f / 6.0f) * rsqrtf(rowss[tok] * (1.0f / 1024.0f) + EPS) * (1.0f / U4SCALE);
#pragma unroll
            for (int st = 0; st < 8; ++st)
#pragma unroll
                for (int c = 0; c < 4; ++c) { const u32x4 hw = *(const u32x4*)(hp + 128 * ((st + lane) & 7) + 8 * c); unsigned q1 = 0u, q2 = 0u;
#define GX_BYTE(b, w) { const float x0 = bflo(w) * sc, x1 = bfhi(w) * sc; q1 = __builtin_amdgcn_cvt_scalef32_pk_fp4_f32(q1, x0, x1, 1.0f, b); \
                        const f32x2 d = __builtin_amdgcn_cvt_scalef32_pk_f32_fp4(q1, 1.0f, b); q2 = __builtin_amdgcn_cvt_scalef32_pk_fp4_f32(q2, (x0 - d[0]) * 8.0f, (x1 - d[1]) * 8.0f, 1.0f, b); }
                    GX_BYTE(0, hw.x) GX_BYTE(1, hw.y) GX_BYTE(2, hw.z) GX_BYTE(3, hw.w)
#undef GX_BYTE
                    xb1[st][c] = (int)q1; xb2[st][c] = (int)q2; }
        }
#pragma unroll
        for (int j = 0; j < GT_T; ++j)
#pragma unroll
            for (int i = 0; i < 8; ++i) op[j][i] = (h16x2){(_Float16)0.f, (_Float16)0.f};
        {
            const int ro = (mi >> 1) * 128 + (mi & 1);
            const LAS int* elp = el + ro; const LAS float* glw = gl + (lane & 7) * 128;
            unsigned rot[8];
#pragma unroll
            for (int st = 0; st < 8; ++st) rot[st] = 64u * (unsigned)((st + (mi >> 1)) & 7) + 16u * (unsigned)mg;
            int ev = elp[0];
            v4i_t a[8];
            { const unsigned vo = (unsigned)ev << 10;
#pragma unroll
              for (int st = 0; st < 8; ++st) a[st] = __builtin_bit_cast(v4i_t, __builtin_amdgcn_raw_buffer_load_b128(rsT, vo + rot[st], 0, 0)); }
#pragma unroll 1
            for (int k = 0; k < 64; ++k) {
                u32x2 w[16];
#pragma unroll
                for (int r = 0; r < 16; ++r) { const int e = __builtin_amdgcn_readlane(ev, r); w[r] = __builtin_amdgcn_raw_buffer_load_b64(rsT, (lane16 >> 1) + 512u, e << 10, 0); }
                __builtin_amdgcn_sched_barrier(0);
                f32x4 c1 = {0.f, 0.f, 0.f, 0.f}, c2 = {0.f, 0.f, 0.f, 0.f};
#pragma unroll
                for (int st = 0; st < 8; ++st) { c1 = mx4(a[st], xb1[st], c1); c2 = mx4(a[st], xb2[st], c2); }
                const float v0 = nodd ? c1[2] + 0.125f * c2[2] : c1[0] + 0.125f * c2[0], v1 = nodd ? c1[3] + 0.125f * c2[3] : c1[1] + 0.125f * c2[1];
                const f32x2 gt2 = *(const LAS f32x2*)(glw + 2 * k);
                __builtin_amdgcn_sched_barrier(0);
                { ev = elp[k < 63 ? 2 * k + 2 : 126]; const unsigned vo = (unsigned)ev << 10;
#pragma unroll
                    for (int st = 0; st < 8; ++st) a[st] = __builtin_bit_cast(v4i_t, __builtin_amdgcn_raw_buffer_load_b128(rsT, vo + rot[st], 0, 0)); }
                __builtin_amdgcn_sched_barrier(0);
                const float h0 = gelu_erf(v0 * ascl) * gt2[0] * (1.0f / V4SCALE), h1 = gelu_erf(v1 * ascl) * gt2[1] * (1.0f / V4SCALE);
                const h16x2 hh0 = {(_Float16)h0, (_Float16)h0}, hh1 = {(_Float16)h1, (_Float16)h1}; const unsigned hr0 = __builtin_bit_cast(unsigned, hh0), hr1 = __builtin_bit_cast(unsigned, hh1);
                __builtin_amdgcn_sched_barrier(0);
                unsigned scs[16];
#pragma unroll
                for (int r = 0; r < 16; ++r) scs[r] = (unsigned)__builtin_amdgcn_readlane((int)((r & 1) ? hr1 : hr0), (r >> 1) + 16 * (r >> 2));
#pragma unroll
                for (int r = 0; r < 16; ++r) { const int j = r >> 1; const h16x2 sc = __builtin_bit_cast(h16x2, scs[r]); u32x2 ww = w[r];
                    asm volatile("" : "+v"(ww));
#pragma unroll
                    for (int c = 0; c < 2; ++c) {
                        op[j][4 * c + 0] = __builtin_elementwise_fma(sc, __builtin_bit_cast(h16x2, __builtin_amdgcn_cvt_scalef32_pk_f16_fp4(ww[c], 1.0f, 0)), op[j][4 * c + 0]);
                        op[j][4 * c + 1] = __builtin_elementwise_fma(sc, __builtin_bit_cast(h16x2, __builtin_amdgcn_cvt_scalef32_pk_f16_fp4(ww[c], 1.0f, 1)), op[j][4 * c + 1]);
                        op[j][4 * c + 2] = __builtin_elementwise_fma(sc, __builtin_bit_cast(h16x2, __builtin_amdgcn_cvt_scalef32_pk_f16_fp4(ww[c], 1.0f, 2)), op[j][4 * c + 2]);
                        op[j][4 * c + 3] = __builtin_elementwise_fma(sc, __builtin_bit_cast(h16x2, __builtin_amdgcn_cvt_scalef32_pk_f16_fp4(ww[c], 1.0f, 3)), op[j][4 * c + 3]); }
                    asm volatile("" : "+v"(op[j][0]), "+v"(op[j][1]), "+v"(op[j][2]), "+v"(op[j][3]), "+v"(op[j][4]), "+v"(op[j][5]), "+v"(op[j][6]), "+v"(op[j][7])); }
                __builtin_amdgcn_sched_barrier(0);
            }
        }
#pragma unroll
        for (int j = 0; j < GT_T; ++j) {
            const int tok = tok0 + j; const bf16_t* hp0 = HB + (size_t)tok * DM + 16 * lane; f32x4 hv[4]; float ss = 0.f;
            const u32x4 hw0 = *(const u32x4*)hp0, hw1 = *(const u32x4*)(hp0 + 8);
            hv[0] = (f32x4){bflo(hw0.x), bfhi(hw0.x), bflo(hw0.y), bfhi(hw0.y)}; hv[1] = (f32x4){bflo(hw0.z), bfhi(hw0.z), bflo(hw0.w), bfhi(hw0.w)};
            hv[2] = (f32x4){bflo(hw1.x), bfhi(hw1.x), bflo(hw1.y), bfhi(hw1.y)}; hv[3] = (f32x4){bflo(hw1.z), bfhi(hw1.z), bflo(hw1.w), bfhi(hw1.w)};
#pragma unroll
            for (int i = 0; i < 4; ++i) { hv[i] = hv[i] + (f32x4){(float)op[j][2 * i].x, (float)op[j][2 * i].y, (float)op[j][2 * i + 1].x, (float)op[j][2 * i + 1].y};
                ss += (hv[i][0] * hv[i][0] + hv[i][1] * hv[i][1]) + (hv[i][2] * hv[i][2] + hv[i][3] * hv[i][3]); }
            ss = wave_sum(ss);
            bf16_t* bp = HBW + (size_t)tok * DM + 16 * lane;
            *(u32x4*)bp = (u32x4){cvtpk(hv[0][0], hv[0][1]), cvtpk(hv[0][2], hv[0][3]), cvtpk(hv[1][0], hv[1][1]), cvtpk(hv[1][2], hv[1][3])};
            *(u32x4*)(bp + 8) = (u32x4){cvtpk(hv[2][0], hv[2][1]), cvtpk(hv[2][2], hv[2][3]), cvtpk(hv[3][0], hv[3][1]), cvtpk(hv[3][2], hv[3][3])};
            if (lane == 0) R3W[tok] = rsqrtf(ss * (1.0f / 1024.0f) + EPS);
        }
    }
}

constexpr int N_PHASES = 9;
__global__ void __launch_bounds__(512, 2) mk_fwd(Params prm) {
    extern __shared__ __attribute__((aligned(16))) unsigned char lds_raw[];
    Ctx C; C.lds = (LAS unsigned char*)lds_raw; C.tid = threadIdx.x; C.lane = C.tid & 63; C.wave = __builtin_amdgcn_readfirstlane(C.tid >> 6);
    C.G = gridDim.x; { const int bx = blockIdx.x; C.vcu = (C.G % 8 == 0) ? (bx % 8) * (C.G / 8) + bx / 8 : bx; }
    C.p = &prm;
    unsigned char* ws = prm.ws;
    const int lo = prm.ph_lo, hi = prm.ph_hi;
#define IN(k) (lo <= (k) && (k) < hi)
    { volatile LAS unsigned* st = (volatile LAS unsigned*)(C.lds + LDS_BYTES - 64); if (C.tid < 2) st[C.tid] = 0u; __syncthreads(); }
    XcdBarrier xbar = xcd_barrier_post((unsigned*)(ws + WS_CTL) + 4096, (volatile LAS unsigned*)(C.lds + LDS_BYTES - 64));
#define SEAM(k) do { if (IN(k) && IN((k) + 1)) { xcd_barrier(xbar); } } while (0)
#if MK_COOP_SYNC0
    if (hi > N_PHASES) cg::this_grid().sync();
#endif
    bf16_t* ACTB = (bf16_t*)(ws + WS_ACTB); bf16_t* Z = (bf16_t*)(ws + WS_Z); bf16_t* YC = (bf16_t*)(ws + WS_YCAT); bf16_t* PPB = (bf16_t*)(ws + WS_PP);
    float* rowss2 = (float*)(ws + WS_CTL + WS_ROWSS2);
    if (IN(0)) { _Pragma("unroll 1") for (int rep = 0; rep <= PROBE_PREP; ++rep) { phase_prep(C); __syncthreads(); } }
    SEAM(0);
    if (IN(1)) for (int rep1 = 0; rep1 <= PROBE_G1; ++rep1) {
        { pg8::Gemm g{ACTB, (const bf16_t*)(ws + WS_WIN), M_TOK, 2048, 1024}; pg8::StaticOrder S; S.init(M_TOK, 2048, C.G, (int)blockIdx.x); pg8::EpiZ E{Z, ZLD, prm.in[I_QN], prm.in[I_KN], (const unsigned*)(ws + WS_CST)};
          pg8::gemm_phase<pg8::EpiZ, pg8::StaticOrder, true, true>(C.lds, g, S, E); }
        { pg8::Gemm g{(const bf16_t*)(ws + WS_PB), (const bf16_t*)(ws + WS_WP), M_TOK, 1024, 256}; pg8::StaticOrder S; S.init(M_TOK, 1024, C.G, (int)blockIdx.x); pg8::EpiStoreBf16 E{PPB, DM};
          pg8::gemm_phase<pg8::EpiStoreBf16, pg8::StaticOrder, true, true>(C.lds, g, S, E); }
    }
    SEAM(1);
    if (IN(2)) phase_rope_pool(C);
    for (int rep = 0; rep < PROBE_SYNC; ++rep) xcd_barrier(xbar);
    if (IN(3)) { _Pragma("unroll 1") for (int rep = 0; rep <= PROBE_ATTN; ++rep) phase_attn(C); }
    SEAM(3);
    if (IN(4)) { pg8::Gemm g{YC, (const bf16_t*)(ws + WS_WO), M_TOK, 1024, 1024}; pg8::StaticOrder S; S.init(M_TOK, 1024, C.G, (int)blockIdx.x); pg8::EpiWo E{prm.in[I_X], ACTB, rowss2};
        pg8::gemm_phase<pg8::EpiWo, pg8::StaticOrder, true, true>(C.lds, g, S, E); }
    SEAM(4);
    if (IN(5)) for (int rep5 = 0; rep5 <= PROBE_G5; ++rep5) { pg8::Gemm g{ACTB, (const bf16_t*)(ws + WS_WS), M_TOK, 2048, 1024}; pg8::StaticOrder S; S.init(M_TOK, 2048, C.G, (int)blockIdx.x); pg8::EpiScores E{(_Float16*)(ws + WS_Z), ZLD, rowss2};
        pg8::gemm_phase<pg8::EpiScores, pg8::StaticOrder, true, true>(C.lds, g, S, E); }
    SEAM(5);
    if (IN(6)) { _Pragma("unroll 1") for (int rep = 0; rep <= PROBE_TOPK; ++rep) phase_topk(C); }
    if (IN(6) && IN(7)) { asm volatile("s_waitcnt vmcnt(0)" ::: "memory"); __syncthreads(); } else { SEAM(6); }
    if (IN(7)) { _Pragma("unroll 1") for (int rep = 0; rep < PROBE_GATHER; ++rep) phase_gather(C, true); phase_gather(C); }
    SEAM(7);
    if (IN(8)) { pg8::Gemm g{ACTB, (const bf16_t*)(ws + WS_WG), M_TOK, 1024, 1024}; pg8::StaticOrder S; S.init(M_TOK, 1024, C.G, (int)blockIdx.x); pg8::EpiGate E{prm.out, ACTB, PPB, (const float*)(ws + WS_RINV3)};
        pg8::gemm_phase<pg8::EpiGate, pg8::StaticOrder, true, true>(C.lds, g, S, E); }
#undef IN
#undef SEAM
}

extern "C" void kernel_launch(void* const* d_in, const int* in_sizes, int n_in, void* d_out, int out_size, void* d_ws, size_t ws_size, hipStream_t stream) {
    static int grid = 0;
    if (grid == 0) {
        if (n_in != 23 || in_sizes[0] != M_TOK * DM || out_size != M_TOK * DM || ws_size < WS_END) { fprintf(stderr, "kernel_launch: unexpected shapes (n_in %d in0 %d out %d ws %zu)\n", n_in, n_in > 0 ? in_sizes[0] : -1, out_size, ws_size); grid = -1; return; }
        int dev = 0, cus = 0, per_cu = 0;
        hipGetDevice(&dev); hipDeviceGetAttribute(&cus, hipDeviceAttributeMultiprocessorCount, dev);
        hipFuncSetAttribute((const void*)mk_fwd, hipFuncAttributeMaxDynamicSharedMemorySize, LDS_BYTES);
        hipOccupancyMaxActiveBlocksPerMultiprocessor(&per_cu, (const void*)mk_fwd, 512, LDS_BYTES);
        if (per_cu < 1) { fprintf(stderr, "kernel_launch: occupancy query says %d blocks per CU\n", per_cu); per_cu = 1; }
        (void)hipGetLastError();
        grid = cus;
    }
    if (grid < 0) return;
    hipMemsetAsync((char*)d_ws + WS_CTL, 0, CTL_BYTES, stream);
    Params prm{};
    for (int i = 0; i < 23; ++i) prm.in[i] = (const float*)d_in[i];
    prm.out = (float*)d_out; prm.ws = (unsigned char*)d_ws;
#if MK_MULTI
    for (int ph = 0; ph < N_PHASES; ++ph) { prm.ph_lo = ph; prm.ph_hi = ph + 1; hipLaunchKernelGGL(mk_fwd, dim3(grid), dim3(512), LDS_BYTES, stream, prm); }
#else
    prm.ph_lo = 0; prm.ph_hi = N_PHASES;
#if MK_COOP_SYNC0
    void* args[] = {&prm};
    hipError_t e = hipLaunchCooperativeKernel((const void*)mk_fwd, dim3(grid), dim3(512), args, LDS_BYTES, stream);
    if (e != hipSuccess) fprintf(stderr, "cooperative launch failed: %s (grid %d)\n", hipGetErrorString(e), grid);
#else
    hipLaunchKernelGGL(mk_fwd, dim3(grid), dim3(512), LDS_BYTES, stream, prm);
#endif
#endif
}
```

```cpp
#include <hip/hip_runtime.h>
#include <hip/hip_cooperative_groups.h>
#include <cstdio>
#include <cstdint>
#include <cmath>
namespace cg = cooperative_groups;

#ifndef MK_COOP_SYNC0
#define MK_COOP_SYNC0 1
#endif
#ifndef MK_MULTI
#define MK_MULTI 0
#endif

#ifndef PROBE_ATTN2
#define PROBE_ATTN2 0
#endif
#ifndef PROBE_G1
#define PROBE_G1 0
#endif
#ifndef PROBE_G5
#define PROBE_G5 0
#endif
#ifndef PROBE_PREP
#define PROBE_PREP 0
#endif
#ifndef PROBE_ATTN
#define PROBE_ATTN 0
#endif
#ifndef PROBE_TOPK
#define PROBE_TOPK 0
#endif
#ifndef PROBE_GATHER
#define PROBE_GATHER 0
#endif
#ifndef PROBE_SYNC
#define PROBE_SYNC 0
#endif
#define LAS __attribute__((address_space(3)))
typedef unsigned short bf16_t;
typedef short bf16x8 __attribute__((ext_vector_type(8)));
typedef short s16x4 __attribute__((ext_vector_type(4)));
typedef float f32x4 __attribute__((ext_vector_type(4)));
typedef float f32x2 __attribute__((ext_vector_type(2)));
typedef float f32x16 __attribute__((ext_vector_type(16)));
typedef unsigned u32x4 __attribute__((ext_vector_type(4)));
typedef unsigned u32x2 __attribute__((ext_vector_type(2)));
typedef __bf16 bf16x2_t __attribute__((ext_vector_type(2)));
typedef _Float16 f16x8 __attribute__((ext_vector_type(8)));
typedef _Float16 f16x2 __attribute__((ext_vector_type(2)));

constexpr int M_TOK = 32768, DM = 1024, SEQ = 8192, NB = 4, ZLD = 2048, DPLE = 256;
constexpr float EPS = 1e-6f;
constexpr float U4SCALE = 64.0f, V4SCALE = 5.656854249f;
constexpr float QSCALE = 0.125f * 1.4426950408889634f;
constexpr size_t MiB = 1u << 20;
constexpr size_t WS_CTL = 0, CTL_BYTES = 1 * MiB;
constexpr size_t WS_ROWSS2 = 256 * 1024;
constexpr size_t WS_WIN = 1 * MiB, WS_WO = 5 * MiB, WS_WS = 7 * MiB, WS_WG = 11 * MiB, WS_WP = 13 * MiB, WS_RINV3 = 14 * MiB;
constexpr size_t WS_UT = 16 * MiB, WS_VT = 48 * MiB, WS_ACTB = 80 * MiB, WS_PB = 144 * MiB, WS_Z = 160 * MiB, WS_YCAT = 288 * MiB, WS_PP = 352 * MiB;
constexpr size_t WS_EIDX = 416 * MiB, WS_GATE = 432 * MiB, WS_CST = 448 * MiB, WS_END = 452 * MiB;
constexpr int LDS_BYTES = 147456;

__device__ __forceinline__ unsigned cvtpk(float lo, float hi) { f32x2 v = {lo, hi}; bf16x2_t b = __builtin_convertvector(v, bf16x2_t); return __builtin_bit_cast(unsigned, b); }
__device__ __forceinline__ float bflo(unsigned w) { return __uint_as_float(w << 16); }
__device__ __forceinline__ float bfhi(unsigned w) { return __uint_as_float(w & 0xffff0000u); }
__device__ __forceinline__ unsigned pack_i8(const f32x4 v) {
    int a = __float2int_rn(v[0]), b = __float2int_rn(v[1]), c = __float2int_rn(v[2]), d = __float2int_rn(v[3]);
    a = a < -127 ? -127 : (a > 127 ? 127 : a); b = b < -127 ? -127 : (b > 127 ? 127 : b); c = c < -127 ? -127 : (c > 127 ? 127 : c); d = d < -127 ? -127 : (d > 127 ? 127 : d);
    return ((unsigned)a & 0xffu) | (((unsigned)b & 0xffu) << 8) | (((unsigned)c & 0xffu) << 16) | ((unsigned)d << 24);
}
__device__ __forceinline__ unsigned pack_u4x8(const f32x4 a, const f32x4 b) {
    unsigned w = 0;
#pragma unroll
    for (int i = 0; i < 4; ++i) { int lo = __float2int_rn(a[i]), hi = __float2int_rn(b[i]); lo = lo < -8 ? -8 : (lo > 7 ? 7 : lo); hi = hi < -8 ? -8 : (hi > 7 ? 7 : hi);
        w |= ((unsigned)(lo + 8) | ((unsigned)(hi + 8) << 4)) << (8 * i); }
    return w;
}
__device__ __forceinline__ float wave_sum(float v) {
#pragma unroll
    for (int o = 1; o < 64; o <<= 1) v += __shfl_xor(v, o);
    return v;
}

namespace pg8 {
#define PG8_LAS __attribute__((address_space(3)))
constexpr int BM = 256, BK = 64, HALF = 128, HTB = HALF * BK * 2, STAGE_BYTES = 8 * HTB, NXCD = 8, WGM = 8;
__host__ __device__ __forceinline__ int lds_byte(int r, int c) { const int st = (r >> 4) * 2 + (c >> 5), rr = r & 15, cc = c & 31, ob = rr * 64 + cc * 2; return st * 1024 + (ob ^ (((ob >> 9) & 1) << 5)); }
__host__ __device__ __forceinline__ void stage_rc(int b, int& R, int& C) { const int st = b / 1024, sb = b % 1024, swz = sb ^ (((sb >> 9) & 1) << 5); R = (st >> 1) * 16 + swz / 64; C = (st & 1) * 32 + (swz % 64) / 2; }
__host__ __device__ __forceinline__ int perm32(int rho) { const int n = rho >> 4, i = rho & 15; return 8 * (i >> 2) + 4 * n + (i & 3); }
struct Unit { int pm, pn; };
struct Gemm { const bf16_t* A; const bf16_t* Bt; int M, N, K; };
struct StaticOrder {
    int nM, nN, nwg, G, c;
    __host__ __device__ void init(int M, int N, int G_, int c_) { nM = M / BM; nN = N / BM; nwg = nM * nN; G = G_; c = c_; }
    __host__ __device__ bool next(int i, Unit& u) const {
        const long L = (long)i * G + c; if (L >= nwg) return false;
        int wgid = (int)L; { const int q = nwg / NXCD, r = nwg % NXCD, xcd = wgid % NXCD, off = wgid / NXCD; wgid = (xcd < r ? xcd * (q + 1) : r * (q + 1) + (xcd - r) * q) + off; }
        const int nig = WGM * nN, gid = wgid / nig, fm = gid * WGM, gsz = (nM - fm) < WGM ? (nM - fm) : WGM;
        u.pm = fm + ((wgid % nig) % gsz); u.pn = (wgid % nig) / gsz; return true;
    }
    __device__ __forceinline__ void a_ready(const Unit&) const {}
    __device__ __forceinline__ void done(const Unit&) const {}
};
template <class Epi, class Sched, bool ALIGN_EPI = false, bool SP2 = false>
__device__ __forceinline__ void gemm_phase(PG8_LAS unsigned char* lds, const Gemm g, const Sched& S, const Epi& E) {
    int tid = threadIdx.x; asm volatile("" : "+v"(tid));
    const int wid = __builtin_amdgcn_readfirstlane(tid >> 6), lane = tid & 63, wr = wid >> 2, wc = wid & 3, fr = lane & 15, fq = lane >> 4;
    const int K = g.K, nt = K / BK;
    unsigned voffA[2], voffB[2];
#pragma unroll
    for (int i = 0; i < 2; ++i) { int R, C; stage_rc(tid * 16 + i * 8192, R, C); const int Rb = Epi::PAIRMAP ? (64 * (R >> 5) + perm32(R & 31)) : Epi::PERM ? ((R & ~31) + perm32(R & 31)) : R;
        voffA[i] = (unsigned)(R * K + C) * 2u; voffB[i] = (unsigned)(Rb * K + C) * 2u; }
    const size_t hstepB = (size_t)(Epi::PAIRMAP ? 32 : HALF) * K * 2;
    const size_t kstep = (size_t)(BK * 2);
    const size_t hstep = (size_t)HALF * K * 2;
    const size_t tstep = 2 * hstep;
    const unsigned ldsw = (unsigned)wid * 1024u;
    const int aoff = lds_byte(wr * 64 + fr, fq * 8), boff = lds_byte(wc * 32 + fr, fq * 8);
#define PG8_SA(b, h) (((b) * 2 + (h)) * HTB)
#define PG8_SB(b, h) ((4 + (b) * 2 + (h)) * HTB)
#define PG8_STAGE(bufoff, gbase, voff) do { _Pragma("unroll") for (int _i = 0; _i < 2; ++_i) \
        __builtin_amdgcn_global_load_lds((const unsigned*)((const char*)(gbase) + (voff)[_i]), (PG8_LAS unsigned*)(lds + (bufoff) + ldsw + _i * 8192), 16, 0, 0); } while (0)
#define PG8_LDA(dst, b, h) do { _Pragma("unroll") for (int m = 0; m < 4; ++m) _Pragma("unroll") for (int k = 0; k < 2; ++k) dst[m][k] = *(const PG8_LAS bf16x8*)(lds + PG8_SA(b, h) + aoff + m * 2048 + k * 1024); } while (0)
#define PG8_LDB(dst, b, h) do { _Pragma("unroll") for (int n = 0; n < 2; ++n) _Pragma("unroll") for (int k = 0; k < 2; ++k) dst[n][k] = *(const PG8_LAS bf16x8*)(lds + PG8_SB(b, h) + boff + n * 2048 + k * 1024); } while (0)
#define PG8_MMA(ai, bj, At, Bt) do { __builtin_amdgcn_s_setprio(1); _Pragma("unroll") for (int m = 0; m < 4; ++m) _Pragma("unroll") for (int n = 0; n < 2; ++n) _Pragma("unroll") for (int k = 0; k < 2; ++k) \
        acc[ai][bj][m][n] = __builtin_amdgcn_mfma_f32_16x16x32_bf16(Bt[n][k], At[m][k], acc[ai][bj][m][n], 0, 0, 0); __builtin_amdgcn_s_setprio(0); } while (0)
#define PG8_WAIT_V(n) asm volatile("s_waitcnt vmcnt(" #n ")" ::: "memory")
#define PG8_WAIT_L(n) asm volatile("s_waitcnt lgkmcnt(" #n ")" ::: "memory")
#define PG8_BAR __builtin_amdgcn_s_barrier()
#define PG8_SCHED __builtin_amdgcn_sched_barrier(0)
    Unit cur, nxt; int ui = 0;
    if (!S.next(0, cur)) return;
    f32x4 acc[2][2][4][2];
#pragma unroll
    for (int a = 0; a < 2; ++a)
#pragma unroll
        for (int b = 0; b < 2; ++b)
#pragma unroll
            for (int m = 0; m < 4; ++m)
#pragma unroll
                for (int n = 0; n < 2; ++n) acc[a][b][m][n] = (f32x4){0.f, 0.f, 0.f, 0.f};
    bf16x8 At[4][2], B0[2][2], B1[2][2];
    const char* cA = (const char*)g.A + (size_t)cur.pm * tstep; const char* cB = (const char*)g.Bt + (size_t)cur.pn * tstep;
    S.a_ready(cur);
    if constexpr (SP2) {
        PG8_STAGE(PG8_SB(0, 0), cB, voffB); PG8_STAGE(PG8_SB(0, 1), cB + hstepB, voffB); PG8_STAGE(PG8_SA(0, 0), cA, voffA); PG8_STAGE(PG8_SA(0, 1), cA + hstep, voffA);
        if (wr == 1) PG8_BAR;
        PG8_WAIT_V(2); PG8_BAR;
        PG8_STAGE(PG8_SB(1, 0), cB + kstep, voffB); PG8_STAGE(PG8_SA(1, 0), cA + kstep, voffA); PG8_STAGE(PG8_SB(1, 1), cB + hstepB + kstep, voffB);
        PG8_WAIT_V(6); PG8_BAR;
    } else {
        PG8_STAGE(PG8_SB(0, 0), cB, voffB); PG8_STAGE(PG8_SA(0, 0), cA, voffA); PG8_STAGE(PG8_SB(0, 1), cB + hstepB, voffB); PG8_STAGE(PG8_SA(0, 1), cA + hstep, voffA);
        if (wr == 1) PG8_BAR;
        PG8_WAIT_V(4); PG8_BAR;
        PG8_STAGE(PG8_SB(1, 0), cB + kstep, voffB); PG8_STAGE(PG8_SA(1, 0), cA + kstep, voffA); PG8_STAGE(PG8_SB(1, 1), cB + hstepB + kstep, voffB);
        PG8_WAIT_V(6); PG8_BAR;
    }
    for (;;) {
        const bool has_next = S.next(ui + 1, nxt);
        const char* nA = has_next ? (const char*)g.A + (size_t)nxt.pm * tstep : cA; const char* nB = has_next ? (const char*)g.Bt + (size_t)nxt.pn * tstep : cB;
#pragma unroll 1
        for (int t = 0; t < nt; t += 2) {
            const bool last = (t == nt - 2);
            const char* a1 = cA + (size_t)(t + 1) * kstep;
            const char* a2 = last ? nA : cA + (size_t)(t + 2) * kstep; const char* b2 = last ? nB : cB + (size_t)(t + 2) * kstep;
            const char* a3 = a2 + kstep; const char* b3 = b2 + kstep;
            if (last && has_next) S.a_ready(nxt);
            if constexpr (SP2) {
            PG8_LDB(B0, 0, 0); PG8_LDB(B1, 0, 1); PG8_SCHED; PG8_LDA(At, 0, 0); PG8_STAGE(PG8_SA(1, 1), a1 + hstep, voffA);
            PG8_WAIT_V(8); PG8_WAIT_L(0); PG8_BAR; PG8_MMA(0, 0, At, B0); PG8_MMA(0, 1, At, B1); PG8_BAR; PG8_SCHED;
            PG8_LDA(At, 0, 1); PG8_STAGE(PG8_SB(0, 0), b2, voffB); PG8_STAGE(PG8_SB(0, 1), b2 + hstepB, voffB); PG8_STAGE(PG8_SA(0, 0), a2, voffA);
            PG8_WAIT_V(8); PG8_WAIT_L(0); PG8_BAR; PG8_MMA(1, 0, At, B0); PG8_MMA(1, 1, At, B1); PG8_BAR; PG8_SCHED;
            PG8_LDB(B0, 1, 0); PG8_LDB(B1, 1, 1); PG8_SCHED; PG8_LDA(At, 1, 0); PG8_STAGE(PG8_SA(0, 1), a2 + hstep, voffA);
            PG8_WAIT_V(8); PG8_WAIT_L(0); PG8_BAR; PG8_MMA(0, 0, At, B0); PG8_MMA(0, 1, At, B1); PG8_BAR; PG8_SCHED;
            PG8_LDA(At, 1, 1); PG8_STAGE(PG8_SB(1, 0), b3, voffB); PG8_STAGE(PG8_SB(1, 1), b3 + hstepB, voffB); PG8_STAGE(PG8_SA(1, 0), a3, voffA);
            PG8_WAIT_V(8); PG8_WAIT_L(0); PG8_BAR; PG8_MMA(1, 0, At, B0); PG8_MMA(1, 1, At, B1); PG8_BAR; PG8_SCHED;
            } else {
            PG8_LDB(B0, 0, 0); PG8_SCHED; PG8_LDA(At, 0, 0); PG8_STAGE(PG8_SA(1, 1), a1 + hstep, voffA);
            PG8_WAIT_L(8); PG8_BAR; PG8_WAIT_L(0); PG8_MMA(0, 0, At, B0); PG8_BAR; PG8_SCHED;
            PG8_LDB(B1, 0, 1); PG8_STAGE(PG8_SB(0, 0), b2, voffB);
            PG8_BAR; PG8_WAIT_L(0); PG8_MMA(0, 1, At, B1); PG8_BAR;
            PG8_LDA(At, 0, 1); PG8_STAGE(PG8_SA(0, 0), a2, voffA);
            PG8_BAR; PG8_WAIT_L(0); PG8_MMA(1, 0, At, B0); PG8_BAR; PG8_SCHED;
            PG8_STAGE(PG8_SB(0, 1), b2 + hstepB, voffB);
            PG8_WAIT_V(6); PG8_BAR; PG8_MMA(1, 1, At, B1); PG8_BAR;
            PG8_LDB(B0, 1, 0); PG8_SCHED; PG8_LDA(At, 1, 0); PG8_STAGE(PG8_SA(0, 1), a2 + hstep, voffA);
            PG8_WAIT_L(8); PG8_BAR; PG8_WAIT_L(0); PG8_MMA(0, 0, At, B0); PG8_BAR; PG8_SCHED;
            PG8_LDB(B1, 1, 1); PG8_STAGE(PG8_SB(1, 0), b3, voffB);
            PG8_BAR; PG8_WAIT_L(0); PG8_MMA(0, 1, At, B1); PG8_BAR;
            PG8_LDA(At, 1, 1); PG8_STAGE(PG8_SA(1, 0), a3, voffA);
            PG8_BAR; PG8_WAIT_L(0); PG8_MMA(1, 0, At, B0); PG8_BAR; PG8_SCHED;
            PG8_STAGE(PG8_SB(1, 1), b3 + hstepB, voffB);
            PG8_WAIT_V(6); PG8_BAR; PG8_MMA(1, 1, At, B1); PG8_BAR;
            }
        }
        if constexpr (ALIGN_EPI) { if (wr == 0) PG8_BAR; }
        if constexpr (!Epi::AFTER_DRAIN) { E(acc, cur, wr, wc, fr, fq); S.done(cur); }
        if (!has_next) break;
#pragma unroll
        for (int a = 0; a < 2; ++a)
#pragma unroll
            for (int b = 0; b < 2; ++b)
#pragma unroll
                for (int m = 0; m < 4; ++m)
#pragma unroll
                    for (int n = 0; n < 2; ++n) acc[a][b][m][n] = (f32x4){0.f, 0.f, 0.f, 0.f};
        cur = nxt; cA = nA; cB = nB; ++ui;
        if constexpr (ALIGN_EPI) { if (wr == 1) PG8_BAR; }
    }
    PG8_WAIT_V(0);
    if constexpr (!ALIGN_EPI) { if (wr == 0) PG8_BAR; }
    PG8_BAR;
#undef PG8_SA
#undef PG8_SB
#undef PG8_STAGE
#undef PG8_LDA
#undef PG8_LDB
#undef PG8_MMA
#undef PG8_WAIT_V
#undef PG8_WAIT_L
#undef PG8_BAR
#undef PG8_SCHED
}

struct EpiStoreBf16 {
    static constexpr bool PERM = true, AFTER_DRAIN = false, PAIRMAP = false;
    bf16_t* O; int ldc;
    __device__ __forceinline__ void operator()(const f32x4 (&acc)[2][2][4][2], const Unit& u, int wr, int wc, int fr, int fq) const {
        const int row0 = u.pm * BM + wr * 64 + fr, col0 = u.pn * BM + wc * 32 + 8 * fq;
#pragma unroll
        for (int ai = 0; ai < 2; ++ai)
#pragma unroll
            for (int m = 0; m < 4; ++m) { bf16_t* rowp = O + (size_t)(row0 + ai * HALF + m * 16) * ldc + col0;
#pragma unroll
                for (int bj = 0; bj < 2; ++bj) { const f32x4 v0 = acc[ai][bj][m][0], v1 = acc[ai][bj][m][1];
                    u32x4 w; w.x = cvtpk(v0[0], v0[1]); w.y = cvtpk(v0[2], v0[3]); w.z = cvtpk(v1[0], v1[1]); w.w = cvtpk(v1[2], v1[3]);
                    *(u32x4*)(rowp + bj * HALF) = w; } }
    }
};
typedef _Float16 hf2 __attribute__((ext_vector_type(2)));
struct EpiZ {
    static constexpr bool PERM = true, AFTER_DRAIN = false, PAIRMAP = true;
    bf16_t* O; int ldc; const float* qn; const float* kn; const unsigned* cst;
    __device__ __forceinline__ void operator()(const f32x4 (&acc)[2][2][4][2], const Unit& u, int wr, int wc, int fr, int fq) const {
        asm volatile("" : "+v"(fr), "+v"(fq));
        const int row0 = u.pm * BM + wr * 64 + fr, col0 = u.pn * BM + wc * 64 + 8 * fq;
        const int kind = u.pn >> 1;
        if (kind == 0 || kind == 3) {
#pragma unroll
            for (int ai = 0; ai < 2; ++ai)
#pragma unroll
                for (int m = 0; m < 4; ++m) { bf16_t* rowp = O + (size_t)(row0 + ai * HALF + m * 16) * ldc + col0;
#pragma unroll
                    for (int bj = 0; bj < 2; ++bj) { const f32x4 v0 = acc[ai][bj][m][0], v1 = acc[ai][bj][m][1];
                        u32x4 w; w.x = cvtpk(v0[0], v0[1]); w.y = cvtpk(v0[2], v0[3]); w.z = cvtpk(v1[0], v1[1]); w.w = cvtpk(v1[2], v1[3]);
                        *(u32x4*)(rowp + bj * 32) = w; } }
            return;
        }
        const float* gn = kind == 1 ? qn : kn; const float osc = kind == 1 ? QSCALE : 1.0f;
        float g1[8], g2[8];
#pragma unroll
        for (int t = 0; t < 8; ++t) { g1[t] = gn[8 * fq + t] * osc; g2[t] = gn[32 + 8 * fq + t] * osc; }
        const unsigned* cp = cst + (size_t)row0 * 32 + 8 * fq;
        u32x4 c0 = *(const u32x4*)cp, c1 = *(const u32x4*)(cp + 4);
#pragma unroll
        for (int it = 0; it < 8; ++it) {
            const int ai = it >> 2, m = it & 3, row = row0 + ai * HALF + m * 16;
            u32x4 n0 = c0, n1 = c1;
            if (it < 7) { const unsigned* np = cp + (size_t)(((it + 1) >> 2) * HALF + ((it + 1) & 3) * 16) * 32; n0 = *(const u32x4*)np; n1 = *(const u32x4*)(np + 4); }
            const unsigned cw[8] = {c0.x, c0.y, c0.z, c0.w, c1.x, c1.y, c1.z, c1.w};
            float t1[8], t2[8];
#pragma unroll
            for (int t = 0; t < 8; ++t) { t1[t] = acc[ai][0][m][t >> 2][t & 3]; t2[t] = acc[ai][1][m][t >> 2][t & 3]; }
            float ss = 0.f;
#pragma unroll
            for (int t = 0; t < 8; ++t) ss += t1[t] * t1[t] + t2[t] * t2[t];
            ss += __shfl_xor(ss, 16); ss += __shfl_xor(ss, 32);
            const float ri = rsqrtf(ss * (1.0f / 64.0f) + EPS);
            float o1[8], o2[8];
#pragma unroll
            for (int t = 0; t < 8; ++t) {
                const hf2 cs2 = __builtin_bit_cast(hf2, cw[t]); const float cs = (float)cs2[0], sn = (float)cs2[1];
                const float x1 = t1[t] * (ri * g1[t]), x2 = t2[t] * (ri * g2[t]);
                o1[t] = x1 * cs - x2 * sn; o2[t] = x2 * cs + x1 * sn;
            }
            bf16_t* rowp = O + (size_t)row * ldc + col0;
            *(u32x4*)rowp = (u32x4){cvtpk(o1[0], o1[1]), cvtpk(o1[2], o1[3]), cvtpk(o1[4], o1[5]), cvtpk(o1[6], o1[7])};
            *(u32x4*)(rowp + 32) = (u32x4){cvtpk(o2[0], o2[1]), cvtpk(o2[2], o2[3]), cvtpk(o2[4], o2[5]), cvtpk(o2[6], o2[7])};
            __builtin_amdgcn_sched_barrier(0);
            c0 = n0; c1 = n1;
        }
    }
};
struct EpiScores {
    static constexpr bool PERM = true, AFTER_DRAIN = false, PAIRMAP = false;
    _Float16* O; int ldc; const float* rowss;
    __device__ __forceinline__ void operator()(const f32x4 (&acc)[2][2][4][2], const Unit& u, int wr, int wc, int fr, int fq) const {
        const int row0 = u.pm * BM + wr * 64 + fr, col0 = u.pn * BM + wc * 32 + 8 * fq;
#pragma unroll
        for (int ai = 0; ai < 2; ++ai)
#pragma unroll
            for (int m = 0; m < 4; ++m) { const int row = row0 + ai * HALF + m * 16; const float ri = rsqrtf(rowss[row] * (1.0f / 1024.0f) + EPS);
                _Float16* rowp = O + (size_t)row * ldc + col0;
#pragma unroll
                for (int bj = 0; bj < 2; ++bj) { const f32x4 v0 = acc[ai][bj][m][0] * ri, v1 = acc[ai][bj][m][1] * ri;
                    f16x8 w = {(_Float16)v0[0], (_Float16)v0[1], (_Float16)v0[2], (_Float16)v0[3], (_Float16)v1[0], (_Float16)v1[1], (_Float16)v1[2], (_Float16)v1[3]};
                    *(f16x8*)(rowp + bj * HALF) = w; } }
    }
};
struct EpiWo {
    static constexpr bool PERM = false, AFTER_DRAIN = false, PAIRMAP = false;
    const float* X; bf16_t* HB; float* rowss;
    __device__ __forceinline__ void operator()(const f32x4 (&acc)[2][2][4][2], const Unit& u, int wr, int wc, int fr, int fq) const {
        const int row0 = u.pm * BM + wr * 64 + fr, col0 = u.pn * BM + wc * 32 + 4 * fq;
#pragma unroll
        for (int ai = 0; ai < 2; ++ai)
#pragma unroll
            for (int m = 0; m < 4; ++m) { const int row = row0 + ai * HALF + m * 16; const size_t off = (size_t)row * DM + col0; float ss = 0.f;
#pragma unroll
                for (int bj = 0; bj < 2; ++bj)
#pragma unroll
                    for (int n = 0; n < 2; ++n) { const size_t o2 = off + bj * HALF + n * 16; const f32x4 h = *(const f32x4*)(X + o2) + acc[ai][bj][m][n];
                        u32x2 w; w.x = cvtpk(h[0], h[1]); w.y = cvtpk(h[2], h[3]); *(u32x2*)(HB + o2) = w;
                        ss += (h[0] * h[0] + h[1] * h[1]) + (h[2] * h[2] + h[3] * h[3]); }
                ss += __shfl_xor(ss, 16); ss += __shfl_xor(ss, 32);
                if (fq == 0) atomicAdd(rowss + row, ss); }
    }
};
struct EpiGate {
    static constexpr bool PERM = false, AFTER_DRAIN = false, PAIRMAP = false;
    float* HO; const bf16_t* HB; const bf16_t* PP; const float* rinv;
    __device__ __forceinline__ void operator()(const f32x4 (&acc)[2][2][4][2], const Unit& u, int wr, int wc, int fr, int fq) const {
        const int row0 = u.pm * BM + wr * 64 + fr, col0 = u.pn * BM + wc * 32 + 4 * fq;
#pragma unroll
        for (int ai = 0; ai < 2; ++ai)
#pragma unroll
            for (int m = 0; m < 4; ++m) { const int row = row0 + ai * HALF + m * 16; const size_t off = (size_t)row * DM + col0; const float ri = rinv[row];
#pragma unroll
                for (int bj = 0; bj < 2; ++bj)
#pragma unroll
                    for (int n = 0; n < 2; ++n) { const size_t o2 = off + bj * HALF + n * 16; const u32x2 hw = *(const u32x2*)(HB + o2); const f32x4 h = {bflo(hw.x), bfhi(hw.x), bflo(hw.y), bfhi(hw.y)}; const u32x2 pw = *(const u32x2*)(PP + o2);
                        const f32x4 a = acc[ai][bj][m][n] * ri; f32x4 o;
                        o[0] = h[0] + bflo(pw.x) / (1.0f + __expf(-a[0])); o[1] = h[1] + bfhi(pw.x) / (1.0f + __expf(-a[1]));
                        o[2] = h[2] + bflo(pw.y) / (1.0f + __expf(-a[2])); o[3] = h[3] + bfhi(pw.y) / (1.0f + __expf(-a[3]));
                        *(f32x4*)(HO + o2) = o; } }
    }
};
}

#define XB_TMO      128
#define XB_XCNT(j)  (256  + 64 * (j))
#define XB_XSUB(j)  (1280 + 64 * (j))
#define XB_XGEN(j)  (2304 + 64 * (j))
#define XB_TOP      3328
#define XB_TOPGEN   3392
#define XCD_BAR_WORDS 3456
#define XB_SPIN_CAP (1u << 18)
__device__ __forceinline__ unsigned xb_ld(unsigned* p)              { return __hip_atomic_load(p, __ATOMIC_RELAXED, __HIP_MEMORY_SCOPE_AGENT); }
__device__ __forceinline__ unsigned xb_add(unsigned* p, unsigned v) { return __hip_atomic_fetch_add(p, v, __ATOMIC_RELAXED, __HIP_MEMORY_SCOPE_AGENT); }
__device__ __forceinline__ unsigned xb_xcc_id() { return (unsigned)__builtin_amdgcn_s_getreg((3 << 11) | 20) & 0xFu; }
#define XB_SPIN(cond, bar) do { unsigned _sp = 0; while (cond) { __builtin_amdgcn_s_sleep(1); \
    if ((++_sp & 255u) == 0u) { if (xb_ld(&(bar)[XB_TMO])) break; if (_sp > XB_SPIN_CAP) { atomicAdd(&(bar)[XB_TMO], 1u); break; } } } } while (0)
struct XcdBarrier { unsigned* bar; unsigned x; volatile LAS unsigned* st; };
__device__ __forceinline__ XcdBarrier xcd_barrier_post(unsigned* bar, volatile LAS unsigned* st) {
    XcdBarrier b; b.bar = bar; b.x = xb_xcc_id(); b.st = st;
    if (threadIdx.x == 0) (void)xb_add(&bar[XB_XCNT(b.x)], 1u);
    return b;
}
__device__ __forceinline__ void xcd_barrier_complete(unsigned* bar, unsigned x, unsigned& nloc, unsigned& nx) {
    const unsigned G = gridDim.x * gridDim.y * gridDim.z;
    unsigned sum, cnt, mine, sp = 0u;
    for (;;) {
        sum = 0u; cnt = 0u; mine = 0u;
#pragma unroll
        for (unsigned j = 0; j < 16; ++j) { const unsigned c = xb_ld(&bar[XB_XCNT(j)]); sum += c; cnt += (c > 0u) ? 1u : 0u; mine = (j == x) ? c : mine; }
        if (sum == G) break;
        __builtin_amdgcn_s_sleep(1);
        if ((++sp & 255u) == 0u) { if (xb_ld(&bar[XB_TMO])) break; if (sp > XB_SPIN_CAP) { atomicAdd(&bar[XB_TMO], 1u); break; } }
    }
    nloc = mine > 0u ? mine : 1u; nx = cnt > 0u ? cnt : 1u;
}
__device__ __forceinline__ void xcd_barrier(const XcdBarrier& b) {
    asm volatile("s_waitcnt vmcnt(0)" ::: "memory");
    __syncthreads();
    if (threadIdx.x == 0) {
        unsigned* bar = b.bar;
        __builtin_amdgcn_s_waitcnt(0);
        unsigned nloc = b.st[0], nx = b.st[1];
        if (nloc == 0u) { xcd_barrier_complete(bar, b.x, nloc, nx); b.st[0] = nloc; b.st[1] = nx; }
        const unsigned old = xb_add(&bar[XB_XSUB(b.x)], 1u);
        const unsigned gen = old / nloc;
        if (old + 1u == (gen + 1u) * nloc) {
            __builtin_amdgcn_fence(__ATOMIC_RELEASE, "agent");
            asm volatile("s_waitcnt vmcnt(0)" ::: "memory");
            const unsigned og = xb_add(&bar[XB_TOP], 1u);
            const unsigned tg = og / nx;
            if (og + 1u == (tg + 1u) * nx) xb_add(&bar[XB_TOPGEN], 1u);
            else XB_SPIN(xb_ld(&bar[XB_TOPGEN]) == tg, bar);
            __builtin_amdgcn_fence(__ATOMIC_ACQUIRE, "agent");
            xb_add(&bar[XB_XGEN(b.x)], 1u);
            asm volatile("s_waitcnt vmcnt(0)" ::: "memory");
        } else {
            XB_SPIN(xb_ld(&bar[XB_XGEN(b.x)]) == gen, bar);
            __builtin_amdgcn_fence(__ATOMIC_ACQUIRE, "agent");
            asm volatile("s_waitcnt vmcnt(0)" ::: "memory");
        }
    }
    __syncthreads();
}

struct Params { const float* in[23]; float* out; unsigned char* ws; int ph_lo, ph_hi; };
enum { I_X = 0, I_P, I_POS, I_LNMIX, I_WIN, I_POOLW, I_POOLS, I_QN, I_KN, I_LQ1, I_LK1, I_LQ2, I_LK2, I_SUBLN, I_WO, I_LNFFN, I_WPQ, I_SUBK, I_PU, I_PV, I_LNPE, I_WG, I_WPP };

struct Ctx {
    LAS unsigned char* lds; int tid, lane, wave, G, vcu;
    const Params* p;
};

__device__ __forceinline__ void transpose_item(const float* W, int ldw, int coff, const float* gain, bf16_t* WT, int ldk, int roff, int nblk, LAS float* scr, int item, int lane) {
    const int kb = item / nblk, nb = item % nblk, k0 = 64 * kb, n0 = 32 * nb;
#pragma unroll 8
    for (int i = 0; i < 32; ++i) { const int kk = 2 * i + (lane >> 5); const float gsc = gain ? gain[k0 + kk] : 1.0f; scr[kk * 33 + (lane & 31)] = W[(size_t)(k0 + kk) * ldw + coff + n0 + (lane & 31)] * gsc; }
    asm volatile("s_waitcnt lgkmcnt(0)" ::: "memory");
    const int c = lane & 7;
#pragma unroll
    for (int j = 0; j < 4; ++j) { const int n = (lane >> 3) + 8 * j; const LAS float* s = scr + (8 * c) * 33 + n;
        u32x4 o; o.x = cvtpk(s[0 * 33], s[1 * 33]); o.y = cvtpk(s[2 * 33], s[3 * 33]); o.z = cvtpk(s[4 * 33], s[5 * 33]); o.w = cvtpk(s[6 * 33], s[7 * 33]);
        *(u32x4*)(WT + (size_t)(roff + n0 + n) * ldk + k0 + 8 * c) = o; }
    asm volatile("s_waitcnt lgkmcnt(0)" ::: "memory");
}

template <int ROWS, bool POOL> __device__ __forceinline__ void fold_items(const Ctx& C) {
    const Params& P = *C.p; unsigned char* ws = P.ws; const int tid = C.tid;
    bf16_t* WinT = (bf16_t*)(ws + WS_WIN); bf16_t* WsT = (bf16_t*)(ws + WS_WS);
    constexpr int KT = 1024 / ROWS, NIT = (POOL ? 4 : 16) * KT, RPT = ROWS / 4;
    LAS float* As = (LAS float*)C.lds;
    LAS float* Bs = (LAS float*)(C.lds + 32768);
    for (int it = blockIdx.x; it < NIT; it += C.G) {
        const int blk = it / KT, k0 = (it % KT) * ROWS;
        const float* Asrc = (POOL ? P.in[I_WIN] : P.in[I_WPQ]) + blk * 128;
        const float* Bsrc = (POOL ? P.in[I_POOLW] : P.in[I_SUBK]) + (size_t)blk * 128 * 128;
#pragma unroll
        for (int i = 0; i < ROWS / 16; ++i) { const int v = tid + 512 * i, r = v >> 5, c4 = v & 31; *(LAS f32x4*)(As + r * 128 + c4 * 4) = *(const f32x4*)(Asrc + (size_t)(k0 + r) * 2048 + c4 * 4); }
        { f32x4 bv[8];
#pragma unroll
          for (int i = 0; i < 8; ++i) bv[i] = *(const f32x4*)(Bsrc + 4 * (tid + 512 * i));
#pragma unroll
          for (int i = 0; i < 8; ++i) { const int idx = 4 * (tid + 512 * i), r = idx >> 7, c = idx & 127;
#pragma unroll
              for (int q = 0; q < 4; ++q) { if (POOL) Bs[r * 129 + c + q] = bv[i][q]; else Bs[(c + q) * 129 + r] = bv[i][q]; } } }
        __syncthreads();
        const int n = tid & 127, kg = tid >> 7;
        float acc[RPT];
#pragma unroll
        for (int i = 0; i < RPT; ++i) acc[i] = 0.f;
        for (int c = 0; c < 128; c += 4) {
            const float b0 = Bs[(c + 0) * 129 + n], b1 = Bs[(c + 1) * 129 + n], b2 = Bs[(c + 2) * 129 + n], b3 = Bs[(c + 3) * 129 + n];
#pragma unroll
            for (int i = 0; i < RPT; ++i) { const f32x4 a = *(const LAS f32x4*)(As + (kg * RPT + i) * 128 + c); acc[i] += a[0] * b0 + a[1] * b1 + a[2] * b2 + a[3] * b3; }
        }
        const float cs = POOL ? P.in[I_POOLS][blk * 128 + n] : 1.0f; const float* gain = POOL ? P.in[I_LNMIX] : P.in[I_LNFFN];
        bf16_t* dst = (POOL ? WinT : WsT) + (size_t)(blk * 128 + n) * 1024 + k0 + kg * RPT;
        float v[RPT];
#pragma unroll
        for (int i = 0; i < RPT; ++i) v[i] = acc[i] * cs * gain[k0 + kg * RPT + i];
#pragma unroll
        for (int i = 0; i < RPT; i += 4) *(u32x2*)(dst + i) = (u32x2){cvtpk(v[i], v[i + 1]), cvtpk(v[i + 2], v[i + 3])};
        __syncthreads();
    }
}

__device__ __forceinline__ void phase_prep(const Ctx& C) {
    const Params& P = *C.p; unsigned char* ws = P.ws; const int tid = C.tid, lane = C.lane;
    bf16_t* WinT = (bf16_t*)(ws + WS_WIN); bf16_t* WoT = (bf16_t*)(ws + WS_WO); bf16_t* WsT = (bf16_t*)(ws + WS_WS); bf16_t* WgT = (bf16_t*)(ws + WS_WG); bf16_t* WpT = (bf16_t*)(ws + WS_WP);
    fold_items<16, true>(C);
    {
        LAS float* scr = (LAS float*)(C.lds + C.wave * 8448);
        const int gw = C.vcu * 8 + C.wave, NGW = C.G * 8;
        constexpr int I1 = 16 * 48, I2 = 16 * 32, I3 = 16 * 32, I4 = 4 * 32;
        for (int it = gw; it < I1 + I2 + I3 + I4; it += NGW) {
            int r = it;
            if (r < I1) { transpose_item(P.in[I_WIN], 2048, 512, P.in[I_LNMIX], WinT, 1024, 512, 48, scr, r, lane); continue; } r -= I1;
            if (r < I2) { transpose_item(P.in[I_WO], 1024, 0, nullptr, WoT, 1024, 0, 32, scr, r, lane); continue; } r -= I2;
            if (r < I3) { transpose_item(P.in[I_WG], 1024, 0, P.in[I_LNPE], WgT, 1024, 0, 32, scr, r, lane); continue; } r -= I3;
            transpose_item(P.in[I_WPP], 1024, 0, nullptr, WpT, 256, 0, 32, scr, r, lane);
        }
        bf16_t* XB = (bf16_t*)(ws + WS_ACTB);
        for (int m0 = gw; m0 < M_TOK; m0 += 4 * NGW) {
            f32x4 v[4][4]; float s[4];
#pragma unroll
            for (int q = 0; q < 4; ++q) { const int m = m0 + q * NGW; const f32x4* xr = (const f32x4*)(P.in[I_X] + (size_t)(m < M_TOK ? m : m0) * DM) + lane;
#pragma unroll
                for (int j = 0; j < 4; ++j) v[q][j] = xr[64 * j]; }
#pragma unroll
            for (int q = 0; q < 4; ++q) { s[q] = 0.f;
#pragma unroll
                for (int j = 0; j < 4; ++j) s[q] += (v[q][j][0] * v[q][j][0] + v[q][j][1] * v[q][j][1]) + (v[q][j][2] * v[q][j][2] + v[q][j][3] * v[q][j][3]); }
#pragma unroll
            for (int q = 0; q < 4; ++q) { const int m = m0 + q * NGW; if (m >= M_TOK) break;
                const float ri = rsqrtf(wave_sum(s[q]) * (1.0f / DM) + EPS);
                u32x2* o = (u32x2*)(XB + (size_t)m * DM) + lane;
#pragma unroll
                for (int j = 0; j < 4; ++j) { u32x2 w; w.x = cvtpk(v[q][j][0] * ri, v[q][j][1] * ri); w.y = cvtpk(v[q][j][2] * ri, v[q][j][3] * ri); o[64 * j] = w; } }
        }
    }
    {
        const size_t gt = (size_t)C.vcu * 512 + tid, NT = (size_t)C.G * 512;
        { const float* s = P.in[I_P]; bf16_t* d = (bf16_t*)(ws + WS_PB); const size_t n = (size_t)M_TOK * DPLE / 8;
          for (size_t i0 = gt; i0 < n; i0 += 4 * NT) { f32x4 v0[4], v1[4];
#pragma unroll
              for (int q = 0; q < 4; ++q) { const size_t i = i0 + q * NT < n ? i0 + q * NT : i0; v0[q] = *(const f32x4*)(s + i * 8); v1[q] = *(const f32x4*)(s + i * 8 + 4); }
#pragma unroll
              for (int q = 0; q < 4; ++q) { const size_t i = i0 + q * NT; if (i >= n) break;
                  u32x4 w; w.x = cvtpk(v0[q][0], v0[q][1]); w.y = cvtpk(v0[q][2], v0[q][3]); w.z = cvtpk(v1[q][0], v1[q][1]); w.w = cvtpk(v1[q][2], v1[q][3]); *(u32x4*)(d + i * 8) = w; } } }
        { const float* s = P.in[I_PV]; unsigned char* d = ws + WS_UT; const size_t n = (size_t)16384 * 1024 / 16;
          for (size_t i0 = gt; i0 < n; i0 += 2 * NT) { f32x4 v[2][4];
#pragma unroll
              for (int q = 0; q < 2; ++q) { const size_t i = i0 + q * NT < n ? i0 + q * NT : i0;
#pragma unroll
                  for (int c = 0; c < 4; ++c) v[q][c] = *(const f32x4*)(s + i * 16 + 4 * c) * V4SCALE; }
#pragma unroll
              for (int q = 0; q < 2; ++q) { const size_t i = i0 + q * NT; if (i >= n) break; u32x2 o;
#pragma unroll
                  for (int c = 0; c < 2; ++c) { unsigned w = 0;
                      w = __builtin_amdgcn_cvt_scalef32_pk_fp4_f32(w, v[q][2 * c][0], v[q][2 * c][1], 1.0f, 0); w = __builtin_amdgcn_cvt_scalef32_pk_fp4_f32(w, v[q][2 * c][2], v[q][2 * c][3], 1.0f, 1);
                      w = __builtin_amdgcn_cvt_scalef32_pk_fp4_f32(w, v[q][2 * c + 1][0], v[q][2 * c + 1][1], 1.0f, 2); w = __builtin_amdgcn_cvt_scalef32_pk_fp4_f32(w, v[q][2 * c + 1][2], v[q][2 * c + 1][3], 1.0f, 3); o[c] = w; }
                  *(u32x2*)(d + (i >> 6) * 1024 + 512 + (i & 63) * 8) = o; } } }
        { const int* pos = (const int*)P.in[I_POS]; unsigned* cst = (unsigned*)(ws + WS_CST);
          for (size_t i = gt; i < (size_t)M_TOK * 4; i += NT) { const int m = (int)(i >> 2), a = (int)(i & 3); const float fp = (float)pos[m]; unsigned w[8];
#pragma unroll
              for (int t = 0; t < 8; ++t) { const float invf = exp2f(-(float)(2 * (8 * a + t)) * (13.287712379549449f / 64.0f)); float tr = fp * invf * 0.15915494309189535f; tr = tr - floorf(tr);
                  const pg8::hf2 cs = {(_Float16)__builtin_amdgcn_cosf(tr), (_Float16)__builtin_amdgcn_sinf(tr)}; w[t] = __builtin_bit_cast(unsigned, cs); }
              *(u32x4*)(cst + i * 8) = (u32x4){w[0], w[1], w[2], w[3]}; *(u32x4*)(cst + i * 8 + 4) = (u32x4){w[4], w[5], w[6], w[7]}; } }
        { const float* s = P.in[I_PU]; unsigned char* d = ws + WS_UT; const size_t n = (size_t)16384 * 1024 / 16; const float* gn = P.in[I_LNFFN];
          for (size_t i0 = gt; i0 < n; i0 += 2 * NT) { f32x4 v[2][4];
#pragma unroll
              for (int q = 0; q < 2; ++q) { const size_t i = i0 + q * NT < n ? i0 + q * NT : i0;
#pragma unroll
                  for (int c = 0; c < 4; ++c) v[q][c] = *(const f32x4*)(s + i * 16 + 4 * c) * *(const f32x4*)(gn + (i & 63) * 16 + 4 * c) * U4SCALE; }
#pragma unroll
              for (int q = 0; q < 2; ++q) { const size_t i = i0 + q * NT; if (i >= n) break; u32x2 o;
#pragma unroll
                  for (int c = 0; c < 2; ++c) { unsigned w = 0;
                      w = __builtin_amdgcn_cvt_scalef32_pk_fp4_f32(w, v[q][2 * c][0], v[q][2 * c][1], 1.0f, 0); w = __builtin_amdgcn_cvt_scalef32_pk_fp4_f32(w, v[q][2 * c][2], v[q][2 * c][3], 1.0f, 1);
                      w = __builtin_amdgcn_cvt_scalef32_pk_fp4_f32(w, v[q][2 * c + 1][0], v[q][2 * c + 1][1], 1.0f, 2); w = __builtin_amdgcn_cvt_scalef32_pk_fp4_f32(w, v[q][2 * c + 1][2], v[q][2 * c + 1][3], 1.0f, 3); o[c] = w; }
                  *(u32x2*)(d + (i >> 6) * 1024 + (i & 63) * 8) = o; } } }
    }
}

__device__ __forceinline__ void phase_rope_pool(const Ctx& C) {
    fold_items<64, false>(C);
    const Params& P = *C.p; unsigned char* ws = P.ws; const int lane = C.lane;
    bf16_t* Z = (bf16_t*)(ws + WS_Z); bf16_t* Y = (bf16_t*)(ws + WS_YCAT);
    const int gw = C.vcu * 8 + C.wave, NGW = C.G * 8;
    constexpr int RP_ROWS = 16;
    const int w = 2 << (lane >> 4);
    for (int mb = gw * RP_ROWS; mb < M_TOK; mb += NGW * RP_ROWS) {
        const int s0 = mb & (SEQ - 1);
        const bf16_t* zp0 = Z + (size_t)mb * ZLD + 8 * lane;
        float acc[8];
#pragma unroll
        for (int i = 0; i < 8; ++i) acc[i] = 0.f;
        { u32x4 pv[15];
#pragma unroll
          for (int i = 1; i < 16; ++i) pv[i - 1] = (i < w && s0 - i >= 0) ? *(const u32x4*)(zp0 - (size_t)i * ZLD) : (u32x4){0u, 0u, 0u, 0u};
#pragma unroll
          for (int i = 0; i < 15; ++i) { acc[0] += bflo(pv[i].x); acc[1] += bfhi(pv[i].x); acc[2] += bflo(pv[i].y); acc[3] += bfhi(pv[i].y); acc[4] += bflo(pv[i].z); acc[5] += bfhi(pv[i].z); acc[6] += bflo(pv[i].w); acc[7] += bfhi(pv[i].w); } }
#pragma unroll 1
        for (int r4 = 0; r4 < RP_ROWS; r4 += 4) {
            u32x4 cv[4], ov[4];
#pragma unroll
            for (int q = 0; q < 4; ++q) { const int r = r4 + q; cv[q] = *(const u32x4*)(zp0 + (size_t)r * ZLD);
                ov[q] = (s0 + r - w + 1 >= 0) ? *(const u32x4*)(zp0 + ((long)r - w + 1) * ZLD) : (u32x4){0u, 0u, 0u, 0u}; }
#pragma unroll
            for (int q = 0; q < 4; ++q) { const int r = r4 + q, s = s0 + r;
                const float c[8] = {bflo(cv[q].x), bfhi(cv[q].x), bflo(cv[q].y), bfhi(cv[q].y), bflo(cv[q].z), bfhi(cv[q].z), bflo(cv[q].w), bfhi(cv[q].w)};
                const float od[8] = {bflo(ov[q].x), bfhi(ov[q].x), bflo(ov[q].y), bfhi(ov[q].y), bflo(ov[q].z), bfhi(ov[q].z), bflo(ov[q].w), bfhi(ov[q].w)};
                const float rc = 1.0f / (float)((s + 1) < w ? (s + 1) : w);
                float ov8[8];
#pragma unroll
                for (int i = 0; i < 8; ++i) { acc[i] += c[i]; ov8[i] = acc[i] * rc - c[i]; acc[i] -= od[i]; }
                u32x4 o; o.x = cvtpk(ov8[0], ov8[1]); o.y = cvtpk(ov8[2], ov8[3]); o.z = cvtpk(ov8[4], ov8[5]); o.w = cvtpk(ov8[6], ov8[7]);
                *(u32x4*)(Y + (size_t)(mb + r) * DM + 8 * lane) = o; }
        }
    }
}

namespace att {
constexpr int SLOT = 32768, KB = 8192;
typedef short v4i16_t __attribute__((ext_vector_type(4)));
__device__ __forceinline__ int crow(int r, int hi) { return (r & 3) + 8 * (r >> 2) + 4 * hi; }
__device__ __forceinline__ s16x4 vtr(const LAS unsigned char* p) { return __builtin_bit_cast(s16x4, __builtin_amdgcn_ds_read_tr16_b64_v4i16((LAS v4i16_t*)p)); }
__device__ __forceinline__ void glds16(const void* gsrc, unsigned lds_dst) { unsigned keep;
    asm volatile("s_mov_b32 %0, m0\n\ts_mov_b32 m0, %2\n\ts_nop 0\n\tglobal_load_lds_dwordx4 %1, off\n\ts_mov_b32 m0, %0" : "=&s"(keep) : "v"(gsrc), "s"(lds_dst) : "memory"); }
__device__ __forceinline__ float swapadd(float v) { auto rr = __builtin_amdgcn_permlane32_swap(__float_as_uint(v), __float_as_uint(v), false, false); return __uint_as_float(rr[0]) + __uint_as_float(rr[1]); }
__device__ __forceinline__ float swapmax(float v) { auto rr = __builtin_amdgcn_permlane32_swap(__float_as_uint(v), __float_as_uint(v), false, false); return fmaxf(__uint_as_float(rr[0]), __uint_as_float(rr[1])); }

template <bool BOUNDED> __device__ __forceinline__ void attn_unit(int b, int h, int qb, const bf16_t* Z, bf16_t* Y, const float* subln, float lam, LAS unsigned char* lds) {
    const int tid = threadIdx.x, lane = tid & 63, r32 = lane & 31, hi = lane >> 5; const int wid = __builtin_amdgcn_readfirstlane(tid >> 6);
    const int m = wid >> 2, wq = wid & 3;
    const size_t rowbase = (size_t)b * SEQ; const int q0 = qb * 128, NT = 2 * qb + 2;
    const int qabs = q0 + wq * 32 + r32;
    bf16x8 qr[4];
    { const bf16_t* Qw = Z + (rowbase + qabs) * ZLD + 512 + h * 128 + m * 64;
#pragma unroll
      for (int d0 = 0; d0 < 4; ++d0) qr[d0] = *(const bf16x8*)(Qw + d0 * 16 + hi * 8); }
    const bf16_t* Zbh = Z + rowbase * ZLD + h * 128;
    unsigned kog[2], vog[2];
#pragma unroll
    for (int j = 0; j < 2; ++j) { const unsigned r = 8u * wid + 4u * j + (lane >> 4), cp = lane & 15;
        kog[j] = r * ZLD + 1024u + 8u * (cp ^ (r & 15u)); vog[j] = r * ZLD + 1536u + 8u * (cp ^ (((r & 3u) << 2) | ((r >> 2) & 3u))); }
    const unsigned wbase = (unsigned)wid * 2048u;
    const unsigned lds0 = (unsigned)(uintptr_t)lds;
#define ATT_DMA(t, slot) do { const bf16_t* zt_ = Zbh + (size_t)(t) * 64 * ZLD; const unsigned d_ = (unsigned)__builtin_amdgcn_readfirstlane(lds0 + (slot) + wbase); \
        glds16(zt_ + kog[0], d_); glds16(zt_ + kog[1], d_ + 1024); glds16(zt_ + vog[0], d_ + 2 * KB); glds16(zt_ + vog[1], d_ + 2 * KB + 1024); } while (0)
    f32x16 o[4];
#pragma unroll
    for (int d = 0; d < 4; ++d)
#pragma unroll
        for (int r = 0; r < 16; ++r) o[d][r] = 0.f;
    float mref = -1e30f, lsum = 0.f;
    int koffs[4], voffs[4][2];
#pragma unroll
    for (int d0 = 0; d0 < 4; ++d0) koffs[d0] = r32 * 256 + (((m * 8 + 2 * d0 + hi) ^ (r32 & 15)) * 16);
    { const int L2 = (lane >> 2) & 3, a = (lane >> 4) & 1, bb = (lane & 3) >> 1;
#pragma unroll
      for (int d = 0; d < 4; ++d)
#pragma unroll
          for (int h2 = 0; h2 < 2; ++h2) voffs[d][h2] = 2 * KB + 256 * (8 * h2 + 4 * hi + L2) + 16 * ((((d ^ L2) & 3) << 2) | (((2 * a + bb) ^ (2 * h2 + hi)) & 3)) + 8 * (lane & 1); }
    ATT_DMA(0, 0); ATT_DMA(1, SLOT);
    asm volatile("s_waitcnt vmcnt(4)" ::: "memory");
    __syncthreads();
    int slot = 0, slot2 = 2 * SLOT;
    for (int t = 0; t < NT; ++t) {
        if (t + 2 < NT) ATT_DMA(t + 2, slot2);
        const bool band = t >= NT - 2;
        bf16x8 kf[8];
        { const LAS unsigned char* kb = lds + slot;
#pragma unroll
          for (int d0 = 0; d0 < 4; ++d0) { kf[2 * d0] = *(const LAS bf16x8*)(kb + koffs[d0]); kf[2 * d0 + 1] = *(const LAS bf16x8*)(kb + koffs[d0] + 8192); } }
        __builtin_amdgcn_sched_barrier(0);
        f32x16 p0, p1;
#pragma unroll
        for (int r = 0; r < 16; ++r) { p0[r] = 0.f; p1[r] = 0.f; }
#pragma unroll
        for (int d0 = 0; d0 < 4; ++d0) { p0 = __builtin_amdgcn_mfma_f32_32x32x16_bf16(kf[2 * d0], qr[d0], p0, 0, 0, 0); p1 = __builtin_amdgcn_mfma_f32_32x32x16_bf16(kf[2 * d0 + 1], qr[d0], p1, 0, 0, 0); }
        const LAS unsigned char* vb = lds + slot;
        s16x4 loA[8], hhA[8], loB[8], hhB[8];
#pragma unroll
        for (int i = 0; i < 8; ++i) { const int d = (i >> 2), ks = i & 3; loA[i] = vtr(vb + voffs[d][0] + ks * 4096); hhA[i] = vtr(vb + voffs[d][1] + ks * 4096); }
        __builtin_amdgcn_sched_barrier(0);
        if (band) {
            const int kb0 = 64 * t + 4 * hi;
#pragma unroll
            for (int r = 0; r < 16; ++r) { const int kv = kb0 + (r & 3) + 8 * (r >> 2); if (kv > qabs) p0[r] = -INFINITY; if (kv + 32 > qabs) p1[r] = -INFINITY; }
        }
        float ls = 0.f;
        if constexpr (BOUNDED) {
#pragma unroll
            for (int r = 0; r < 16; ++r) { p0[r] = __builtin_amdgcn_exp2f(p0[r]); p1[r] = __builtin_amdgcn_exp2f(p1[r]); ls += p0[r] + p1[r]; }
        } else {
            float rm = fmaxf(p0[0], p1[0]);
#pragma unroll
            for (int r = 1; r < 16; ++r) rm = fmaxf(rm, fmaxf(p0[r], p1[r]));
            rm = swapmax(rm);
            if (__any(rm - mref > 8.0f)) {
                const float mn = fmaxf(mref, rm), al = exp2f(mref - mn);
                mref = mn; lsum *= al;
#pragma unroll
                for (int d = 0; d < 4; ++d)
#pragma unroll
                    for (int r = 0; r < 16; ++r) o[d][r] *= al;
            }
#pragma unroll
            for (int r = 0; r < 16; ++r) { p0[r] = __builtin_amdgcn_exp2f(p0[r] - mref); p1[r] = __builtin_amdgcn_exp2f(p1[r] - mref); ls += p0[r] + p1[r]; }
        }
        lsum += ls;
        u32x4 pw[4];
        pw[0] = (u32x4){cvtpk(p0[0], p0[1]), cvtpk(p0[2], p0[3]), cvtpk(p0[4], p0[5]), cvtpk(p0[6], p0[7])};
        pw[1] = (u32x4){cvtpk(p0[8], p0[9]), cvtpk(p0[10], p0[11]), cvtpk(p0[12], p0[13]), cvtpk(p0[14], p0[15])};
        pw[2] = (u32x4){cvtpk(p1[0], p1[1]), cvtpk(p1[2], p1[3]), cvtpk(p1[4], p1[5]), cvtpk(p1[6], p1[7])};
        pw[3] = (u32x4){cvtpk(p1[8], p1[9]), cvtpk(p1[10], p1[11]), cvtpk(p1[12], p1[13]), cvtpk(p1[14], p1[15])};
        __builtin_amdgcn_sched_barrier(0);
#pragma unroll
        for (int i = 0; i < 8; ++i) { const int d = 2 + (i >> 2), ks = i & 3; loB[i] = vtr(vb + voffs[d][0] + ks * 4096); hhB[i] = vtr(vb + voffs[d][1] + ks * 4096); }
        __builtin_amdgcn_sched_barrier(0);
#pragma unroll
        for (int i = 0; i < 8; ++i) { const int d = (i >> 2), ks = i & 3;
            const bf16x8 vf = {loA[i][0], loA[i][1], loA[i][2], loA[i][3], hhA[i][0], hhA[i][1], hhA[i][2], hhA[i][3]};
            o[d] = __builtin_amdgcn_mfma_f32_32x32x16_bf16(vf, __builtin_bit_cast(bf16x8, pw[ks]), o[d], 0, 0, 0); }
#pragma unroll
        for (int i = 0; i < 8; ++i) { const int d = 2 + (i >> 2), ks = i & 3;
            const bf16x8 vf = {loB[i][0], loB[i][1], loB[i][2], loB[i][3], hhB[i][0], hhB[i][1], hhB[i][2], hhB[i][3]};
            o[d] = __builtin_amdgcn_mfma_f32_32x32x16_bf16(vf, __builtin_bit_cast(bf16x8, pw[ks]), o[d], 0, 0, 0); }
        if (t + 2 < NT) asm volatile("s_waitcnt vmcnt(4)" ::: "memory"); else asm volatile("s_waitcnt vmcnt(0)" ::: "memory");
        __syncthreads();
        slot2 = slot; slot = (slot == 2 * SLOT) ? 0 : slot + SLOT;
    }
#undef ATT_DMA
    const float inv = 1.0f / swapadd(lsum);
    LAS float* xch = (LAS float*)(lds + wq * 16384);
    if (m == 1) {
        const float sc = inv * lam;
#pragma unroll
        for (int d = 0; d < 4; ++d)
#pragma unroll
            for (int r = 0; r < 16; ++r) xch[(d * 16 + r) * 64 + lane] = o[d][r] * sc;
    }
    __syncthreads();
    if (m == 0) {
        float ss = 0.f;
#pragma unroll
        for (int d = 0; d < 4; ++d)
#pragma unroll
            for (int r = 0; r < 16; ++r) { const float v = o[d][r] * inv - xch[(d * 16 + r) * 64 + lane]; o[d][r] = v; ss += v * v; }
        ss = swapadd(ss);
        const float rn = rsqrtf(ss * (1.0f / 128.0f) + EPS) * 0.8f;
        bf16_t* yp = Y + (rowbase + qabs) * DM + 512 + h * 128;
#pragma unroll
        for (int d = 0; d < 4; ++d)
#pragma unroll
            for (int rq = 0; rq < 4; ++rq) { const int dc = 32 * d + 8 * rq + 4 * hi; const f32x4 g = *(const f32x4*)(subln + dc);
                u32x2 w; w.x = cvtpk(o[d][4 * rq] * rn * g[0], o[d][4 * rq + 1] * rn * g[1]); w.y = cvtpk(o[d][4 * rq + 2] * rn * g[2], o[d][4 * rq + 3] * rn * g[3]);
                *(u32x2*)(yp + dc) = w; }
    }
    __syncthreads();
}

__device__ __forceinline__ void attn_unit_pipe(int b, int h, int qb, const bf16_t* Z, bf16_t* Y, const float* subln, float lam, LAS unsigned char* lds) {
    int tid = threadIdx.x; asm volatile("" : "+v"(tid));
    const int lane = tid & 63, r32 = lane & 31, hi = lane >> 5; const int wid = __builtin_amdgcn_readfirstlane(tid >> 6);
    const int m = wid >> 2, wq = wid & 3;
    const size_t rowbase = (size_t)b * SEQ; const int q0 = qb * 128, NT = 2 * qb + 2;
    const int qabs = q0 + wq * 32 + r32;
    bf16x8 qr[4];
    { const bf16_t* Qw = Z + (rowbase + qabs) * ZLD + 512 + h * 128 + m * 64;
#pragma unroll
      for (int d0 = 0; d0 < 4; ++d0) qr[d0] = *(const bf16x8*)(Qw + d0 * 16 + hi * 8); }
    const bf16_t* Zbh = Z + rowbase * ZLD + h * 128;
    unsigned kog[2], vog[2];
#pragma unroll
    for (int j = 0; j < 2; ++j) { const unsigned r = 8u * wid + 4u * j + (lane >> 4), cp = lane & 15;
        kog[j] = r * ZLD + 1024u + 8u * (cp ^ (r & 15u)); vog[j] = r * ZLD + 1536u + 8u * (cp ^ (((r & 3u) << 2) | ((r >> 2) & 3u))); }
    const unsigned wbase = (unsigned)wid * 2048u;
    const unsigned lds0 = (unsigned)(uintptr_t)lds;
#define ATP_DMA(t) do { const bf16_t* zt_ = Zbh + (size_t)(t) * 64 * ZLD; const unsigned d_ = (unsigned)__builtin_amdgcn_readfirstlane(lds0 + ((t) & 3) * SLOT + wbase); \
        glds16(zt_ + kog[0], d_); glds16(zt_ + kog[1], d_ + 1024); glds16(zt_ + vog[0], d_ + 2 * KB); glds16(zt_ + vog[1], d_ + 2 * KB + 1024); } while (0)
    f32x16 o[4];
#pragma unroll
    for (int d = 0; d < 4; ++d)
#pragma unroll
        for (int r = 0; r < 16; ++r) o[d][r] = 0.f;
    float lsum = 0.f;
    const int kbase = r32 * 256 + (((m * 8 + hi) ^ (r32 & 15)) * 16);
    int vbase[2];
    { const int L2 = (lane >> 2) & 3, a = (lane >> 4) & 1, bb = (lane & 3) >> 1;
#pragma unroll
      for (int h2 = 0; h2 < 2; ++h2) vbase[h2] = 2 * KB + 256 * (8 * h2 + 4 * hi + L2) + 16 * ((L2 << 2) | (((2 * a + bb) ^ (2 * h2 + hi)) & 3)) + 8 * (lane & 1); }
#define ATP_PIN(x) asm volatile("" : "+v"(x))
#define ATP_SB() __builtin_amdgcn_sched_barrier(0)
#define ATP_MASK(C0, C1, t) do { if ((t) >= NT - 2) { const int kb0_ = 64 * (t) + 4 * hi; \
        _Pragma("unroll") for (int r = 0; r < 16; ++r) { const int kv = kb0_ + (r & 3) + 8 * (r >> 2); if (kv > qabs) C0[r] = -INFINITY; if (kv + 32 > qabs) C1[r] = -INFINITY; } } } while (0)
#define ATP_KLOAD(t) do { const LAS unsigned char* kb_ = lds + ((t) & 3) * SLOT; \
        _Pragma("unroll") for (int d0 = 0; d0 < 4; ++d0) { kf[2 * d0] = *(const LAS bf16x8*)(kb_ + (kbase ^ (32 * d0))); kf[2 * d0 + 1] = *(const LAS bf16x8*)(kb_ + (kbase ^ (32 * d0)) + 8192); } } while (0)
#define ATP_VLOAD(vf, vb, d) do { _Pragma("unroll") for (int ks = 0; ks < 4; ++ks) { const s16x4 lo_ = vtr((vb) + (vbase[0] ^ (64 * (d))) + ks * 4096), hh_ = vtr((vb) + (vbase[1] ^ (64 * (d))) + ks * 4096); \
        vf[ks] = (bf16x8){lo_[0], lo_[1], lo_[2], lo_[3], hh_[0], hh_[1], hh_[2], hh_[3]}; } } while (0)
#define ATP_WAIT(t) do { if ((t) + 2 < NT) asm volatile("s_waitcnt vmcnt(4)" ::: "memory"); else asm volatile("s_waitcnt vmcnt(0)" ::: "memory"); __syncthreads(); } while (0)
    bf16x8 kf[8], vfA[4], vfB[4]; u32x4 pw[4];
    f32x16 pA0, pA1, pB0, pB1;
    ATP_DMA(0); ATP_DMA(1);
    asm volatile("s_waitcnt vmcnt(4)" ::: "memory");
    __syncthreads();
    if (2 < NT) ATP_DMA(2);
    ATP_KLOAD(0); ATP_SB();
#pragma unroll
    for (int r = 0; r < 16; ++r) { pA0[r] = 0.f; pA1[r] = 0.f; }
#pragma unroll
    for (int d0 = 0; d0 < 4; ++d0) { pA0 = __builtin_amdgcn_mfma_f32_32x32x16_bf16(kf[2 * d0], qr[d0], pA0, 0, 0, 0); pA1 = __builtin_amdgcn_mfma_f32_32x32x16_bf16(kf[2 * d0 + 1], qr[d0], pA1, 0, 0, 0); }
    ATP_MASK(pA0, pA1, 0);
#pragma unroll
    for (int r = 0; r < 16; ++r) { pA0[r] = __builtin_amdgcn_exp2f(pA0[r]); pA1[r] = __builtin_amdgcn_exp2f(pA1[r]); }
    ATP_WAIT(0);
#define ATP_GAPA(i, C0, C1, P0, P1) do { \
        if ((i) & 1) { C1 = __builtin_amdgcn_mfma_f32_32x32x16_bf16(kf[i], qr[(i) >> 1], C1, 0, 0, 0); ATP_PIN(C1); } else { C0 = __builtin_amdgcn_mfma_f32_32x32x16_bf16(kf[i], qr[(i) >> 1], C0, 0, 0, 0); ATP_PIN(C0); } \
        if ((i) < 4) { sacc += (P0[4 * (i)] + P0[4 * (i) + 1]) + (P0[4 * (i) + 2] + P0[4 * (i) + 3]); pw[(i) >> 1][2 * ((i) & 1)] = cvtpk(P0[4 * (i)], P0[4 * (i) + 1]); pw[(i) >> 1][2 * ((i) & 1) + 1] = cvtpk(P0[4 * (i) + 2], P0[4 * (i) + 3]); } \
        else { sacc += (P1[4 * ((i) - 4)] + P1[4 * ((i) - 4) + 1]) + (P1[4 * ((i) - 4) + 2] + P1[4 * ((i) - 4) + 3]); pw[(i) >> 1][2 * ((i) & 1)] = cvtpk(P1[4 * ((i) - 4)], P1[4 * ((i) - 4) + 1]); pw[(i) >> 1][2 * ((i) & 1) + 1] = cvtpk(P1[4 * ((i) - 4) + 2], P1[4 * ((i) - 4) + 3]); } \
        ATP_PIN(sacc); ATP_PIN(pw[(i) >> 1]); ATP_SB(); } while (0)
#define ATP_GAPB(vf, d, ks, X, e0) do { o[d] = __builtin_amdgcn_mfma_f32_32x32x16_bf16(vf[ks], __builtin_bit_cast(bf16x8, pw[ks]), o[d], 0, 0, 0); \
        X[e0] = __builtin_amdgcn_exp2f(X[e0]); X[(e0) + 1] = __builtin_amdgcn_exp2f(X[(e0) + 1]); ATP_PIN(X); ATP_SB(); } while (0)
#define ATP_STEP(C0, C1, P0, P1, t) do { \
        if ((t) + 2 < NT) ATP_DMA((t) + 2); \
        ATP_KLOAD(t); ATP_SB(); \
        const LAS unsigned char* vb_ = lds + (((t) - 1) & 3) * SLOT; \
        _Pragma("unroll") for (int r = 0; r < 16; ++r) { C0[r] = 0.f; C1[r] = 0.f; } \
        float sacc = 0.f; \
        ATP_GAPA(0, C0, C1, P0, P1); ATP_GAPA(1, C0, C1, P0, P1); ATP_GAPA(2, C0, C1, P0, P1); ATP_GAPA(3, C0, C1, P0, P1); \
        ATP_GAPA(4, C0, C1, P0, P1); ATP_GAPA(5, C0, C1, P0, P1); ATP_GAPA(6, C0, C1, P0, P1); ATP_GAPA(7, C0, C1, P0, P1); \
        lsum += sacc; \
        ATP_VLOAD(vfA, vb_, 0); ATP_VLOAD(vfB, vb_, 1); ATP_SB(); \
        ATP_MASK(C0, C1, t); ATP_SB(); \
        ATP_GAPB(vfA, 0, 0, C0, 0); ATP_GAPB(vfA, 0, 1, C0, 2); ATP_GAPB(vfA, 0, 2, C0, 4); ATP_GAPB(vfA, 0, 3, C0, 6); \
        ATP_VLOAD(vfA, vb_, 2); ATP_SB(); \
        ATP_GAPB(vfB, 1, 0, C0, 8); ATP_GAPB(vfB, 1, 1, C0, 10); ATP_GAPB(vfB, 1, 2, C0, 12); ATP_GAPB(vfB, 1, 3, C0, 14); \
        ATP_VLOAD(vfB, vb_, 3); ATP_SB(); \
        ATP_GAPB(vfA, 2, 0, C1, 0); ATP_GAPB(vfA, 2, 1, C1, 2); ATP_GAPB(vfA, 2, 2, C1, 4); ATP_GAPB(vfA, 2, 3, C1, 6); \
        ATP_GAPB(vfB, 3, 0, C1, 8); ATP_GAPB(vfB, 3, 1, C1, 10); ATP_GAPB(vfB, 3, 2, C1, 12); ATP_GAPB(vfB, 3, 3, C1, 14); \
        ATP_WAIT(t); } while (0)
    int t = 1;
    for (; t + 1 < NT; t += 2) { ATP_STEP(pB0, pB1, pA0, pA1, t); ATP_STEP(pA0, pA1, pB0, pB1, t + 1); }
    ATP_STEP(pB0, pB1, pA0, pA1, t);
    { float sacc = 0.f;
#pragma unroll
      for (int r = 0; r < 16; ++r) sacc += pB0[r] + pB1[r];
      lsum += sacc;
      pw[0] = (u32x4){cvtpk(pB0[0], pB0[1]), cvtpk(pB0[2], pB0[3]), cvtpk(pB0[4], pB0[5]), cvtpk(pB0[6], pB0[7])};
      pw[1] = (u32x4){cvtpk(pB0[8], pB0[9]), cvtpk(pB0[10], pB0[11]), cvtpk(pB0[12], pB0[13]), cvtpk(pB0[14], pB0[15])};
      pw[2] = (u32x4){cvtpk(pB1[0], pB1[1]), cvtpk(pB1[2], pB1[3]), cvtpk(pB1[4], pB1[5]), cvtpk(pB1[6], pB1[7])};
      pw[3] = (u32x4){cvtpk(pB1[8], pB1[9]), cvtpk(pB1[10], pB1[11]), cvtpk(pB1[12], pB1[13]), cvtpk(pB1[14], pB1[15])};
      const LAS unsigned char* vb_ = lds + ((NT - 1) & 3) * SLOT;
#pragma unroll
      for (int d = 0; d < 4; ++d) { ATP_VLOAD(vfA, vb_, d);
#pragma unroll
          for (int ks = 0; ks < 4; ++ks) o[d] = __builtin_amdgcn_mfma_f32_32x32x16_bf16(vfA[ks], __builtin_bit_cast(bf16x8, pw[ks]), o[d], 0, 0, 0); } }
    __syncthreads();
#undef ATP_DMA
#undef ATP_PIN
#undef ATP_SB
#undef ATP_MASK
#undef ATP_KLOAD
#undef ATP_VLOAD
#undef ATP_WAIT
#undef ATP_GAPA
#undef ATP_GAPB
#undef ATP_STEP
    const float inv = 1.0f / swapadd(lsum);
    LAS float* xch = (LAS float*)(lds + wq * 16384);
    if (m == 1) {
        const float sc = inv * lam;
#pragma unroll
        for (int d = 0; d < 4; ++d)
#pragma unroll
            for (int r = 0; r < 16; ++r) xch[(d * 16 + r) * 64 + lane] = o[d][r] * sc;
    }
    __syncthreads();
    if (m == 0) {
        float ss = 0.f;
#pragma unroll
        for (int d = 0; d < 4; ++d)
#pragma unroll
            for (int r = 0; r < 16; ++r) { const float v = o[d][r] * inv - xch[(d * 16 + r) * 64 + lane]; o[d][r] = v; ss += v * v; }
        ss = swapadd(ss);
        const float rn = rsqrtf(ss * (1.0f / 128.0f) + EPS) * 0.8f;
        bf16_t* yp = Y + (rowbase + qabs) * DM + 512 + h * 128;
#pragma unroll
        for (int d = 0; d < 4; ++d)
#pragma unroll
            for (int rq = 0; rq < 4; ++rq) { const int dc = 32 * d + 8 * rq + 4 * hi; const f32x4 g = *(const f32x4*)(subln + dc);
                u32x2 w; w.x = cvtpk(o[d][4 * rq] * rn * g[0], o[d][4 * rq + 1] * rn * g[1]); w.y = cvtpk(o[d][4 * rq + 2] * rn * g[2], o[d][4 * rq + 3] * rn * g[3]);
                *(u32x2*)(yp + dc) = w; }
    }
    __syncthreads();
}
}

__device__ __forceinline__ void phase_attn(const Ctx& C) {
    const Params& P = *C.p; unsigned char* ws = P.ws;
    const bf16_t* Z = (const bf16_t*)(ws + WS_Z); bf16_t* Y = (bf16_t*)(ws + WS_YCAT);
    const float d1 = wave_sum(P.in[I_LQ1][C.lane] * P.in[I_LK1][C.lane]), d2 = wave_sum(P.in[I_LQ2][C.lane] * P.in[I_LK2][C.lane]);
    const float lam = expf(d1) - expf(d2) + 0.2f;
    float gq = fabsf(P.in[I_QN][C.lane]), gk = fabsf(P.in[I_KN][C.lane]);
#pragma unroll
    for (int o = 1; o < 64; o <<= 1) { gq = fmaxf(gq, __shfl_xor(gq, o)); gk = fmaxf(gk, __shfl_xor(gk, o)); }
    const bool bounded = 8.0f * 1.4426950408889634f * gq * gk <= 40.0f;
#pragma unroll 1
    for (int rep = 0; rep <= PROBE_ATTN2; ++rep)
#pragma unroll 1
    for (int pi = C.vcu; pi < 512; pi += C.G) {
        const int bh = pi >> 5, s = pi & 31;
        if (bounded) {
#pragma unroll 1
            for (int u = 0; u < 2; ++u) att::attn_unit_pipe(bh >> 2, bh & 3, u ? s : 63 - s, Z, Y, P.in[I_SUBLN], lam, C.lds);
        } else {
#pragma unroll 1
            for (int u = 0; u < 2; ++u) att::attn_unit<false>(bh >> 2, bh & 3, u ? s : 63 - s, Z, Y, P.in[I_SUBLN], lam, C.lds);
        }
    }
}

__device__ __forceinline__ unsigned mono(float f) { const unsigned u = __float_as_uint(f); return (u & 0x80000000u) ? ~u : (u | 0x80000000u); }
__device__ __forceinline__ float unmono(unsigned u) { return __uint_as_float((u & 0x80000000u) ? (u & 0x7fffffffu) : ~u); }
template <class T> __device__ __forceinline__ void sort16_desc(T (&a)[16]) {
#define CE(i, j) { const T mx = a[i] > a[j] ? a[i] : a[j], mn = a[i] > a[j] ? a[j] : a[i]; a[i] = mx; a[j] = mn; }
    CE(0, 13) CE(1, 12) CE(2, 15) CE(3, 14) CE(4, 8) CE(5, 6) CE(7, 11) CE(9, 10)
    CE(0, 5) CE(1, 7) CE(2, 9) CE(3, 4) CE(6, 13) CE(8, 14) CE(10, 15) CE(11, 12)
    CE(0, 1) CE(2, 3) CE(4, 5) CE(6, 8) CE(7, 9) CE(10, 11) CE(12, 13) CE(14, 15)
    CE(0, 2) CE(1, 3) CE(4, 10) CE(5, 11) CE(6, 7) CE(8, 9) CE(12, 14) CE(13, 15)
    CE(1, 2) CE(3, 12) CE(4, 6) CE(5, 7) CE(8, 10) CE(9, 11) CE(13, 14)
    CE(1, 4) CE(2, 6) CE(5, 8) CE(7, 10) CE(9, 13) CE(11, 14)
    CE(2, 4) CE(3, 6) CE(9, 12) CE(11, 13)
    CE(3, 5) CE(6, 8) CE(7, 9) CE(10, 12)
    CE(3, 4) CE(5, 6) CE(7, 8) CE(9, 10) CE(11, 12)
    CE(6, 7) CE(8, 9)
#undef CE
}
template <class T> __device__ __forceinline__ void merge16_desc(T (&a)[16], const T (&b)[16]) {
#pragma unroll
    for (int i = 0; i < 16; ++i) a[i] = a[i] > b[15 - i] ? a[i] : b[15 - i];
#pragma unroll
    for (int j = 8; j > 0; j >>= 1)
#pragma unroll
        for (int i = 0; i < 16; ++i) { const int l = i ^ j; if (l > i) { const T mx = a[i] > a[l] ? a[i] : a[l], mn = a[i] > a[l] ? a[l] : a[i]; a[i] = mx; a[l] = mn; } }
}
__device__ __forceinline__ void top16_of_128(const _Float16* sc, unsigned (&a)[16]) {
    f16x8 n0 = *(const f16x8*)sc, n1 = *(const f16x8*)(sc + 8);
#pragma unroll 1
    for (int g = 0; g < 8; ++g) {
        const f16x8 h0 = n0, h1 = n1;
        { const int gn = g < 7 ? g + 1 : 7; n0 = *(const f16x8*)(sc + 16 * gn); n1 = *(const f16x8*)(sc + 16 * gn + 8); }
        unsigned b[16];
#pragma unroll
        for (int i = 0; i < 8; ++i) { b[i] = (mono((float)h0[i]) & ~127u) | (unsigned)(127 - (16 * g + i)); b[8 + i] = (mono((float)h1[i]) & ~127u) | (unsigned)(127 - (16 * g + 8 + i)); }
        sort16_desc(b);
        if (g == 0) {
#pragma unroll
            for (int i = 0; i < 16; ++i) a[i] = b[i];
        } else merge16_desc(a, b);
    }
}
typedef unsigned long long u64;
__device__ __forceinline__ void phase_topk(const Ctx& C) {
    const Params& P = *C.p; unsigned char* ws = P.ws;
    const _Float16* SC = (const _Float16*)(ws + WS_Z); int* EI = (int*)(ws + WS_EIDX); float* GT = (float*)(ws + WS_GATE);
    const int gt = C.vcu * 512 + C.tid, NT = C.G * 512;
    for (int it = gt; it < M_TOK * 8; it += NT) {
        const _Float16* sc = SC + (size_t)it * 256;
        unsigned a0[16], a1[16];
        top16_of_128(sc, a0); top16_of_128(sc + 128, a1);
        float v0[16], v1[16]; unsigned e0[16], e1[16];
#pragma unroll
        for (int i = 0; i < 16; ++i) { v0[i] = unmono(a0[i] & ~127u); v1[i] = unmono(a1[i] & ~127u); e0[i] = (127u - (a0[i] & 127u)) << 7; e1[i] = 127u - (a1[i] & 127u); }
#define CAND(i, j) ((((u64)mono(v0[i] + v1[j])) << 32) | (u64)(((255u - (unsigned)((i) * 16 + (j))) << 16) | e0[i] | e1[j]))
        u64 a[16], bq[16];
#pragma unroll
        for (int j = 0; j < 16; ++j) a[j] = CAND(0, j);
#pragma unroll
        for (int i = 0; i < 15; ++i) bq[i] = CAND(i + 1, 0);
        bq[15] = 0ull; merge16_desc(a, bq);
#pragma unroll
        for (int i = 0; i < 16; ++i) bq[i] = 0ull;
#pragma unroll
        for (int j = 1; j < 8; ++j) bq[j - 1] = CAND(1, j);
        merge16_desc(a, bq);
#pragma unroll
        for (int i = 0; i < 16; ++i) bq[i] = 0ull;
#pragma unroll
        for (int i = 2; i < 8; ++i) bq[i - 2] = CAND(i, 1);
        merge16_desc(a, bq);
#pragma unroll
        for (int i = 0; i < 16; ++i) bq[i] = 0ull;
        bq[0] = CAND(2, 2); bq[1] = CAND(2, 3); bq[2] = CAND(2, 4); bq[3] = CAND(3, 2); bq[4] = CAND(4, 2); bq[5] = CAND(3, 3);
        sort16_desc(bq); merge16_desc(a, bq);
#undef CAND
        float sv[16]; const float smax = unmono((unsigned)(a[0] >> 32)); float den = 0.f;
#pragma unroll
        for (int i = 0; i < 16; ++i) { sv[i] = __expf(unmono((unsigned)(a[i] >> 32)) - smax); den += sv[i]; }
        const float rd = 1.0f / den;
        int* eo = EI + (size_t)it * 16; float* go = GT + (size_t)it * 16;
#pragma unroll
        for (int q = 0; q < 4; ++q) {
            *(u32x4*)(eo + 4 * q) = (u32x4){(unsigned)a[4 * q] & 0x3fffu, (unsigned)a[4 * q + 1] & 0x3fffu, (unsigned)a[4 * q + 2] & 0x3fffu, (unsigned)a[4 * q + 3] & 0x3fffu};
            *(f32x4*)(go + 4 * q) = (f32x4){sv[4 * q] * rd, sv[4 * q + 1] * rd, sv[4 * q + 2] * rd, sv[4 * q + 3] * rd};
        }
    }
}

constexpr int GT_T = 8;
typedef _Float16 h16x2 __attribute__((ext_vector_type(2)));
typedef int v4i_t __attribute__((ext_vector_type(4)));
typedef int v8i_t __attribute__((ext_vector_type(8)));
__device__ __forceinline__ f32x4 mx4(const v4i_t a, const v4i_t b, const f32x4 c) {
    const v8i_t A = {a[0], a[1], a[2], a[3], 0, 0, 0, 0}, B = {b[0], b[1], b[2], b[3], 0, 0, 0, 0};
    return __builtin_amdgcn_mfma_scale_f32_16x16x128_f8f6f4(A, B, c, 4, 4, 0, 0x7f7f7f7f, 0, 0x7f7f7f7f);
}
__device__ __forceinline__ float gelu_erf(float a) {
    const float x = a * 0.70710678118654752f, ax = fabsf(x);
    const float t = __builtin_amdgcn_rcpf(fmaf(0.3275911f, ax, 1.0f));
    const float pl = t * fmaf(t, fmaf(t, fmaf(t, fmaf(t, 1.061405429f, -1.453152027f), 1.421413741f), -0.284496736f), 0.254829592f);
    const float er = fmaf(-pl, __builtin_amdgcn_exp2f(-1.4426950408889634f * x * x), 1.0f);
    return 0.5f * a * (1.0f + copysignf(er, x));
}
__device__ __forceinline__ unsigned pkmax16(unsigned a, unsigned b) { typedef unsigned short us2 __attribute__((ext_vector_type(2))); return __builtin_bit_cast(unsigned, __builtin_elementwise_max(__builtin_bit_cast(us2, a), __builtin_bit_cast(us2, b))); }
__device__ __forceinline__ void phase_gather(const Ctx& C, bool dry = false) {
    const Params& P = *C.p; unsigned char* ws = P.ws; const int lane = C.lane;
    bf16_t* HB = (bf16_t*)(ws + WS_ACTB); const float* rowss = (const float*)(ws + WS_CTL + WS_ROWSS2); float* rinv3 = (float*)(ws + WS_RINV3);
    bf16_t* HBW = dry ? (bf16_t*)(ws + WS_YCAT) : HB; float* R3W = dry ? (float*)(ws + WS_WIN) : rinv3;
    const auto rsT = __builtin_amdgcn_make_buffer_rsrc((void*)(ws + WS_UT), 0, 16 << 20, 0x00020000);
    const int* EI = (const int*)(ws + WS_EIDX); const float* GT = (const float*)(ws + WS_GATE);
    constexpr int WLDS = 9216;
    LAS u32x2* sl = (LAS u32x2*)(C.lds + C.wave * WLDS);
    LAS float* gl = (LAS float*)(C.lds + C.wave * WLDS + 1024);
    LAS int* el = (LAS int*)(C.lds + C.wave * WLDS + 5120);
    const unsigned lane16 = 16u * (unsigned)lane;
    const int mi = lane & 15, mg = lane >> 4;
    const bool xsel = mi < 8 && mg == (mi >> 1), nodd = lane & 1;
    for (int tok0 = (C.vcu * 8 + C.wave) * GT_T; tok0 < M_TOK; tok0 += C.G * 8 * GT_T) {
        h16x2 op[GT_T][8];
#pragma unroll
        for (int j = 0; j < GT_T; ++j) {
            const int tok = tok0 + j;
            const int e0 = EI[(size_t)tok * 128 + lane], e1 = EI[(size_t)tok * 128 + 64 + lane]; const float g0 = GT[(size_t)tok * 128 + lane], g1 = GT[(size_t)tok * 128 + 64 + lane];
            int pos0 = 0, pos1 = 0, base = 0;
#pragma unroll
            for (int b = 0; b < 16; ++b) {
                const bool q0 = (e0 >> 10) == b, q1 = (e1 >> 10) == b;
                const unsigned long long m0 = __ballot(q0), m1 = __ballot(q1);
                const int c0 = __builtin_popcountll(m0), c1 = __builtin_popcountll(m1);
                const int r0 = __builtin_amdgcn_mbcnt_hi((unsigned)(m0 >> 32), __builtin_amdgcn_mbcnt_lo((unsigned)m0, 0u));
                const int r1 = __builtin_amdgcn_mbcnt_hi((unsigned)(m1 >> 32), __builtin_amdgcn_mbcnt_lo((unsigned)m1, 0u));
                if (q0) pos0 = base + r0;
                if (q1) pos1 = base + c0 + r1;
                base += c0 + c1;
            }
            sl[pos0] = (u32x2){(unsigned)e0, __float_as_uint(g0)}; sl[pos1] = (u32x2){(unsigned)e1, __float_as_uint(g1)};
            const u32x2 a = sl[lane], b = sl[64 + lane];
            gl[j * 128 + lane] = __uint_as_float(a.y); gl[j * 128 + 64 + lane] = __uint_as_float(b.y);
            el[j * 128 + lane] = (int)a.x; el[j * 128 + 64 + lane] = (int)b.x;
        }
        v4i_t xb1[8], xb2[8]; float ascl;
        {
            const int tok = tok0 + (lane & 7); const bf16_t* hp = HB + (size_t)tok * DM + 32 * mg;
            unsigned mx = 0u;
#pragma unroll
            for (int st = 0; st < 8; ++st)
#pragma unroll
                for (int c = 0; c < 4; ++c) { const u32x4 hw = *(const u32x4*)(hp + 128 * st + 8 * c);
                    mx = pkmax16(mx, pkmax16(pkmax16(hw.x & 0x7fff7fffu, hw.y & 0x7fff7fffu), pkmax16(hw.z & 0x7fff7fffu, hw.w & 0x7fff7fffu))); }
            float am = __uint_as_float(((mx & 0xffffu) > (mx >> 16) ? (mx & 0xffffu) : (mx >> 16)) << 16);
            am = fmaxf(am, __shfl_xor(am, 16)); am = fmaxf(am, __shfl_xor(am, 32)); am = fmaxf(am, 1e-30f);
            const float sc = 6.0f / am;
            ascl = am * (1.0f / 6.0f) * rsqrtf(rowss[tok] * (1.0f / 1024.0f) + EPS) * (1.0f / U4SCALE);
#pragma unroll
            for (int st = 0; st < 8; ++st)
#pragma unroll
                for (int c = 0; c < 4; ++c) { const u32x4 hw = *(const u32x4*)(hp + 128 * ((st + lane) & 7) + 8 * c); unsigned q1 = 0u, q2 = 0u;
#define GX_BYTE(b, w) { const float x0 = bflo(w) * sc, x1 = bfhi(w) * sc; q1 = __builtin_amdgcn_cvt_scalef32_pk_fp4_f32(q1, x0, x1, 1.0f, b); \
                        const f32x2 d = __builtin_amdgcn_cvt_scalef32_pk_f32_fp4(q1, 1.0f, b); q2 = __builtin_amdgcn_cvt_scalef32_pk_fp4_f32(q2, (x0 - d[0]) * 8.0f, (x1 - d[1]) * 8.0f, 1.0f, b); }
                    GX_BYTE(0, hw.x) GX_BYTE(1, hw.y) GX_BYTE(2, hw.z) GX_BYTE(3, hw.w)
#undef GX_BYTE
                    xb1[st][c] = (int)q1; xb2[st][c] = (int)q2; }
        }
#pragma unroll
        for (int j = 0; j < GT_T; ++j)
#pragma unroll
            for (int i = 0; i < 8; ++i) op[j][i] = (h16x2){(_Float16)0.f, (_Float16)0.f};
        {
            const int ro = (mi >> 1) * 128 + (mi & 1);
            const LAS int* elp = el + ro; const LAS float* glw = gl + (lane & 7) * 128;
            unsigned rot[8];
#pragma unroll
            for (int st = 0; st < 8; ++st) rot[st] = 64u * (unsigned)((st + (mi >> 1)) & 7) + 16u * (unsigned)mg;
            int ev = elp[0];
            v4i_t a[8];
            { const unsigned vo = (unsigned)ev << 10;
#pragma unroll
              for (int st = 0; st < 8; ++st) a[st] = __builtin_bit_cast(v4i_t, __builtin_amdgcn_raw_buffer_load_b128(rsT, vo + rot[st], 0, 0)); }
#pragma unroll 1
            for (int k = 0; k < 64; ++k) {
                u32x2 w[16];
#pragma unroll
                for (int r = 0; r < 16; ++r) { const int e = __builtin_amdgcn_readlane(ev, r); w[r] = __builtin_amdgcn_raw_buffer_load_b64(rsT, (lane16 >> 1) + 512u, e << 10, 17); }
                __builtin_amdgcn_sched_barrier(0);
                f32x4 c1 = {0.f, 0.f, 0.f, 0.f}, c2 = {0.f, 0.f, 0.f, 0.f};
#pragma unroll
                for (int st = 0; st < 8; ++st) { c1 = mx4(a[st], xb1[st], c1); c2 = mx4(a[st], xb2[st], c2); }
                const float v0 = nodd ? c1[2] + 0.125f * c2[2] : c1[0] + 0.125f * c2[0], v1 = nodd ? c1[3] + 0.125f * c2[3] : c1[1] + 0.125f * c2[1];
                const f32x2 gt2 = *(const LAS f32x2*)(glw + 2 * k);
                __builtin_amdgcn_sched_barrier(0);
                { ev = elp[k < 63 ? 2 * k + 2 : 126]; const unsigned vo = (unsigned)ev << 10;
#pragma unroll
                    for (int st = 0; st < 8; ++st) a[st] = __builtin_bit_cast(v4i_t, __builtin_amdgcn_raw_buffer_load_b128(rsT, vo + rot[st], 0, 0)); }
                __builtin_amdgcn_sched_barrier(0);
                const float h0 = gelu_erf(v0 * ascl) * gt2[0] * (1.0f / V4SCALE), h1 = gelu_erf(v1 * ascl) * gt2[1] * (1.0f / V4SCALE);
                const h16x2 hh0 = {(_Float16)h0, (_Float16)h0}, hh1 = {(_Float16)h1, (_Float16)h1}; const unsigned hr0 = __builtin_bit_cast(unsigned, hh0), hr1 = __builtin_bit_cast(unsigned, hh1);
                __builtin_amdgcn_sched_barrier(0);
                unsigned scs[16];
#pragma unroll
                for (int r = 0; r < 16; ++r) scs[r] = (unsigned)__builtin_amdgcn_readlane((int)((r & 1) ? hr1 : hr0), (r >> 1) + 16 * (r >> 2));
#pragma unroll
                for (int r = 0; r < 16; ++r) { const int j = r >> 1; const h16x2 sc = __builtin_bit_cast(h16x2, scs[r]); u32x2 ww = w[r];
                    asm volatile("" : "+v"(ww));
#pragma unroll
                    for (int c = 0; c < 2; ++c) {
                        op[j][4 * c + 0] = __builtin_elementwise_fma(sc, __builtin_bit_cast(h16x2, __builtin_amdgcn_cvt_scalef32_pk_f16_fp4(ww[c], 1.0f, 0)), op[j][4 * c + 0]);
                        op[j][4 * c + 1] = __builtin_elementwise_fma(sc, __builtin_bit_cast(h16x2, __builtin_amdgcn_cvt_scalef32_pk_f16_fp4(ww[c], 1.0f, 1)), op[j][4 * c + 1]);
                        op[j][4 * c + 2] = __builtin_elementwise_fma(sc, __builtin_bit_cast(h16x2, __builtin_amdgcn_cvt_scalef32_pk_f16_fp4(ww[c], 1.0f, 2)), op[j][4 * c + 2]);
                        op[j][4 * c + 3] = __builtin_elementwise_fma(sc, __builtin_bit_cast(h16x2, __builtin_amdgcn_cvt_scalef32_pk_f16_fp4(ww[c], 1.0f, 3)), op[j][4 * c + 3]); }
                    asm volatile("" : "+v"(op[j][0]), "+v"(op[j][1]), "+v"(op[j][2]), "+v"(op[j][3]), "+v"(op[j][4]), "+v"(op[j][5]), "+v"(op[j][6]), "+v"(op[j][7])); }
                __builtin_amdgcn_sched_barrier(0);
            }
        }
#pragma unroll
        for (int j = 0; j < GT_T; ++j) {
            const int tok = tok0 + j; const bf16_t* hp0 = HB + (size_t)tok * DM + 16 * lane; f32x4 hv[4]; float ss = 0.f;
            const u32x4 hw0 = *(const u32x4*)hp0, hw1 = *(const u32x4*)(hp0 + 8);
            hv[0] = (f32x4){bflo(hw0.x), bfhi(hw0.x), bflo(hw0.y), bfhi(hw0.y)}; hv[1] = (f32x4){bflo(hw0.z), bfhi(hw0.z), bflo(hw0.w), bfhi(hw0.w)};
            hv[2] = (f32x4){bflo(hw1.x), bfhi(hw1.x), bflo(hw1.y), bfhi(hw1.y)}; hv[3] = (f32x4){bflo(hw1.z), bfhi(hw1.z), bflo(hw1.w), bfhi(hw1.w)};
#pragma unroll
            for (int i = 0; i < 4; ++i) { hv[i] = hv[i] + (f32x4){(float)op[j][2 * i].x, (float)op[j][2 * i].y, (float)op[j][2 * i + 1].x, (float)op[j][2 * i + 1].y};
                ss += (hv[i][0] * hv[i][0] + hv[i][1] * hv[i][1]) + (hv[i][2] * hv[i][2] + hv[i][3] * hv[i][3]); }
            ss = wave_sum(ss);
            bf16_t* bp = HBW + (size_t)tok * DM + 16 * lane;
            *(u32x4*)bp = (u32x4){cvtpk(hv[0][0], hv[0][1]), cvtpk(hv[0][2], hv[0][3]), cvtpk(hv[1][0], hv[1][1]), cvtpk(hv[1][2], hv[1][3])};
            *(u32x4*)(bp + 8) = (u32x4){cvtpk(hv[2][0], hv[2][1]), cvtpk(hv[2][2], hv[2][3]), cvtpk(hv[3][0], hv[3][1]), cvtpk(hv[3][2], hv[3][3])};
            if (lane == 0) R3W[tok] = rsqrtf(ss * (1.0f / 1024.0f) + EPS);
        }
    }
}

constexpr int N_PHASES = 9;
__global__ void __launch_bounds__(512, 2) mk_fwd(Params prm) {
    extern __shared__ __attribute__((aligned(16))) unsigned char lds_raw[];
    Ctx C; C.lds = (LAS unsigned char*)lds_raw; C.tid = threadIdx.x; C.lane = C.tid & 63; C.wave = __builtin_amdgcn_readfirstlane(C.tid >> 6);
    C.G = gridDim.x; { const int bx = blockIdx.x; C.vcu = (C.G % 8 == 0) ? (bx % 8) * (C.G / 8) + bx / 8 : bx; }
    C.p = &prm;
    unsigned char* ws = prm.ws;
    const int lo = prm.ph_lo, hi = prm.ph_hi;
#define IN(k) (lo <= (k) && (k) < hi)
    { volatile LAS unsigned* st = (volatile LAS unsigned*)(C.lds + LDS_BYTES - 64); if (C.tid < 2) st[C.tid] = 0u; __syncthreads(); }
    XcdBarrier xbar = xcd_barrier_post((unsigned*)(ws + WS_CTL) + 4096, (volatile LAS unsigned*)(C.lds + LDS_BYTES - 64));
#define SEAM(k) do { if (IN(k) && IN((k) + 1)) { xcd_barrier(xbar); } } while (0)
#if MK_COOP_SYNC0
    if (hi > N_PHASES) cg::this_grid().sync();
#endif
    bf16_t* ACTB = (bf16_t*)(ws + WS_ACTB); bf16_t* Z = (bf16_t*)(ws + WS_Z); bf16_t* YC = (bf16_t*)(ws + WS_YCAT); bf16_t* PPB = (bf16_t*)(ws + WS_PP);
    float* rowss2 = (float*)(ws + WS_CTL + WS_ROWSS2);
    if (IN(0)) { _Pragma("unroll 1") for (int rep = 0; rep <= PROBE_PREP; ++rep) { phase_prep(C); __syncthreads(); } }
    SEAM(0);
    if (IN(1)) for (int rep1 = 0; rep1 <= PROBE_G1; ++rep1) {
        { pg8::Gemm g{ACTB, (const bf16_t*)(ws + WS_WIN), M_TOK, 2048, 1024}; pg8::StaticOrder S; S.init(M_TOK, 2048, C.G, (int)blockIdx.x); pg8::EpiZ E{Z, ZLD, prm.in[I_QN], prm.in[I_KN], (const unsigned*)(ws + WS_CST)};
          pg8::gemm_phase<pg8::EpiZ, pg8::StaticOrder, true, true>(C.lds, g, S, E); }
        { pg8::Gemm g{(const bf16_t*)(ws + WS_PB), (const bf16_t*)(ws + WS_WP), M_TOK, 1024, 256}; pg8::StaticOrder S; S.init(M_TOK, 1024, C.G, (int)blockIdx.x); pg8::EpiStoreBf16 E{PPB, DM};
          pg8::gemm_phase<pg8::EpiStoreBf16, pg8::StaticOrder, true, true>(C.lds, g, S, E); }
    }
    SEAM(1);
    if (IN(2)) phase_rope_pool(C);
    for (int rep = 0; rep < PROBE_SYNC; ++rep) xcd_barrier(xbar);
    if (IN(3)) { _Pragma("unroll 1") for (int rep = 0; rep <= PROBE_ATTN; ++rep) phase_attn(C); }
    SEAM(3);
    if (IN(4)) { pg8::Gemm g{YC, (const bf16_t*)(ws + WS_WO), M_TOK, 1024, 1024}; pg8::StaticOrder S; S.init(M_TOK, 1024, C.G, (int)blockIdx.x); pg8::EpiWo E{prm.in[I_X], ACTB, rowss2};
        pg8::gemm_phase<pg8::EpiWo, pg8::StaticOrder, true, true>(C.lds, g, S, E); }
    SEAM(4);
    if (IN(5)) for (int rep5 = 0; rep5 <= PROBE_G5; ++rep5) { pg8::Gemm g{ACTB, (const bf16_t*)(ws + WS_WS), M_TOK, 2048, 1024}; pg8::StaticOrder S; S.init(M_TOK, 2048, C.G, (int)blockIdx.x); pg8::EpiScores E{(_Float16*)(ws + WS_Z), ZLD, rowss2};
        pg8::gemm_phase<pg8::EpiScores, pg8::StaticOrder, true, true>(C.lds, g, S, E); }
    SEAM(5);
    if (IN(6)) { _Pragma("unroll 1") for (int rep = 0; rep <= PROBE_TOPK; ++rep) phase_topk(C); }
    if (IN(6) && IN(7)) { asm volatile("s_waitcnt vmcnt(0)" ::: "memory"); __syncthreads(); } else { SEAM(6); }
    if (IN(7)) { _Pragma("unroll 1") for (int rep = 0; rep < PROBE_GATHER; ++rep) phase_gather(C, true); phase_gather(C); }
    SEAM(7);
    if (IN(8)) { pg8::Gemm g{ACTB, (const bf16_t*)(ws + WS_WG), M_TOK, 1024, 1024}; pg8::StaticOrder S; S.init(M_TOK, 1024, C.G, (int)blockIdx.x); pg8::EpiGate E{prm.out, ACTB, PPB, (const float*)(ws + WS_RINV3)};
        pg8::gemm_phase<pg8::EpiGate, pg8::StaticOrder, true, true>(C.lds, g, S, E); }
#undef IN
#undef SEAM
}

extern "C" void kernel_launch(void* const* d_in, const int* in_sizes, int n_in, void* d_out, int out_size, void* d_ws, size_t ws_size, hipStream_t stream) {
    static int grid = 0;
    if (grid == 0) {
        if (n_in != 23 || in_sizes[0] != M_TOK * DM || out_size != M_TOK * DM || ws_size < WS_END) { fprintf(stderr, "kernel_launch: unexpected shapes (n_in %d in0 %d out %d ws %zu)\n", n_in, n_in > 0 ? in_sizes[0] : -1, out_size, ws_size); grid = -1; return; }
        int dev = 0, cus = 0, per_cu = 0;
        hipGetDevice(&dev); hipDeviceGetAttribute(&cus, hipDeviceAttributeMultiprocessorCount, dev);
        hipFuncSetAttribute((const void*)mk_fwd, hipFuncAttributeMaxDynamicSharedMemorySize, LDS_BYTES);
        hipOccupancyMaxActiveBlocksPerMultiprocessor(&per_cu, (const void*)mk_fwd, 512, LDS_BYTES);
        if (per_cu < 1) { fprintf(stderr, "kernel_launch: occupancy query says %d blocks per CU\n", per_cu); per_cu = 1; }
        (void)hipGetLastError();
        grid = cus;
    }
    if (grid < 0) return;
    hipMemsetAsync((char*)d_ws + WS_CTL, 0, CTL_BYTES, stream);
    Params prm{};
    for (int i = 0; i < 23; ++i) prm.in[i] = (const float*)d_in[i];
    prm.out = (float*)d_out; prm.ws = (unsigned char*)d_ws;
#if MK_MULTI
    for (int ph = 0; ph < N_PHASES; ++ph) { prm.ph_lo = ph; prm.ph_hi = ph + 1; hipLaunchKernelGGL(mk_fwd, dim3(grid), dim3(512), LDS_BYTES, stream, prm); }
#else
    prm.ph_lo = 0; prm.ph_hi = N_PHASES;
#if MK_COOP_SYNC0
    void* args[] = {&prm};
    hipError_t e = hipLaunchCooperativeKernel((const void*)mk_fwd, dim3(grid), dim3(512), args, LDS_BYTES, stream);
    if (e != hipSuccess) fprintf(stderr, "cooperative launch failed: %s (grid %d)\n", hipGetErrorString(e), grid);
#else
    hipLaunchKernelGGL(mk_fwd, dim3(grid), dim3(512), LDS_BYTES, stream, prm);
#endif
#endif
}
```

```cpp
#include <hip/hip_runtime.h>
#include <hip/hip_cooperative_groups.h>
#include <cstdio>
#include <cstdint>
#include <cmath>
namespace cg = cooperative_groups;

#ifndef MK_COOP_SYNC0
#define MK_COOP_SYNC0 1
#endif
#ifndef MK_MULTI
#define MK_MULTI 0
#endif

#ifndef PROBE_ATTN2
#define PROBE_ATTN2 0
#endif
#ifndef PROBE_G1
#define PROBE_G1 0
#endif
#ifndef PROBE_G5
#define PROBE_G5 0
#endif
#ifndef PROBE_PREP
#define PROBE_PREP 0
#endif
#ifndef PROBE_ATTN
#define PROBE_ATTN 0
#endif
#ifndef PROBE_TOPK
#define PROBE_TOPK 0
#endif
#ifndef PROBE_GATHER
#define PROBE_GATHER 0
#endif
#ifndef PROBE_SYNC
#define PROBE_SYNC 0
#endif
#define LAS __attribute__((address_space(3)))
typedef unsigned short bf16_t;
typedef short bf16x8 __attribute__((ext_vector_type(8)));
typedef short s16x4 __attribute__((ext_vector_type(4)));
typedef float f32x4 __attribute__((ext_vector_type(4)));
typedef float f32x2 __attribute__((ext_vector_type(2)));
typedef float f32x16 __attribute__((ext_vector_type(16)));
typedef unsigned u32x4 __attribute__((ext_vector_type(4)));
typedef unsigned u32x2 __attribute__((ext_vector_type(2)));
typedef __bf16 bf16x2_t __attribute__((ext_vector_type(2)));
typedef _Float16 f16x8 __attribute__((ext_vector_type(8)));
typedef _Float16 f16x2 __attribute__((ext_vector_type(2)));

constexpr int M_TOK = 32768, DM = 1024, SEQ = 8192, NB = 4, ZLD = 2048, DPLE = 256;
constexpr float EPS = 1e-6f;
constexpr float U4SCALE = 64.0f, V4SCALE = 5.656854249f;
constexpr float QSCALE = 0.125f * 1.4426950408889634f;
constexpr size_t MiB = 1u << 20;
constexpr size_t WS_CTL = 0, CTL_BYTES = 1 * MiB;
constexpr size_t WS_ROWSS2 = 256 * 1024;
constexpr size_t WS_WIN = 1 * MiB, WS_WO = 5 * MiB, WS_WS = 7 * MiB, WS_WG = 11 * MiB, WS_WP = 13 * MiB, WS_RINV3 = 14 * MiB;
constexpr size_t WS_UT = 16 * MiB  , WS_VT = 48 * MiB  , WS_ACTB = 80 * MiB, WS_PB = 144 * MiB, WS_Z = 160 * MiB, WS_YCAT = 288 * MiB, WS_PP = 352 * MiB;
constexpr size_t WS_EIDX = 416 * MiB, WS_GATE = 432 * MiB, WS_CST = 448 * MiB, WS_END = 452 * MiB;
constexpr int LDS_BYTES = 147456;

__device__ __forceinline__ unsigned cvtpk(float lo, float hi) { f32x2 v = {lo, hi}; bf16x2_t b = __builtin_convertvector(v, bf16x2_t); return __builtin_bit_cast(unsigned, b); }
__device__ __forceinline__ float bflo(unsigned w) { return __uint_as_float(w << 16); }
__device__ __forceinline__ float bfhi(unsigned w) { return __uint_as_float(w & 0xffff0000u); }
__device__ __forceinline__ unsigned pack_i8(const f32x4 v) {
    int a = __float2int_rn(v[0]), b = __float2int_rn(v[1]), c = __float2int_rn(v[2]), d = __float2int_rn(v[3]);
    a = a < -127 ? -127 : (a > 127 ? 127 : a); b = b < -127 ? -127 : (b > 127 ? 127 : b); c = c < -127 ? -127 : (c > 127 ? 127 : c); d = d < -127 ? -127 : (d > 127 ? 127 : d);
    return ((unsigned)a & 0xffu) | (((unsigned)b & 0xffu) << 8) | (((unsigned)c & 0xffu) << 16) | ((unsigned)d << 24);
}
__device__ __forceinline__ unsigned pack_u4x8(const f32x4 a, const f32x4 b) {
    unsigned w = 0;
#pragma unroll
    for (int i = 0; i < 4; ++i) { int lo = __float2int_rn(a[i]), hi = __float2int_rn(b[i]); lo = lo < -8 ? -8 : (lo > 7 ? 7 : lo); hi = hi < -8 ? -8 : (hi > 7 ? 7 : hi);
        w |= ((unsigned)(lo + 8) | ((unsigned)(hi + 8) << 4)) << (8 * i); }
    return w;
}
__device__ __forceinline__ float wave_sum(float v) {
#pragma unroll
    for (int o = 1; o < 64; o <<= 1) v += __shfl_xor(v, o);
    return v;
}

namespace pg8 {
#define PG8_LAS __attribute__((address_space(3)))
constexpr int BM = 256, BK = 64, HALF = 128, HTB = HALF * BK * 2, STAGE_BYTES = 8 * HTB, NXCD = 8, WGM = 8;
__host__ __device__ __forceinline__ int lds_byte(int r, int c) { const int st = (r >> 4) * 2 + (c >> 5), rr = r & 15, cc = c & 31, ob = rr * 64 + cc * 2; return st * 1024 + (ob ^ (((ob >> 9) & 1) << 5)); }
__host__ __device__ __forceinline__ void stage_rc(int b, int& R, int& C) { const int st = b / 1024, sb = b % 1024, swz = sb ^ (((sb >> 9) & 1) << 5); R = (st >> 1) * 16 + swz / 64; C = (st & 1) * 32 + (swz % 64) / 2; }
__host__ __device__ __forceinline__ int perm32(int rho) { const int n = rho >> 4, i = rho & 15; return 8 * (i >> 2) + 4 * n + (i & 3); }
struct Unit { int pm, pn; };
struct Gemm { const bf16_t* A; const bf16_t* Bt; int M, N, K; };
struct StaticOrder {
    int nM, nN, nwg, G, c;
    __host__ __device__ void init(int M, int N, int G_, int c_) { nM = M / BM; nN = N / BM; nwg = nM * nN; G = G_; c = c_; }
    __host__ __device__ bool next(int i, Unit& u) const {
        const long L = (long)i * G + c; if (L >= nwg) return false;
        int wgid = (int)L; { const int q = nwg / NXCD, r = nwg % NXCD, xcd = wgid % NXCD, off = wgid / NXCD; wgid = (xcd < r ? xcd * (q + 1) : r * (q + 1) + (xcd - r) * q) + off; }
        const int nig = WGM * nN, gid = wgid / nig, fm = gid * WGM, gsz = (nM - fm) < WGM ? (nM - fm) : WGM;
        u.pm = fm + ((wgid % nig) % gsz); u.pn = (wgid % nig) / gsz; return true;
    }
    __device__ __forceinline__ void a_ready(const Unit&) const {}
    __device__ __forceinline__ void done(const Unit&) const {}
};
template <class Epi, class Sched, bool ALIGN_EPI = false, bool SP2 = false>
__device__ __forceinline__ void gemm_phase(PG8_LAS unsigned char* lds, const Gemm g, const Sched& S, const Epi& E) {
    int tid = threadIdx.x; asm volatile("" : "+v"(tid));
    const int wid = __builtin_amdgcn_readfirstlane(tid >> 6), lane = tid & 63, wr = wid >> 2, wc = wid & 3, fr = lane & 15, fq = lane >> 4;
    const int K = g.K, nt = K / BK;
    unsigned voffA[2], voffB[2];
#pragma unroll
    for (int i = 0; i < 2; ++i) { int R, C; stage_rc(tid * 16 + i * 8192, R, C); const int Rb = Epi::PAIRMAP ? (64 * (R >> 5) + perm32(R & 31)) : Epi::PERM ? ((R & ~31) + perm32(R & 31)) : R;
        voffA[i] = (unsigned)(R * K + C) * 2u; voffB[i] = (unsigned)(Rb * K + C) * 2u; }
    const size_t hstepB = (size_t)(Epi::PAIRMAP ? 32 : HALF) * K * 2;
    const size_t kstep = (size_t)(BK * 2);
    const size_t hstep = (size_t)HALF * K * 2;
    const size_t tstep = 2 * hstep;
    const unsigned ldsw = (unsigned)wid * 1024u;
    const int aoff = lds_byte(wr * 64 + fr, fq * 8), boff = lds_byte(wc * 32 + fr, fq * 8);
#define PG8_SA(b, h) (((b) * 2 + (h)) * HTB)
#define PG8_SB(b, h) ((4 + (b) * 2 + (h)) * HTB)
#define PG8_STAGE(bufoff, gbase, voff) do { _Pragma("unroll") for (int _i = 0; _i < 2; ++_i) \
        __builtin_amdgcn_global_load_lds((const unsigned*)((const char*)(gbase) + (voff)[_i]), (PG8_LAS unsigned*)(lds + (bufoff) + ldsw + _i * 8192), 16, 0, 0); } while (0)
#define PG8_LDA(dst, b, h) do { _Pragma("unroll") for (int m = 0; m < 4; ++m) _Pragma("unroll") for (int k = 0; k < 2; ++k) dst[m][k] = *(const PG8_LAS bf16x8*)(lds + PG8_SA(b, h) + aoff + m * 2048 + k * 1024); } while (0)
#define PG8_LDB(dst, b, h) do { _Pragma("unroll") for (int n = 0; n < 2; ++n) _Pragma("unroll") for (int k = 0; k < 2; ++k) dst[n][k] = *(const PG8_LAS bf16x8*)(lds + PG8_SB(b, h) + boff + n * 2048 + k * 1024); } while (0)
#define PG8_MMA(ai, bj, At, Bt) do { __builtin_amdgcn_s_setprio(1); _Pragma("unroll") for (int m = 0; m < 4; ++m) _Pragma("unroll") for (int n = 0; n < 2; ++n) _Pragma("unroll") for (int k = 0; k < 2; ++k) \
        acc[ai][bj][m][n] = __builtin_amdgcn_mfma_f32_16x16x32_bf16(Bt[n][k], At[m][k], acc[ai][bj][m][n], 0, 0, 0); __builtin_amdgcn_s_setprio(0); } while (0)
#define PG8_WAIT_V(n) asm volatile("s_waitcnt vmcnt(" #n ")" ::: "memory")
#define PG8_WAIT_L(n) asm volatile("s_waitcnt lgkmcnt(" #n ")" ::: "memory")
#define PG8_BAR __builtin_amdgcn_s_barrier()
#define PG8_SCHED __builtin_amdgcn_sched_barrier(0)
    Unit cur, nxt; int ui = 0;
    if (!S.next(0, cur)) return;
    f32x4 acc[2][2][4][2];
#pragma unroll
    for (int a = 0; a < 2; ++a)
#pragma unroll
        for (int b = 0; b < 2; ++b)
#pragma unroll
            for (int m = 0; m < 4; ++m)
#pragma unroll
                for (int n = 0; n < 2; ++n) acc[a][b][m][n] = (f32x4){0.f, 0.f, 0.f, 0.f};
    bf16x8 At[4][2], B0[2][2], B1[2][2];
    const char* cA = (const char*)g.A + (size_t)cur.pm * tstep; const char* cB = (const char*)g.Bt + (size_t)cur.pn * tstep;
    S.a_ready(cur);
    if constexpr (SP2) {
        PG8_STAGE(PG8_SB(0, 0), cB, voffB); PG8_STAGE(PG8_SB(0, 1), cB + hstepB, voffB); PG8_STAGE(PG8_SA(0, 0), cA, voffA); PG8_STAGE(PG8_SA(0, 1), cA + hstep, voffA);
        if (wr == 1) PG8_BAR;
        PG8_WAIT_V(2); PG8_BAR;
        PG8_STAGE(PG8_SB(1, 0), cB + kstep, voffB); PG8_STAGE(PG8_SA(1, 0), cA + kstep, voffA); PG8_STAGE(PG8_SB(1, 1), cB + hstepB + kstep, voffB);
        PG8_WAIT_V(6); PG8_BAR;
    } else {
        PG8_STAGE(PG8_SB(0, 0), cB, voffB); PG8_STAGE(PG8_SA(0, 0), cA, voffA); PG8_STAGE(PG8_SB(0, 1), cB + hstepB, voffB); PG8_STAGE(PG8_SA(0, 1), cA + hstep, voffA);
        if (wr == 1) PG8_BAR;
        PG8_WAIT_V(4); PG8_BAR;
        PG8_STAGE(PG8_SB(1, 0), cB + kstep, voffB); PG8_STAGE(PG8_SA(1, 0), cA + kstep, voffA); PG8_STAGE(PG8_SB(1, 1), cB + hstepB + kstep, voffB);
        PG8_WAIT_V(6); PG8_BAR;
    }
    for (;;) {
        const bool has_next = S.next(ui + 1, nxt);
        const char* nA = has_next ? (const char*)g.A + (size_t)nxt.pm * tstep : cA; const char* nB = has_next ? (const char*)g.Bt + (size_t)nxt.pn * tstep : cB;
#pragma unroll 1
        for (int t = 0; t < nt; t += 2) {
            const bool last = (t == nt - 2);
            const char* a1 = cA + (size_t)(t + 1) * kstep;
            const char* a2 = last ? nA : cA + (size_t)(t + 2) * kstep; const char* b2 = last ? nB : cB + (size_t)(t + 2) * kstep;
            const char* a3 = a2 + kstep; const char* b3 = b2 + kstep;
            if (last && has_next) S.a_ready(nxt);
            if constexpr (SP2) {
            PG8_LDB(B0, 0, 0); PG8_LDB(B1, 0, 1); PG8_SCHED; PG8_LDA(At, 0, 0); PG8_STAGE(PG8_SA(1, 1), a1 + hstep, voffA);
            PG8_WAIT_V(8); PG8_WAIT_L(0); PG8_BAR; PG8_MMA(0, 0, At, B0); PG8_MMA(0, 1, At, B1); PG8_BAR; PG8_SCHED;
            PG8_LDA(At, 0, 1); PG8_STAGE(PG8_SB(0, 0), b2, voffB); PG8_STAGE(PG8_SB(0, 1), b2 + hstepB, voffB); PG8_STAGE(PG8_SA(0, 0), a2, voffA);
            PG8_WAIT_V(8); PG8_WAIT_L(0); PG8_BAR; PG8_MMA(1, 0, At, B0); PG8_MMA(1, 1, At, B1); PG8_BAR; PG8_SCHED;
            PG8_LDB(B0, 1, 0); PG8_LDB(B1, 1, 1); PG8_SCHED; PG8_LDA(At, 1, 0); PG8_STAGE(PG8_SA(0, 1), a2 + hstep, voffA);
            PG8_WAIT_V(8); PG8_WAIT_L(0); PG8_BAR; PG8_MMA(0, 0, At, B0); PG8_MMA(0, 1, At, B1); PG8_BAR; PG8_SCHED;
            PG8_LDA(At, 1, 1); PG8_STAGE(PG8_SB(1, 0), b3, voffB); PG8_STAGE(PG8_SB(1, 1), b3 + hstepB, voffB); PG8_STAGE(PG8_SA(1, 0), a3, voffA);
            PG8_WAIT_V(8); PG8_WAIT_L(0); PG8_BAR; PG8_MMA(1, 0, At, B0); PG8_MMA(1, 1, At, B1); PG8_BAR; PG8_SCHED;
            } else {
            PG8_LDB(B0, 0, 0); PG8_SCHED; PG8_LDA(At, 0, 0); PG8_STAGE(PG8_SA(1, 1), a1 + hstep, voffA);
            PG8_WAIT_L(8); PG8_BAR; PG8_WAIT_L(0); PG8_MMA(0, 0, At, B0); PG8_BAR; PG8_SCHED;
            PG8_LDB(B1, 0, 1); PG8_STAGE(PG8_SB(0, 0), b2, voffB);
            PG8_BAR; PG8_WAIT_L(0); PG8_MMA(0, 1, At, B1); PG8_BAR;
            PG8_LDA(At, 0, 1); PG8_STAGE(PG8_SA(0, 0), a2, voffA);
            PG8_BAR; PG8_WAIT_L(0); PG8_MMA(1, 0, At, B0); PG8_BAR; PG8_SCHED;
            PG8_STAGE(PG8_SB(0, 1), b2 + hstepB, voffB);
            PG8_WAIT_V(6); PG8_BAR; PG8_MMA(1, 1, At, B1); PG8_BAR;
            PG8_LDB(B0, 1, 0); PG8_SCHED; PG8_LDA(At, 1, 0); PG8_STAGE(PG8_SA(0, 1), a2 + hstep, voffA);
            PG8_WAIT_L(8); PG8_BAR; PG8_WAIT_L(0); PG8_MMA(0, 0, At, B0); PG8_BAR; PG8_SCHED;
            PG8_LDB(B1, 1, 1); PG8_STAGE(PG8_SB(1, 0), b3, voffB);
            PG8_BAR; PG8_WAIT_L(0); PG8_MMA(0, 1, At, B1); PG8_BAR;
            PG8_LDA(At, 1, 1); PG8_STAGE(PG8_SA(1, 0), a3, voffA);
            PG8_BAR; PG8_WAIT_L(0); PG8_MMA(1, 0, At, B0); PG8_BAR; PG8_SCHED;
            PG8_STAGE(PG8_SB(1, 1), b3 + hstepB, voffB);
            PG8_WAIT_V(6); PG8_BAR; PG8_MMA(1, 1, At, B1); PG8_BAR;
            }
        }
        if constexpr (ALIGN_EPI) { if (wr == 0) PG8_BAR; }
        if constexpr (!Epi::AFTER_DRAIN) { E(acc, cur, wr, wc, fr, fq); S.done(cur); }
        if (!has_next) break;
#pragma unroll
        for (int a = 0; a < 2; ++a)
#pragma unroll
            for (int b = 0; b < 2; ++b)
#pragma unroll
                for (int m = 0; m < 4; ++m)
#pragma unroll
                    for (int n = 0; n < 2; ++n) acc[a][b][m][n] = (f32x4){0.f, 0.f, 0.f, 0.f};
        cur = nxt; cA = nA; cB = nB; ++ui;
        if constexpr (ALIGN_EPI) { if (wr == 1) PG8_BAR; }
    }
    PG8_WAIT_V(0);
    if constexpr (!ALIGN_EPI) { if (wr == 0) PG8_BAR; }
    PG8_BAR;
#undef PG8_SA
#undef PG8_SB
#undef PG8_STAGE
#undef PG8_LDA
#undef PG8_LDB
#undef PG8_MMA
#undef PG8_WAIT_V
#undef PG8_WAIT_L
#undef PG8_BAR
#undef PG8_SCHED
}

struct EpiStoreBf16 {
    static constexpr bool PERM = true, AFTER_DRAIN = false, PAIRMAP = false;
    bf16_t* O; int ldc;
    __device__ __forceinline__ void operator()(const f32x4 (&acc)[2][2][4][2], const Unit& u, int wr, int wc, int fr, int fq) const {
        const int row0 = u.pm * BM + wr * 64 + fr, col0 = u.pn * BM + wc * 32 + 8 * fq;
#pragma unroll
        for (int ai = 0; ai < 2; ++ai)
#pragma unroll
            for (int m = 0; m < 4; ++m) { bf16_t* rowp = O + (size_t)(row0 + ai * HALF + m * 16) * ldc + col0;
#pragma unroll
                for (int bj = 0; bj < 2; ++bj) { const f32x4 v0 = acc[ai][bj][m][0], v1 = acc[ai][bj][m][1];
                    u32x4 w; w.x = cvtpk(v0[0], v0[1]); w.y = cvtpk(v0[2], v0[3]); w.z = cvtpk(v1[0], v1[1]); w.w = cvtpk(v1[2], v1[3]);
                    *(u32x4*)(rowp + bj * HALF) = w; } }
    }
};
typedef _Float16 hf2 __attribute__((ext_vector_type(2)));
struct EpiZ {
    static constexpr bool PERM = true, AFTER_DRAIN = false, PAIRMAP = true;
    bf16_t* O; int ldc; const float* qn; const float* kn; const unsigned* cst;
    __device__ __forceinline__ void operator()(const f32x4 (&acc)[2][2][4][2], const Unit& u, int wr, int wc, int fr, int fq) const {
        asm volatile("" : "+v"(fr), "+v"(fq));
        const int row0 = u.pm * BM + wr * 64 + fr, col0 = u.pn * BM + wc * 64 + 8 * fq;
        const int kind = u.pn >> 1;
        if (kind == 0 || kind == 3) {
#pragma unroll
            for (int ai = 0; ai < 2; ++ai)
#pragma unroll
                for (int m = 0; m < 4; ++m) { bf16_t* rowp = O + (size_t)(row0 + ai * HALF + m * 16) * ldc + col0;
#pragma unroll
                    for (int bj = 0; bj < 2; ++bj) { const f32x4 v0 = acc[ai][bj][m][0], v1 = acc[ai][bj][m][1];
                        u32x4 w; w.x = cvtpk(v0[0], v0[1]); w.y = cvtpk(v0[2], v0[3]); w.z = cvtpk(v1[0], v1[1]); w.w = cvtpk(v1[2], v1[3]);
                        *(u32x4*)(rowp + bj * 32) = w; } }
            return;
        }
        const float* gn = kind == 1 ? qn : kn; const float osc = kind == 1 ? QSCALE : 1.0f;
        float g1[8], g2[8];
#pragma unroll
        for (int t = 0; t < 8; ++t) { g1[t] = gn[8 * fq + t] * osc; g2[t] = gn[32 + 8 * fq + t] * osc; }
        const unsigned* cp = cst + (size_t)row0 * 32 + 8 * fq;
        u32x4 c0 = *(const u32x4*)cp, c1 = *(const u32x4*)(cp + 4);
#pragma unroll
        for (int it = 0; it < 8; ++it) {
            const int ai = it >> 2, m = it & 3, row = row0 + ai * HALF + m * 16;
            u32x4 n0 = c0, n1 = c1;
            if (it < 7) { const unsigned* np = cp + (size_t)(((it + 1) >> 2) * HALF + ((it + 1) & 3) * 16) * 32; n0 = *(const u32x4*)np; n1 = *(const u32x4*)(np + 4); }
            const unsigned cw[8] = {c0.x, c0.y, c0.z, c0.w, c1.x, c1.y, c1.z, c1.w};
            float t1[8], t2[8];
#pragma unroll
            for (int t = 0; t < 8; ++t) { t1[t] = acc[ai][0][m][t >> 2][t & 3]; t2[t] = acc[ai][1][m][t >> 2][t & 3]; }
            float ss = 0.f;
#pragma unroll
            for (int t = 0; t < 8; ++t) ss += t1[t] * t1[t] + t2[t] * t2[t];
            ss += __shfl_xor(ss, 16); ss += __shfl_xor(ss, 32);
            const float ri = rsqrtf(ss * (1.0f / 64.0f) + EPS);
            float o1[8], o2[8];
#pragma unroll
            for (int t = 0; t < 8; ++t) {
                const hf2 cs2 = __builtin_bit_cast(hf2, cw[t]); const float cs = (float)cs2[0], sn = (float)cs2[1];
                const float x1 = t1[t] * (ri * g1[t]), x2 = t2[t] * (ri * g2[t]);
                o1[t] = x1 * cs - x2 * sn; o2[t] = x2 * cs + x1 * sn;
            }
            bf16_t* rowp = O + (size_t)row * ldc + col0;
            *(u32x4*)rowp = (u32x4){cvtpk(o1[0], o1[1]), cvtpk(o1[2], o1[3]), cvtpk(o1[4], o1[5]), cvtpk(o1[6], o1[7])};
            *(u32x4*)(rowp + 32) = (u32x4){cvtpk(o2[0], o2[1]), cvtpk(o2[2], o2[3]), cvtpk(o2[4], o2[5]), cvtpk(o2[6], o2[7])};
            __builtin_amdgcn_sched_barrier(0);
            c0 = n0; c1 = n1;
        }
    }
};
struct EpiScores {
    static constexpr bool PERM = true, AFTER_DRAIN = false, PAIRMAP = false;
    _Float16* O; int ldc; const float* rowss;
    __device__ __forceinline__ void operator()(const f32x4 (&acc)[2][2][4][2], const Unit& u, int wr, int wc, int fr, int fq) const {
        const int row0 = u.pm * BM + wr * 64 + fr, col0 = u.pn * BM + wc * 32 + 8 * fq;
#pragma unroll
        for (int ai = 0; ai < 2; ++ai)
#pragma unroll
            for (int m = 0; m < 4; ++m) { const int row = row0 + ai * HALF + m * 16; const float ri = rsqrtf(rowss[row] * (1.0f / 1024.0f) + EPS);
                _Float16* rowp = O + (size_t)row * ldc + col0;
#pragma unroll
                for (int bj = 0; bj < 2; ++bj) { const f32x4 v0 = acc[ai][bj][m][0] * ri, v1 = acc[ai][bj][m][1] * ri;
                    f16x8 w = {(_Float16)v0[0], (_Float16)v0[1], (_Float16)v0[2], (_Float16)v0[3], (_Float16)v1[0], (_Float16)v1[1], (_Float16)v1[2], (_Float16)v1[3]};
                    *(f16x8*)(rowp + bj * HALF) = w; } }
    }
};
struct EpiWo {
    static constexpr bool PERM = false, AFTER_DRAIN = false, PAIRMAP = false;
    const float* X; bf16_t* HB; float* rowss;
    __device__ __forceinline__ void operator()(const f32x4 (&acc)[2][2][4][2], const Unit& u, int wr, int wc, int fr, int fq) const {
        const int row0 = u.pm * BM + wr * 64 + fr, col0 = u.pn * BM + wc * 32 + 4 * fq;
#pragma unroll
        for (int ai = 0; ai < 2; ++ai)
#pragma unroll
            for (int m = 0; m < 4; ++m) { const int row = row0 + ai * HALF + m * 16; const size_t off = (size_t)row * DM + col0; float ss = 0.f;
#pragma unroll
                for (int bj = 0; bj < 2; ++bj)
#pragma unroll
                    for (int n = 0; n < 2; ++n) { const size_t o2 = off + bj * HALF + n * 16; const f32x4 h = *(const f32x4*)(X + o2) + acc[ai][bj][m][n];
                        u32x2 w; w.x = cvtpk(h[0], h[1]); w.y = cvtpk(h[2], h[3]); *(u32x2*)(HB + o2) = w;
                        ss += (h[0] * h[0] + h[1] * h[1]) + (h[2] * h[2] + h[3] * h[3]); }
                ss += __shfl_xor(ss, 16); ss += __shfl_xor(ss, 32);
                if (fq == 0) atomicAdd(rowss + row, ss); }
    }
};
struct EpiGate {
    static constexpr bool PERM = false, AFTER_DRAIN = false, PAIRMAP = false;
    float* HO; const bf16_t* HB; const bf16_t* PP; const float* rinv;
    __device__ __forceinline__ void operator()(const f32x4 (&acc)[2][2][4][2], const Unit& u, int wr, int wc, int fr, int fq) const {
        const int row0 = u.pm * BM + wr * 64 + fr, col0 = u.pn * BM + wc * 32 + 4 * fq;
#pragma unroll
        for (int ai = 0; ai < 2; ++ai)
#pragma unroll
            for (int m = 0; m < 4; ++m) { const int row = row0 + ai * HALF + m * 16; const size_t off = (size_t)row * DM + col0; const float ri = rinv[row];
#pragma unroll
                for (int bj = 0; bj < 2; ++bj)
#pragma unroll
                    for (int n = 0; n < 2; ++n) { const size_t o2 = off + bj * HALF + n * 16; const u32x2 hw = *(const u32x2*)(HB + o2); const f32x4 h = {bflo(hw.x), bfhi(hw.x), bflo(hw.y), bfhi(hw.y)}; const u32x2 pw = *(const u32x2*)(PP + o2);
                        const f32x4 a = acc[ai][bj][m][n] * ri; f32x4 o;
                        o[0] = h[0] + bflo(pw.x) / (1.0f + __expf(-a[0])); o[1] = h[1] + bfhi(pw.x) / (1.0f + __expf(-a[1]));
                        o[2] = h[2] + bflo(pw.y) / (1.0f + __expf(-a[2])); o[3] = h[3] + bfhi(pw.y) / (1.0f + __expf(-a[3]));
                        *(f32x4*)(HO + o2) = o; } }
    }
};
}

#define XB_TMO      128
#define XB_XCNT(j)  (256  + 64 * (j))
#define XB_XSUB(j)  (1280 + 64 * (j))
#define XB_XGEN(j)  (2304 + 64 * (j))
#define XB_TOP      3328
#define XB_TOPGEN   3392
#define XCD_BAR_WORDS 3456
#define XB_SPIN_CAP (1u << 18)
__device__ __forceinline__ unsigned xb_ld(unsigned* p)              { return __hip_atomic_load(p, __ATOMIC_RELAXED, __HIP_MEMORY_SCOPE_AGENT); }
__device__ __forceinline__ unsigned xb_add(unsigned* p, unsigned v) { return __hip_atomic_fetch_add(p, v, __ATOMIC_RELAXED, __HIP_MEMORY_SCOPE_AGENT); }
__device__ __forceinline__ unsigned xb_xcc_id() { return (unsigned)__builtin_amdgcn_s_getreg((3 << 11) | 20) & 0xFu; }
#define XB_SPIN(cond, bar) do { unsigned _sp = 0; while (cond) { __builtin_amdgcn_s_sleep(1); \
    if ((++_sp & 255u) == 0u) { if (xb_ld(&(bar)[XB_TMO])) break; if (_sp > XB_SPIN_CAP) { atomicAdd(&(bar)[XB_TMO], 1u); break; } } } } while (0)
struct XcdBarrier { unsigned* bar; unsigned x; volatile LAS unsigned* st; };
__device__ __forceinline__ XcdBarrier xcd_barrier_post(unsigned* bar, volatile LAS unsigned* st) {
    XcdBarrier b; b.bar = bar; b.x = xb_xcc_id(); b.st = st;
    if (threadIdx.x == 0) (void)xb_add(&bar[XB_XCNT(b.x)], 1u);
    return b;
}
__device__ __forceinline__ void xcd_barrier_complete(unsigned* bar, unsigned x, unsigned& nloc, unsigned& nx) {
    const unsigned G = gridDim.x * gridDim.y * gridDim.z;
    unsigned sum, cnt, mine, sp = 0u;
    for (;;) {
        sum = 0u; cnt = 0u; mine = 0u;
#pragma unroll
        for (unsigned j = 0; j < 16; ++j) { const unsigned c = xb_ld(&bar[XB_XCNT(j)]); sum += c; cnt += (c > 0u) ? 1u : 0u; mine = (j == x) ? c : mine; }
        if (sum == G) break;
        __builtin_amdgcn_s_sleep(1);
        if ((++sp & 255u) == 0u) { if (xb_ld(&bar[XB_TMO])) break; if (sp > XB_SPIN_CAP) { atomicAdd(&bar[XB_TMO], 1u); break; } }
    }
    nloc = mine > 0u ? mine : 1u; nx = cnt > 0u ? cnt : 1u;
}
__device__ __forceinline__ void xcd_barrier(const XcdBarrier& b) {
    asm volatile("s_waitcnt vmcnt(0)" ::: "memory");
    __syncthreads();
    if (threadIdx.x == 0) {
        unsigned* bar = b.bar;
        __builtin_amdgcn_s_waitcnt(0);
        unsigned nloc = b.st[0], nx = b.st[1];
        if (nloc == 0u) { xcd_barrier_complete(bar, b.x, nloc, nx); b.st[0] = nloc; b.st[1] = nx; }
        const unsigned old = xb_add(&bar[XB_XSUB(b.x)], 1u);
        const unsigned gen = old / nloc;
        if (old + 1u == (gen + 1u) * nloc) {
            __builtin_amdgcn_fence(__ATOMIC_RELEASE, "agent");
            asm volatile("s_waitcnt vmcnt(0)" ::: "memory");
            const unsigned og = xb_add(&bar[XB_TOP], 1u);
            const unsigned tg = og / nx;
            if (og + 1u == (tg + 1u) * nx) xb_add(&bar[XB_TOPGEN], 1u);
            else XB_SPIN(xb_ld(&bar[XB_TOPGEN]) == tg, bar);
            __builtin_amdgcn_fence(__ATOMIC_ACQUIRE, "agent");
            xb_add(&bar[XB_XGEN(b.x)], 1u);
            asm volatile("s_waitcnt vmcnt(0)" ::: "memory");
        } else {
            XB_SPIN(xb_ld(&bar[XB_XGEN(b.x)]) == gen, bar);
            __builtin_amdgcn_fence(__ATOMIC_ACQUIRE, "agent");
            asm volatile("s_waitcnt vmcnt(0)" ::: "memory");
        }
    }
    __syncthreads();
}

struct Params { const float* in[23]; float* out; unsigned char* ws; int ph_lo, ph_hi; };
enum { I_X = 0, I_P, I_POS, I_LNMIX, I_WIN, I_POOLW, I_POOLS, I_QN, I_KN, I_LQ1, I_LK1, I_LQ2, I_LK2, I_SUBLN, I_WO, I_LNFFN, I_WPQ, I_SUBK, I_PU, I_PV, I_LNPE, I_WG, I_WPP };

struct Ctx {
    LAS unsigned char* lds; int tid, lane, wave, G, vcu;
    const Params* p;
};

__device__ __forceinline__ void transpose_item(const float* W, int ldw, int coff, const float* gain, bf16_t* WT, int ldk, int roff, int nblk, LAS float* scr, int item, int lane) {
    const int kb = item / nblk, nb = item % nblk, k0 = 64 * kb, n0 = 32 * nb;
#pragma unroll 8
    for (int i = 0; i < 32; ++i) { const int kk = 2 * i + (lane >> 5); const float gsc = gain ? gain[k0 + kk] : 1.0f; scr[kk * 33 + (lane & 31)] = W[(size_t)(k0 + kk) * ldw + coff + n0 + (lane & 31)] * gsc; }
    asm volatile("s_waitcnt lgkmcnt(0)" ::: "memory");
    const int c = lane & 7;
#pragma unroll
    for (int j = 0; j < 4; ++j) { const int n = (lane >> 3) + 8 * j; const LAS float* s = scr + (8 * c) * 33 + n;
        u32x4 o; o.x = cvtpk(s[0 * 33], s[1 * 33]); o.y = cvtpk(s[2 * 33], s[3 * 33]); o.z = cvtpk(s[4 * 33], s[5 * 33]); o.w = cvtpk(s[6 * 33], s[7 * 33]);
        *(u32x4*)(WT + (size_t)(roff + n0 + n) * ldk + k0 + 8 * c) = o; }
    asm volatile("s_waitcnt lgkmcnt(0)" ::: "memory");
}

template <int ROWS, bool POOL> __device__ __forceinline__ void fold_items(const Ctx& C) {
    const Params& P = *C.p; unsigned char* ws = P.ws; const int tid = C.tid;
    bf16_t* WinT = (bf16_t*)(ws + WS_WIN); bf16_t* WsT = (bf16_t*)(ws + WS_WS);
    constexpr int KT = 1024 / ROWS, NIT = (POOL ? 4 : 16) * KT, RPT = ROWS / 4;
    LAS float* As = (LAS float*)C.lds;
    LAS float* Bs = (LAS float*)(C.lds + 32768);
    for (int it = blockIdx.x; it < NIT; it += C.G) {
        const int blk = it / KT, k0 = (it % KT) * ROWS;
        const float* Asrc = (POOL ? P.in[I_WIN] : P.in[I_WPQ]) + blk * 128;
        const float* Bsrc = (POOL ? P.in[I_POOLW] : P.in[I_SUBK]) + (size_t)blk * 128 * 128;
#pragma unroll
        for (int i = 0; i < ROWS / 16; ++i) { const int v = tid + 512 * i, r = v >> 5, c4 = v & 31; *(LAS f32x4*)(As + r * 128 + c4 * 4) = *(const f32x4*)(Asrc + (size_t)(k0 + r) * 2048 + c4 * 4); }
        { f32x4 bv[8];
#pragma unroll
          for (int i = 0; i < 8; ++i) bv[i] = *(const f32x4*)(Bsrc + 4 * (tid + 512 * i));
#pragma unroll
          for (int i = 0; i < 8; ++i) { const int idx = 4 * (tid + 512 * i), r = idx >> 7, c = idx & 127;
#pragma unroll
              for (int q = 0; q < 4; ++q) { if (POOL) Bs[r * 129 + c + q] = bv[i][q]; else Bs[(c + q) * 129 + r] = bv[i][q]; } } }
        __syncthreads();
        const int n = tid & 127, kg = tid >> 7;
        float acc[RPT];
#pragma unroll
        for (int i = 0; i < RPT; ++i) acc[i] = 0.f;
        for (int c = 0; c < 128; c += 4) {
            const float b0 = Bs[(c + 0) * 129 + n], b1 = Bs[(c + 1) * 129 + n], b2 = Bs[(c + 2) * 129 + n], b3 = Bs[(c + 3) * 129 + n];
#pragma unroll
            for (int i = 0; i < RPT; ++i) { const f32x4 a = *(const LAS f32x4*)(As + (kg * RPT + i) * 128 + c); acc[i] += a[0] * b0 + a[1] * b1 + a[2] * b2 + a[3] * b3; }
        }
        const float cs = POOL ? P.in[I_POOLS][blk * 128 + n] : 1.0f; const float* gain = POOL ? P.in[I_LNMIX] : P.in[I_LNFFN];
        bf16_t* dst = (POOL ? WinT : WsT) + (size_t)(blk * 128 + n) * 1024 + k0 + kg * RPT;
        float v[RPT];
#pragma unroll
        for (int i = 0; i < RPT; ++i) v[i] = acc[i] * cs * gain[k0 + kg * RPT + i];
#pragma unroll
        for (int i = 0; i < RPT; i += 4) *(u32x2*)(dst + i) = (u32x2){cvtpk(v[i], v[i + 1]), cvtpk(v[i + 2], v[i + 3])};
        __syncthreads();
    }
}

__device__ __forceinline__ void phase_prep(const Ctx& C) {
    const Params& P = *C.p; unsigned char* ws = P.ws; const int tid = C.tid, lane = C.lane;
    bf16_t* WinT = (bf16_t*)(ws + WS_WIN); bf16_t* WoT = (bf16_t*)(ws + WS_WO); bf16_t* WsT = (bf16_t*)(ws + WS_WS); bf16_t* WgT = (bf16_t*)(ws + WS_WG); bf16_t* WpT = (bf16_t*)(ws + WS_WP);
    fold_items<16, true>(C);
    {
        LAS float* scr = (LAS float*)(C.lds + C.wave * 8448);
        const int gw = C.vcu * 8 + C.wave, NGW = C.G * 8;
        constexpr int I1 = 16 * 48, I2 = 16 * 32, I3 = 16 * 32, I4 = 4 * 32;
        for (int it = gw; it < I1 + I2 + I3 + I4; it += NGW) {
            int r = it;
            if (r < I1) { transpose_item(P.in[I_WIN], 2048, 512, P.in[I_LNMIX], WinT, 1024, 512, 48, scr, r, lane); continue; } r -= I1;
            if (r < I2) { transpose_item(P.in[I_WO], 1024, 0, nullptr, WoT, 1024, 0, 32, scr, r, lane); continue; } r -= I2;
            if (r < I3) { transpose_item(P.in[I_WG], 1024, 0, P.in[I_LNPE], WgT, 1024, 0, 32, scr, r, lane); continue; } r -= I3;
            transpose_item(P.in[I_WPP], 1024, 0, nullptr, WpT, 256, 0, 32, scr, r, lane);
        }
        bf16_t* XB = (bf16_t*)(ws + WS_ACTB);
        for (int m0 = gw; m0 < M_TOK; m0 += 4 * NGW) {
            f32x4 v[4][4]; float s[4];
#pragma unroll
            for (int q = 0; q < 4; ++q) { const int m = m0 + q * NGW; const f32x4* xr = (const f32x4*)(P.in[I_X] + (size_t)(m < M_TOK ? m : m0) * DM) + lane;
#pragma unroll
                for (int j = 0; j < 4; ++j) v[q][j] = xr[64 * j]; }
#pragma unroll
            for (int q = 0; q < 4; ++q) { s[q] = 0.f;
#pragma unroll
                for (int j = 0; j < 4; ++j) s[q] += (v[q][j][0] * v[q][j][0] + v[q][j][1] * v[q][j][1]) + (v[q][j][2] * v[q][j][2] + v[q][j][3] * v[q][j][3]); }
#pragma unroll
            for (int q = 0; q < 4; ++q) { const int m = m0 + q * NGW; if (m >= M_TOK) break;
                const float ri = rsqrtf(wave_sum(s[q]) * (1.0f / DM) + EPS);
                u32x2* o = (u32x2*)(XB + (size_t)m * DM) + lane;
#pragma unroll
                for (int j = 0; j < 4; ++j) { u32x2 w; w.x = cvtpk(v[q][j][0] * ri, v[q][j][1] * ri); w.y = cvtpk(v[q][j][2] * ri, v[q][j][3] * ri); o[64 * j] = w; } }
        }
    }
    {
        const size_t gt = (size_t)C.vcu * 512 + tid, NT = (size_t)C.G * 512;
        { const float* s = P.in[I_P]; bf16_t* d = (bf16_t*)(ws + WS_PB); const size_t n = (size_t)M_TOK * DPLE / 8;
          for (size_t i0 = gt; i0 < n; i0 += 4 * NT) { f32x4 v0[4], v1[4];
#pragma unroll
              for (int q = 0; q < 4; ++q) { const size_t i = i0 + q * NT < n ? i0 + q * NT : i0; v0[q] = *(const f32x4*)(s + i * 8); v1[q] = *(const f32x4*)(s + i * 8 + 4); }
#pragma unroll
              for (int q = 0; q < 4; ++q) { const size_t i = i0 + q * NT; if (i >= n) break;
                  u32x4 w; w.x = cvtpk(v0[q][0], v0[q][1]); w.y = cvtpk(v0[q][2], v0[q][3]); w.z = cvtpk(v1[q][0], v1[q][1]); w.w = cvtpk(v1[q][2], v1[q][3]); *(u32x4*)(d + i * 8) = w; } } }
        { const float* s = P.in[I_PV]; unsigned char* d = ws + WS_UT; const size_t n = (size_t)16384 * 1024 / 16;
          for (size_t i0 = gt; i0 < n; i0 += 2 * NT) { f32x4 v[2][4];
#pragma unroll
              for (int q = 0; q < 2; ++q) { const size_t i = i0 + q * NT < n ? i0 + q * NT : i0;
#pragma unroll
                  for (int c = 0; c < 4; ++c) v[q][c] = *(const f32x4*)(s + i * 16 + 4 * c) * V4SCALE; }
#pragma unroll
              for (int q = 0; q < 2; ++q) { const size_t i = i0 + q * NT; if (i >= n) break; u32x2 o;
#pragma unroll
                  for (int c = 0; c < 2; ++c) { unsigned w = 0;
                      w = __builtin_amdgcn_cvt_scalef32_pk_fp4_f32(w, v[q][2 * c][0], v[q][2 * c][1], 1.0f, 0); w = __builtin_amdgcn_cvt_scalef32_pk_fp4_f32(w, v[q][2 * c][2], v[q][2 * c][3], 1.0f, 1);
                      w = __builtin_amdgcn_cvt_scalef32_pk_fp4_f32(w, v[q][2 * c + 1][0], v[q][2 * c + 1][1], 1.0f, 2); w = __builtin_amdgcn_cvt_scalef32_pk_fp4_f32(w, v[q][2 * c + 1][2], v[q][2 * c + 1][3], 1.0f, 3); o[c] = w; }
                  *(u32x2*)(d + (i >> 6) * 1024 + 512 + (i & 63) * 8) = o; } } }
        { const int* pos = (const int*)P.in[I_POS]; unsigned* cst = (unsigned*)(ws + WS_CST);
          for (size_t i = gt; i < (size_t)M_TOK * 4; i += NT) { const int m = (int)(i >> 2), a = (int)(i & 3); const float fp = (float)pos[m]; unsigned w[8];
#pragma unroll
              for (int t = 0; t < 8; ++t) { const float invf = exp2f(-(float)(2 * (8 * a + t)) * (13.287712379549449f / 64.0f)); float tr = fp * invf * 0.15915494309189535f; tr = tr - floorf(tr);
                  const pg8::hf2 cs = {(_Float16)__builtin_amdgcn_cosf(tr), (_Float16)__builtin_amdgcn_sinf(tr)}; w[t] = __builtin_bit_cast(unsigned, cs); }
              *(u32x4*)(cst + i * 8) = (u32x4){w[0], w[1], w[2], w[3]}; *(u32x4*)(cst + i * 8 + 4) = (u32x4){w[4], w[5], w[6], w[7]}; } }
        { const float* s = P.in[I_PU]; unsigned char* d = ws + WS_UT; const size_t n = (size_t)16384 * 1024 / 16; const float* gn = P.in[I_LNFFN];
          for (size_t i0 = gt; i0 < n; i0 += 2 * NT) { f32x4 v[2][4];
#pragma unroll
              for (int q = 0; q < 2; ++q) { const size_t i = i0 + q * NT < n ? i0 + q * NT : i0;
#pragma unroll
                  for (int c = 0; c < 4; ++c) v[q][c] = *(const f32x4*)(s + i * 16 + 4 * c) * *(const f32x4*)(gn + (i & 63) * 16 + 4 * c) * U4SCALE; }
#pragma unroll
              for (int q = 0; q < 2; ++q) { const size_t i = i0 + q * NT; if (i >= n) break; u32x2 o;
#pragma unroll
                  for (int c = 0; c < 2; ++c) { unsigned w = 0;
                      w = __builtin_amdgcn_cvt_scalef32_pk_fp4_f32(w, v[q][2 * c][0], v[q][2 * c][1], 1.0f, 0); w = __builtin_amdgcn_cvt_scalef32_pk_fp4_f32(w, v[q][2 * c][2], v[q][2 * c][3], 1.0f, 1);
                      w = __builtin_amdgcn_cvt_scalef32_pk_fp4_f32(w, v[q][2 * c + 1][0], v[q][2 * c + 1][1], 1.0f, 2); w = __builtin_amdgcn_cvt_scalef32_pk_fp4_f32(w, v[q][2 * c + 1][2], v[q][2 * c + 1][3], 1.0f, 3); o[c] = w; }
                  *(u32x2*)(d + (i >> 6) * 1024 + (i & 63) * 8) = o; } } }
    }
}

__device__ __forceinline__ void phase_rope_pool(const Ctx& C) {
    fold_items<64, false>(C);
    const Params& P = *C.p; unsigned char* ws = P.ws; const int lane = C.lane;
    bf16_t* Z = (bf16_t*)(ws + WS_Z); bf16_t* Y = (bf16_t*)(ws + WS_YCAT);
    const int gw = C.vcu * 8 + C.wave, NGW = C.G * 8;
    constexpr int RP_ROWS = 16;
    const int w = 2 << (lane >> 4);
    for (int mb = gw * RP_ROWS; mb < M_TOK; mb += NGW * RP_ROWS) {
        const int s0 = mb & (SEQ - 1);
        const bf16_t* zp0 = Z + (size_t)mb * ZLD + 8 * lane;
        float acc[8];
#pragma unroll
        for (int i = 0; i < 8; ++i) acc[i] = 0.f;
        { u32x4 pv[15];
#pragma unroll
          for (int i = 1; i < 16; ++i) pv[i - 1] = (i < w && s0 - i >= 0) ? *(const u32x4*)(zp0 - (size_t)i * ZLD) : (u32x4){0u, 0u, 0u, 0u};
#pragma unroll
          for (int i = 0; i < 15; ++i) { acc[0] += bflo(pv[i].x); acc[1] += bfhi(pv[i].x); acc[2] += bflo(pv[i].y); acc[3] += bfhi(pv[i].y); acc[4] += bflo(pv[i].z); acc[5] += bfhi(pv[i].z); acc[6] += bflo(pv[i].w); acc[7] += bfhi(pv[i].w); } }
#pragma unroll 1
        for (int r4 = 0; r4 < RP_ROWS; r4 += 4) {
            u32x4 cv[4], ov[4];
#pragma unroll
            for (int q = 0; q < 4; ++q) { const int r = r4 + q; cv[q] = *(const u32x4*)(zp0 + (size_t)r * ZLD);
                ov[q] = (s0 + r - w + 1 >= 0) ? *(const u32x4*)(zp0 + ((long)r - w + 1) * ZLD) : (u32x4){0u, 0u, 0u, 0u}; }
#pragma unroll
            for (int q = 0; q < 4; ++q) { const int r = r4 + q, s = s0 + r;
                const float c[8] = {bflo(cv[q].x), bfhi(cv[q].x), bflo(cv[q].y), bfhi(cv[q].y), bflo(cv[q].z), bfhi(cv[q].z), bflo(cv[q].w), bfhi(cv[q].w)};
                const float od[8] = {bflo(ov[q].x), bfhi(ov[q].x), bflo(ov[q].y), bfhi(ov[q].y), bflo(ov[q].z), bfhi(ov[q].z), bflo(ov[q].w), bfhi(ov[q].w)};
                const float rc = 1.0f / (float)((s + 1) < w ? (s + 1) : w);
                float ov8[8];
#pragma unroll
                for (int i = 0; i < 8; ++i) { acc[i] += c[i]; ov8[i] = acc[i] * rc - c[i]; acc[i] -= od[i]; }
                u32x4 o; o.x = cvtpk(ov8[0], ov8[1]); o.y = cvtpk(ov8[2], ov8[3]); o.z = cvtpk(ov8[4], ov8[5]); o.w = cvtpk(ov8[6], ov8[7]);
                *(u32x4*)(Y + (size_t)(mb + r) * DM + 8 * lane) = o; }
        }
    }
}

namespace att {
constexpr int SLOT = 32768, KB = 8192;
typedef short v4i16_t __attribute__((ext_vector_type(4)));
__device__ __forceinline__ int crow(int r, int hi) { return (r & 3) + 8 * (r >> 2) + 4 * hi; }
__device__ __forceinline__ s16x4 vtr(const LAS unsigned char* p) { return __builtin_bit_cast(s16x4, __builtin_amdgcn_ds_read_tr16_b64_v4i16((LAS v4i16_t*)p)); }
__device__ __forceinline__ void glds16(const void* gsrc, unsigned lds_dst) { unsigned keep;
    asm volatile("s_mov_b32 %0, m0\n\ts_mov_b32 m0, %2\n\ts_nop 0\n\tglobal_load_lds_dwordx4 %1, off\n\ts_mov_b32 m0, %0" : "=&s"(keep) : "v"(gsrc), "s"(lds_dst) : "memory"); }
__device__ __forceinline__ float swapadd(float v) { auto rr = __builtin_amdgcn_permlane32_swap(__float_as_uint(v), __float_as_uint(v), false, false); return __uint_as_float(rr[0]) + __uint_as_float(rr[1]); }
__device__ __forceinline__ float swapmax(float v) { auto rr = __builtin_amdgcn_permlane32_swap(__float_as_uint(v), __float_as_uint(v), false, false); return fmaxf(__uint_as_float(rr[0]), __uint_as_float(rr[1])); }

template <bool BOUNDED> __device__ __forceinline__ void attn_unit(int b, int h, int qb, const bf16_t* Z, bf16_t* Y, const float* subln, float lam, LAS unsigned char* lds) {
    const int tid = threadIdx.x, lane = tid & 63, r32 = lane & 31, hi = lane >> 5; const int wid = __builtin_amdgcn_readfirstlane(tid >> 6);
    const int m = wid >> 2, wq = wid & 3;
    const size_t rowbase = (size_t)b * SEQ; const int q0 = qb * 128, NT = 2 * qb + 2;
    const int qabs = q0 + wq * 32 + r32;
    bf16x8 qr[4];
    { const bf16_t* Qw = Z + (rowbase + qabs) * ZLD + 512 + h * 128 + m * 64;
#pragma unroll
      for (int d0 = 0; d0 < 4; ++d0) qr[d0] = *(const bf16x8*)(Qw + d0 * 16 + hi * 8); }
    const bf16_t* Zbh = Z + rowbase * ZLD + h * 128;
    unsigned kog[2], vog[2];
#pragma unroll
    for (int j = 0; j < 2; ++j) { const unsigned r = 8u * wid + 4u * j + (lane >> 4), cp = lane & 15;
        kog[j] = r * ZLD + 1024u + 8u * (cp ^ (r & 15u)); vog[j] = r * ZLD + 1536u + 8u * (cp ^ (((r & 3u) << 2) | ((r >> 2) & 3u))); }
    const unsigned wbase = (unsigned)wid * 2048u;
    const unsigned lds0 = (unsigned)(uintptr_t)lds;
#define ATT_DMA(t, slot) do { const bf16_t* zt_ = Zbh + (size_t)(t) * 64 * ZLD; const unsigned d_ = (unsigned)__builtin_amdgcn_readfirstlane(lds0 + (slot) + wbase); \
        glds16(zt_ + kog[0], d_); glds16(zt_ + kog[1], d_ + 1024); glds16(zt_ + vog[0], d_ + 2 * KB); glds16(zt_ + vog[1], d_ + 2 * KB + 1024); } while (0)
    f32x16 o[4];
#pragma unroll
    for (int d = 0; d < 4; ++d)
#pragma unroll
        for (int r = 0; r < 16; ++r) o[d][r] = 0.f;
    float mref = -1e30f, lsum = 0.f;
    int koffs[4], voffs[4][2];
#pragma unroll
    for (int d0 = 0; d0 < 4; ++d0) koffs[d0] = r32 * 256 + (((m * 8 + 2 * d0 + hi) ^ (r32 & 15)) * 16);
    { const int L2 = (lane >> 2) & 3, a = (lane >> 4) & 1, bb = (lane & 3) >> 1;
#pragma unroll
      for (int d = 0; d < 4; ++d)
#pragma unroll
          for (int h2 = 0; h2 < 2; ++h2) voffs[d][h2] = 2 * KB + 256 * (8 * h2 + 4 * hi + L2) + 16 * ((((d ^ L2) & 3) << 2) | (((2 * a + bb) ^ (2 * h2 + hi)) & 3)) + 8 * (lane & 1); }
    ATT_DMA(0, 0); ATT_DMA(1, SLOT);
    asm volatile("s_waitcnt vmcnt(4)" ::: "memory");
    __syncthreads();
    int slot = 0, slot2 = 2 * SLOT;
    for (int t = 0; t < NT; ++t) {
        if (t + 2 < NT) ATT_DMA(t + 2, slot2);
        const bool band = t >= NT - 2;
        bf16x8 kf[8];
        { const LAS unsigned char* kb = lds + slot;
#pragma unroll
          for (int d0 = 0; d0 < 4; ++d0) { kf[2 * d0] = *(const LAS bf16x8*)(kb + koffs[d0]); kf[2 * d0 + 1] = *(const LAS bf16x8*)(kb + koffs[d0] + 8192); } }
        __builtin_amdgcn_sched_barrier(0);
        f32x16 p0, p1;
#pragma unroll
        for (int r = 0; r < 16; ++r) { p0[r] = 0.f; p1[r] = 0.f; }
#pragma unroll
        for (int d0 = 0; d0 < 4; ++d0) { p0 = __builtin_amdgcn_mfma_f32_32x32x16_bf16(kf[2 * d0], qr[d0], p0, 0, 0, 0); p1 = __builtin_amdgcn_mfma_f32_32x32x16_bf16(kf[2 * d0 + 1], qr[d0], p1, 0, 0, 0); }
        const LAS unsigned char* vb = lds + slot;
        s16x4 loA[8], hhA[8], loB[8], hhB[8];
#pragma unroll
        for (int i = 0; i < 8; ++i) { const int d = (i >> 2), ks = i & 3; loA[i] = vtr(vb + voffs[d][0] + ks * 4096); hhA[i] = vtr(vb + voffs[d][1] + ks * 4096); }
        __builtin_amdgcn_sched_barrier(0);
        if (band) {
            const int kb0 = 64 * t + 4 * hi;
#pragma unroll
            for (int r = 0; r < 16; ++r) { const int kv = kb0 + (r & 3) + 8 * (r >> 2); if (kv > qabs) p0[r] = -INFINITY; if (kv + 32 > qabs) p1[r] = -INFINITY; }
        }
        float ls = 0.f;
        if constexpr (BOUNDED) {
#pragma unroll
            for (int r = 0; r < 16; ++r) { p0[r] = __builtin_amdgcn_exp2f(p0[r]); p1[r] = __builtin_amdgcn_exp2f(p1[r]); ls += p0[r] + p1[r]; }
        } else {
            float rm = fmaxf(p0[0], p1[0]);
#pragma unroll
            for (int r = 1; r < 16; ++r) rm = fmaxf(rm, fmaxf(p0[r], p1[r]));
            rm = swapmax(rm);
            if (__any(rm - mref > 8.0f)) {
                const float mn = fmaxf(mref, rm), al = exp2f(mref - mn);
                mref = mn; lsum *= al;
#pragma unroll
                for (int d = 0; d < 4; ++d)
#pragma unroll
                    for (int r = 0; r < 16; ++r) o[d][r] *= al;
            }
#pragma unroll
            for (int r = 0; r < 16; ++r) { p0[r] = __builtin_amdgcn_exp2f(p0[r] - mref); p1[r] = __builtin_amdgcn_exp2f(p1[r] - mref); ls += p0[r] + p1[r]; }
        }
        lsum += ls;
        u32x4 pw[4];
        pw[0] = (u32x4){cvtpk(p0[0], p0[1]), cvtpk(p0[2], p0[3]), cvtpk(p0[4], p0[5]), cvtpk(p0[6], p0[7])};
        pw[1] = (u32x4){cvtpk(p0[8], p0[9]), cvtpk(p0[10], p0[11]), cvtpk(p0[12], p0[13]), cvtpk(p0[14], p0[15])};
        pw[2] = (u32x4){cvtpk(p1[0], p1[1]), cvtpk(p1[2], p1[3]), cvtpk(p1[4], p1[5]), cvtpk(p1[6], p1[7])};
        pw[3] = (u32x4){cvtpk(p1[8], p1[9]), cvtpk(p1[10], p1[11]), cvtpk(p1[12], p1[13]), cvtpk(p1[14], p1[15])};
        __builtin_amdgcn_sched_barrier(0);
#pragma unroll
        for (int i = 0; i < 8; ++i) { const int d = 2 + (i >> 2), ks = i & 3; loB[i] = vtr(vb + voffs[d][0] + ks * 4096); hhB[i] = vtr(vb + voffs[d][1] + ks * 4096); }
        __builtin_amdgcn_sched_barrier(0);
#pragma unroll
        for (int i = 0; i < 8; ++i) { const int d = (i >> 2), ks = i & 3;
            const bf16x8 vf = {loA[i][0], loA[i][1], loA[i][2], loA[i][3], hhA[i][0], hhA[i][1], hhA[i][2], hhA[i][3]};
            o[d] = __builtin_amdgcn_mfma_f32_32x32x16_bf16(vf, __builtin_bit_cast(bf16x8, pw[ks]), o[d], 0, 0, 0); }
#pragma unroll
        for (int i = 0; i < 8; ++i) { const int d = 2 + (i >> 2), ks = i & 3;
            const bf16x8 vf = {loB[i][0], loB[i][1], loB[i][2], loB[i][3], hhB[i][0], hhB[i][1], hhB[i][2], hhB[i][3]};
            o[d] = __builtin_amdgcn_mfma_f32_32x32x16_bf16(vf, __builtin_bit_cast(bf16x8, pw[ks]), o[d], 0, 0, 0); }
        if (t + 2 < NT) asm volatile("s_waitcnt vmcnt(4)" ::: "memory"); else asm volatile("s_waitcnt vmcnt(0)" ::: "memory");
        __syncthreads();
        slot2 = slot; slot = (slot == 2 * SLOT) ? 0 : slot + SLOT;
    }
#undef ATT_DMA
    const float inv = 1.0f / swapadd(lsum);
    LAS float* xch = (LAS float*)(lds + wq * 16384);
    if (m == 1) {
        const float sc = inv * lam;
#pragma unroll
        for (int d = 0; d < 4; ++d)
#pragma unroll
            for (int r = 0; r < 16; ++r) xch[(d * 16 + r) * 64 + lane] = o[d][r] * sc;
    }
    __syncthreads();
    if (m == 0) {
        float ss = 0.f;
#pragma unroll
        for (int d = 0; d < 4; ++d)
#pragma unroll
            for (int r = 0; r < 16; ++r) { const float v = o[d][r] * inv - xch[(d * 16 + r) * 64 + lane]; o[d][r] = v; ss += v * v; }
        ss = swapadd(ss);
        const float rn = rsqrtf(ss * (1.0f / 128.0f) + EPS) * 0.8f;
        bf16_t* yp = Y + (rowbase + qabs) * DM + 512 + h * 128;
#pragma unroll
        for (int d = 0; d < 4; ++d)
#pragma unroll
            for (int rq = 0; rq < 4; ++rq) { const int dc = 32 * d + 8 * rq + 4 * hi; const f32x4 g = *(const f32x4*)(subln + dc);
                u32x2 w; w.x = cvtpk(o[d][4 * rq] * rn * g[0], o[d][4 * rq + 1] * rn * g[1]); w.y = cvtpk(o[d][4 * rq + 2] * rn * g[2], o[d][4 * rq + 3] * rn * g[3]);
                *(u32x2*)(yp + dc) = w; }
    }
    __syncthreads();
}

__device__ __forceinline__ void attn_unit_pipe(int b, int h, int qb, const bf16_t* Z, bf16_t* Y, const float* subln, float lam, LAS unsigned char* lds) {
    int tid = threadIdx.x; asm volatile("" : "+v"(tid));
    const int lane = tid & 63, r32 = lane & 31, hi = lane >> 5; const int wid = __builtin_amdgcn_readfirstlane(tid >> 6);
    const int m = wid >> 2, wq = wid & 3;
    const size_t rowbase = (size_t)b * SEQ; const int q0 = qb * 128, NT = 2 * qb + 2;
    const int qabs = q0 + wq * 32 + r32;
    bf16x8 qr[4];
    { const bf16_t* Qw = Z + (rowbase + qabs) * ZLD + 512 + h * 128 + m * 64;
#pragma unroll
      for (int d0 = 0; d0 < 4; ++d0) qr[d0] = *(const bf16x8*)(Qw + d0 * 16 + hi * 8); }
    const bf16_t* Zbh = Z + rowbase * ZLD + h * 128;
    unsigned kog[2], vog[2];
#pragma unroll
    for (int j = 0; j < 2; ++j) { const unsigned r = 8u * wid + 4u * j + (lane >> 4), cp = lane & 15;
        kog[j] = r * ZLD + 1024u + 8u * (cp ^ (r & 15u)); vog[j] = r * ZLD + 1536u + 8u * (cp ^ (((r & 3u) << 2) | ((r >> 2) & 3u))); }
    const unsigned wbase = (unsigned)wid * 2048u;
    const unsigned lds0 = (unsigned)(uintptr_t)lds;
#define ATP_DMA(t) do { const bf16_t* zt_ = Zbh + (size_t)(t) * 64 * ZLD; const unsigned d_ = (unsigned)__builtin_amdgcn_readfirstlane(lds0 + ((t) & 3) * SLOT + wbase); \
        glds16(zt_ + kog[0], d_); glds16(zt_ + kog[1], d_ + 1024); glds16(zt_ + vog[0], d_ + 2 * KB); glds16(zt_ + vog[1], d_ + 2 * KB + 1024); } while (0)
    f32x16 o[4];
#pragma unroll
    for (int d = 0; d < 4; ++d)
#pragma unroll
        for (int r = 0; r < 16; ++r) o[d][r] = 0.f;
    float lsum = 0.f;
    const int kbase = r32 * 256 + (((m * 8 + hi) ^ (r32 & 15)) * 16);
    int vbase[2];
    { const int L2 = (lane >> 2) & 3, a = (lane >> 4) & 1, bb = (lane & 3) >> 1;
#pragma unroll
      for (int h2 = 0; h2 < 2; ++h2) vbase[h2] = 2 * KB + 256 * (8 * h2 + 4 * hi + L2) + 16 * ((L2 << 2) | (((2 * a + bb) ^ (2 * h2 + hi)) & 3)) + 8 * (lane & 1); }
#define ATP_PIN(x) asm volatile("" : "+v"(x))
#define ATP_SB() __builtin_amdgcn_sched_barrier(0)
#define ATP_MASK(C0, C1, t) do { if ((t) >= NT - 2) { const int kb0_ = 64 * (t) + 4 * hi; \
        _Pragma("unroll") for (int r = 0; r < 16; ++r) { const int kv = kb0_ + (r & 3) + 8 * (r >> 2); if (kv > qabs) C0[r] = -INFINITY; if (kv + 32 > qabs) C1[r] = -INFINITY; } } } while (0)
#define ATP_KLOAD(t) do { const LAS unsigned char* kb_ = lds + ((t) & 3) * SLOT; \
        _Pragma("unroll") for (int d0 = 0; d0 < 4; ++d0) { kf[2 * d0] = *(const LAS bf16x8*)(kb_ + (kbase ^ (32 * d0))); kf[2 * d0 + 1] = *(const LAS bf16x8*)(kb_ + (kbase ^ (32 * d0)) + 8192); } } while (0)
#define ATP_VLOAD(vf, vb, d) do { _Pragma("unroll") for (int ks = 0; ks < 4; ++ks) { const s16x4 lo_ = vtr((vb) + (vbase[0] ^ (64 * (d))) + ks * 4096), hh_ = vtr((vb) + (vbase[1] ^ (64 * (d))) + ks * 4096); \
        vf[ks] = (bf16x8){lo_[0], lo_[1], lo_[2], lo_[3], hh_[0], hh_[1], hh_[2], hh_[3]}; } } while (0)
#define ATP_WAIT(t) do { if ((t) + 2 < NT) asm volatile("s_waitcnt vmcnt(4)" ::: "memory"); else asm volatile("s_waitcnt vmcnt(0)" ::: "memory"); __syncthreads(); } while (0)
    bf16x8 kf[8], vfA[4], vfB[4]; u32x4 pw[4];
    f32x16 pA0, pA1, pB0, pB1;
    ATP_DMA(0); ATP_DMA(1);
    asm volatile("s_waitcnt vmcnt(4)" ::: "memory");
    __syncthreads();
    if (2 < NT) ATP_DMA(2);
    ATP_KLOAD(0); ATP_SB();
#pragma unroll
    for (int r = 0; r < 16; ++r) { pA0[r] = 0.f; pA1[r] = 0.f; }
#pragma unroll
    for (int d0 = 0; d0 < 4; ++d0) { pA0 = __builtin_amdgcn_mfma_f32_32x32x16_bf16(kf[2 * d0], qr[d0], pA0, 0, 0, 0); pA1 = __builtin_amdgcn_mfma_f32_32x32x16_bf16(kf[2 * d0 + 1], qr[d0], pA1, 0, 0, 0); }
    ATP_MASK(pA0, pA1, 0);
#pragma unroll
    for (int r = 0; r < 16; ++r) { pA0[r] = __builtin_amdgcn_exp2f(pA0[r]); pA1[r] = __builtin_amdgcn_exp2f(pA1[r]); }
    ATP_WAIT(0);
#define ATP_GAPA(i, C0, C1, P0, P1) do { \
        if ((i) & 1) { C1 = __builtin_amdgcn_mfma_f32_32x32x16_bf16(kf[i], qr[(i) >> 1], C1, 0, 0, 0); ATP_PIN(C1); } else { C0 = __builtin_amdgcn_mfma_f32_32x32x16_bf16(kf[i], qr[(i) >> 1], C0, 0, 0, 0); ATP_PIN(C0); } \
        if ((i) < 4) { sacc += (P0[4 * (i)] + P0[4 * (i) + 1]) + (P0[4 * (i) + 2] + P0[4 * (i) + 3]); pw[(i) >> 1][2 * ((i) & 1)] = cvtpk(P0[4 * (i)], P0[4 * (i) + 1]); pw[(i) >> 1][2 * ((i) & 1) + 1] = cvtpk(P0[4 * (i) + 2], P0[4 * (i) + 3]); } \
        else { sacc += (P1[4 * ((i) - 4)] + P1[4 * ((i) - 4) + 1]) + (P1[4 * ((i) - 4) + 2] + P1[4 * ((i) - 4) + 3]); pw[(i) >> 1][2 * ((i) & 1)] = cvtpk(P1[4 * ((i) - 4)], P1[4 * ((i) - 4) + 1]); pw[(i) >> 1][2 * ((i) & 1) + 1] = cvtpk(P1[4 * ((i) - 4) + 2], P1[4 * ((i) - 4) + 3]); } \
        ATP_PIN(sacc); ATP_PIN(pw[(i) >> 1]); ATP_SB(); } while (0)
#define ATP_GAPB(vf, d, ks, X, e0) do { o[d] = __builtin_amdgcn_mfma_f32_32x32x16_bf16(vf[ks], __builtin_bit_cast(bf16x8, pw[ks]), o[d], 0, 0, 0); \
        X[e0] = __builtin_amdgcn_exp2f(X[e0]); X[(e0) + 1] = __builtin_amdgcn_exp2f(X[(e0) + 1]); ATP_PIN(X); ATP_SB(); } while (0)
#define ATP_STEP(C0, C1, P0, P1, t) do { \
        if ((t) + 2 < NT) ATP_DMA((t) + 2); \
        ATP_KLOAD(t); ATP_SB(); \
        const LAS unsigned char* vb_ = lds + (((t) - 1) & 3) * SLOT; \
        _Pragma("unroll") for (int r = 0; r < 16; ++r) { C0[r] = 0.f; C1[r] = 0.f; } \
        float sacc = 0.f; \
        ATP_GAPA(0, C0, C1, P0, P1); ATP_GAPA(1, C0, C1, P0, P1); ATP_GAPA(2, C0, C1, P0, P1); ATP_GAPA(3, C0, C1, P0, P1); \
        ATP_GAPA(4, C0, C1, P0, P1); ATP_GAPA(5, C0, C1, P0, P1); ATP_GAPA(6, C0, C1, P0, P1); ATP_GAPA(7, C0, C1, P0, P1); \
        lsum += sacc; \
        ATP_VLOAD(vfA, vb_, 0); ATP_VLOAD(vfB, vb_, 1); ATP_SB(); \
        ATP_MASK(C0, C1, t); ATP_SB(); \
        ATP_GAPB(vfA, 0, 0, C0, 0); ATP_GAPB(vfA, 0, 1, C0, 2); ATP_GAPB(vfA, 0, 2, C0, 4); ATP_GAPB(vfA, 0, 3, C0, 6); \
        ATP_VLOAD(vfA, vb_, 2); ATP_SB(); \
        ATP_GAPB(vfB, 1, 0, C0, 8); ATP_GAPB(vfB, 1, 1, C0, 10); ATP_GAPB(vfB, 1, 2, C0, 12); ATP_GAPB(vfB, 1, 3, C0, 14); \
        ATP_VLOAD(vfB, vb_, 3); ATP_SB(); \
        ATP_GAPB(vfA, 2, 0, C1, 0); ATP_GAPB(vfA, 2, 1, C1, 2); ATP_GAPB(vfA, 2, 2, C1, 4); ATP_GAPB(vfA, 2, 3, C1, 6); \
        ATP_GAPB(vfB, 3, 0, C1, 8); ATP_GAPB(vfB, 3, 1, C1, 10); ATP_GAPB(vfB, 3, 2, C1, 12); ATP_GAPB(vfB, 3, 3, C1, 14); \
        ATP_WAIT(t); } while (0)
    int t = 1;
    for (; t + 1 < NT; t += 2) { ATP_STEP(pB0, pB1, pA0, pA1, t); ATP_STEP(pA0, pA1, pB0, pB1, t + 1); }
    ATP_STEP(pB0, pB1, pA0, pA1, t);
    { float sacc = 0.f;
#pragma unroll
      for (int r = 0; r < 16; ++r) sacc += pB0[r] + pB1[r];
      lsum += sacc;
      pw[0] = (u32x4){cvtpk(pB0[0], pB0[1]), cvtpk(pB0[2], pB0[3]), cvtpk(pB0[4], pB0[5]), cvtpk(pB0[6], pB0[7])};
      pw[1] = (u32x4){cvtpk(pB0[8], pB0[9]), cvtpk(pB0[10], pB0[11]), cvtpk(pB0[12], pB0[13]), cvtpk(pB0[14], pB0[15])};
      pw[2] = (u32x4){cvtpk(pB1[0], pB1[1]), cvtpk(pB1[2], pB1[3]), cvtpk(pB1[4], pB1[5]), cvtpk(pB1[6], pB1[7])};
      pw[3] = (u32x4){cvtpk(pB1[8], pB1[9]), cvtpk(pB1[10], pB1[11]), cvtpk(pB1[12], pB1[13]), cvtpk(pB1[14], pB1[15])};
      const LAS unsigned char* vb_ = lds + ((NT - 1) & 3) * SLOT;
#pragma unroll
      for (int d = 0; d < 4; ++d) { ATP_VLOAD(vfA, vb_, d);
#pragma unroll
          for (int ks = 0; ks < 4; ++ks) o[d] = __builtin_amdgcn_mfma_f32_32x32x16_bf16(vfA[ks], __builtin_bit_cast(bf16x8, pw[ks]), o[d], 0, 0, 0); } }
    __syncthreads();
#undef ATP_DMA
#undef ATP_PIN
#undef ATP_SB
#undef ATP_MASK
#undef ATP_KLOAD
#undef ATP_VLOAD
#undef ATP_WAIT
#undef ATP_GAPA
#undef ATP_GAPB
#undef ATP_STEP
    const float inv = 1.0f / swapadd(lsum);
    LAS float* xch = (LAS float*)(lds + wq * 16384);
    if (m == 1) {
        const float sc = inv * lam;
#pragma unroll
        for (int d = 0; d < 4; ++d)
#pragma unroll
            for (int r = 0; r < 16; ++r) xch[(d * 16 + r) * 64 + lane] = o[d][r] * sc;
    }
    __syncthreads();
    if (m == 0) {
        float ss = 0.f;
#pragma unroll
        for (int d = 0; d < 4; ++d)
#pragma unroll
            for (int r = 0; r < 16; ++r) { const float v = o[d][r] * inv - xch[(d * 16 + r) * 64 + lane]; o[d][r] = v; ss += v * v; }
        ss = swapadd(ss);
        const float rn = rsqrtf(ss * (1.0f / 128.0f) + EPS) * 0.8f;
        bf16_t* yp = Y + (rowbase + qabs) * DM + 512 + h * 128;
#pragma unroll
        for (int d = 0; d < 4; ++d)
#pragma unroll
            for (int rq = 0; rq < 4; ++rq) { const int dc = 32 * d + 8 * rq + 4 * hi; const f32x4 g = *(const f32x4*)(subln + dc);
                u32x2 w; w.x = cvtpk(o[d][4 * rq] * rn * g[0], o[d][4 * rq + 1] * rn * g[1]); w.y = cvtpk(o[d][4 * rq + 2] * rn * g[2], o[d][4 * rq + 3] * rn * g[3]);
                *(u32x2*)(yp + dc) = w; }
    }
    __syncthreads();
}
}

__device__ __forceinline__ void phase_attn(const Ctx& C) {
    const Params& P = *C.p; unsigned char* ws = P.ws;
    const bf16_t* Z = (const bf16_t*)(ws + WS_Z); bf16_t* Y = (bf16_t*)(ws + WS_YCAT);
    const float d1 = wave_sum(P.in[I_LQ1][C.lane] * P.in[I_LK1][C.lane]), d2 = wave_sum(P.in[I_LQ2][C.lane] * P.in[I_LK2][C.lane]);
    const float lam = expf(d1) - expf(d2) + 0.2f;
    float gq = fabsf(P.in[I_QN][C.lane]), gk = fabsf(P.in[I_KN][C.lane]);
#pragma unroll
    for (int o = 1; o < 64; o <<= 1) { gq = fmaxf(gq, __shfl_xor(gq, o)); gk = fmaxf(gk, __shfl_xor(gk, o)); }
    const bool bounded = 8.0f * 1.4426950408889634f * gq * gk <= 40.0f;
#pragma unroll 1
    for (int rep = 0; rep <= PROBE_ATTN2; ++rep)
#pragma unroll 1
    for (int pi = C.vcu; pi < 512; pi += C.G) {
        const int bh = pi >> 5, s = pi & 31;
        if (bounded) {
#pragma unroll 1
            for (int u = 0; u < 2; ++u) att::attn_unit_pipe(bh >> 2, bh & 3, u ? s : 63 - s, Z, Y, P.in[I_SUBLN], lam, C.lds);
        } else {
#pragma unroll 1
            for (int u = 0; u < 2; ++u) att::attn_unit<false>(bh >> 2, bh & 3, u ? s : 63 - s, Z, Y, P.in[I_SUBLN], lam, C.lds);
        }
    }
}

__device__ __forceinline__ unsigned mono(float f) { const unsigned u = __float_as_uint(f); return (u & 0x80000000u) ? ~u : (u | 0x80000000u); }
__device__ __forceinline__ float unmono(unsigned u) { return __uint_as_float((u & 0x80000000u) ? (u & 0x7fffffffu) : ~u); }
template <class T> __device__ __forceinline__ void sort16_desc(T (&a)[16]) {
#define CE(i, j) { const T mx = a[i] > a[j] ? a[i] : a[j], mn = a[i] > a[j] ? a[j] : a[i]; a[i] = mx; a[j] = mn; }
    CE(0, 13) CE(1, 12) CE(2, 15) CE(3, 14) CE(4, 8) CE(5, 6) CE(7, 11) CE(9, 10)
    CE(0, 5) CE(1, 7) CE(2, 9) CE(3, 4) CE(6, 13) CE(8, 14) CE(10, 15) CE(11, 12)
    CE(0, 1) CE(2, 3) CE(4, 5) CE(6, 8) CE(7, 9) CE(10, 11) CE(12, 13) CE(14, 15)
    CE(0, 2) CE(1, 3) CE(4, 10) CE(5, 11) CE(6, 7) CE(8, 9) CE(12, 14) CE(13, 15)
    CE(1, 2) CE(3, 12) CE(4, 6) CE(5, 7) CE(8, 10) CE(9, 11) CE(13, 14)
    CE(1, 4) CE(2, 6) CE(5, 8) CE(7, 10) CE(9, 13) CE(11, 14)
    CE(2, 4) CE(3, 6) CE(9, 12) CE(11, 13)
    CE(3, 5) CE(6, 8) CE(7, 9) CE(10, 12)
    CE(3, 4) CE(5, 6) CE(7, 8) CE(9, 10) CE(11, 12)
    CE(6, 7) CE(8, 9)
#undef CE
}
template <class T> __device__ __forceinline__ void merge16_desc(T (&a)[16], const T (&b)[16]) {
#pragma unroll
    for (int i = 0; i < 16; ++i) a[i] = a[i] > b[15 - i] ? a[i] : b[15 - i];
#pragma unroll
    for (int j = 8; j > 0; j >>= 1)
#pragma unroll
        for (int i = 0; i < 16; ++i) { const int l = i ^ j; if (l > i) { const T mx = a[i] > a[l] ? a[i] : a[l], mn = a[i] > a[l] ? a[l] : a[i]; a[i] = mx; a[l] = mn; } }
}
__device__ __forceinline__ void top16_of_128(const _Float16* sc, unsigned (&a)[16]) {
    f16x8 n0 = *(const f16x8*)sc, n1 = *(const f16x8*)(sc + 8);
#pragma unroll 1
    for (int g = 0; g < 8; ++g) {
        const f16x8 h0 = n0, h1 = n1;
        { const int gn = g < 7 ? g + 1 : 7; n0 = *(const f16x8*)(sc + 16 * gn); n1 = *(const f16x8*)(sc + 16 * gn + 8); }
        unsigned b[16];
#pragma unroll
        for (int i = 0; i < 8; ++i) { b[i] = (mono((float)h0[i]) & ~127u) | (unsigned)(127 - (16 * g + i)); b[8 + i] = (mono((float)h1[i]) & ~127u) | (unsigned)(127 - (16 * g + 8 + i)); }
        sort16_desc(b);
        if (g == 0) {
#pragma unroll
            for (int i = 0; i < 16; ++i) a[i] = b[i];
        } else merge16_desc(a, b);
    }
}
typedef unsigned long long u64;
__device__ __forceinline__ void phase_topk(const Ctx& C) {
    const Params& P = *C.p; unsigned char* ws = P.ws;
    const _Float16* SC = (const _Float16*)(ws + WS_Z); int* EI = (int*)(ws + WS_EIDX); float* GT = (float*)(ws + WS_GATE);
    const int gt = C.vcu * 512 + C.tid, NT = C.G * 512;
    for (int it = gt; it < M_TOK * 8; it += NT) {
        const _Float16* sc = SC + (size_t)it * 256;
        unsigned a0[16], a1[16];
        top16_of_128(sc, a0); top16_of_128(sc + 128, a1);
        float v0[16], v1[16]; unsigned e0[16], e1[16];
#pragma unroll
        for (int i = 0; i < 16; ++i) { v0[i] = unmono(a0[i] & ~127u); v1[i] = unmono(a1[i] & ~127u); e0[i] = (127u - (a0[i] & 127u)) << 7; e1[i] = 127u - (a1[i] & 127u); }
#define CAND(i, j) ((((u64)mono(v0[i] + v1[j])) << 32) | (u64)(((255u - (unsigned)((i) * 16 + (j))) << 16) | e0[i] | e1[j]))
        u64 a[16], bq[16];
#pragma unroll
        for (int j = 0; j < 16; ++j) a[j] = CAND(0, j);
#pragma unroll
        for (int i = 0; i < 15; ++i) bq[i] = CAND(i + 1, 0);
        bq[15] = 0ull; merge16_desc(a, bq);
#pragma unroll
        for (int i = 0; i < 16; ++i) bq[i] = 0ull;
#pragma unroll
        for (int j = 1; j < 8; ++j) bq[j - 1] = CAND(1, j);
        merge16_desc(a, bq);
#pragma unroll
        for (int i = 0; i < 16; ++i) bq[i] = 0ull;
#pragma unroll
        for (int i = 2; i < 8; ++i) bq[i - 2] = CAND(i, 1);
        merge16_desc(a, bq);
#pragma unroll
        for (int i = 0; i < 16; ++i) bq[i] = 0ull;
        bq[0] = CAND(2, 2); bq[1] = CAND(2, 3); bq[2] = CAND(2, 4); bq[3] = CAND(3, 2); bq[4] = CAND(4, 2); bq[5] = CAND(3, 3);
        sort16_desc(bq); merge16_desc(a, bq);
#undef CAND
        float sv[16]; const float smax = unmono((unsigned)(a[0] >> 32)); float den = 0.f;
#pragma unroll
        for (int i = 0; i < 16; ++i) { sv[i] = __expf(unmono((unsigned)(a[i] >> 32)) - smax); den += sv[i]; }
        const float rd = 1.0f / den;
        int* eo = EI + (size_t)it * 16; float* go = GT + (size_t)it * 16;
#pragma unroll
        for (int q = 0; q < 4; ++q) {
            *(u32x4*)(eo + 4 * q) = (u32x4){(unsigned)a[4 * q] & 0x3fffu, (unsigned)a[4 * q + 1] & 0x3fffu, (unsigned)a[4 * q + 2] & 0x3fffu, (unsigned)a[4 * q + 3] & 0x3fffu};
            *(f32x4*)(go + 4 * q) = (f32x4){sv[4 * q] * rd, sv[4 * q + 1] * rd, sv[4 * q + 2] * rd, sv[4 * q + 3] * rd};
        }
    }
}

constexpr int GT_T = 8;
typedef _Float16 h16x2 __attribute__((ext_vector_type(2)));
typedef int v4i_t __attribute__((ext_vector_type(4)));
typedef int v8i_t __attribute__((ext_vector_type(8)));
__device__ __forceinline__ f32x4 mx4(const v4i_t a, const v4i_t b, const f32x4 c) {
    const v8i_t A = {a[0], a[1], a[2], a[3], 0, 0, 0, 0}, B = {b[0], b[1], b[2], b[3], 0, 0, 0, 0};
    return __builtin_amdgcn_mfma_scale_f32_16x16x128_f8f6f4(A, B, c, 4, 4, 0, 0x7f7f7f7f, 0, 0x7f7f7f7f);
}
__device__ __forceinline__ float gelu_erf(float a) {
    const float x = a * 0.70710678118654752f, ax = fabsf(x);
    const float t = __builtin_amdgcn_rcpf(fmaf(0.3275911f, ax, 1.0f));
    const float pl = t * fmaf(t, fmaf(t, fmaf(t, fmaf(t, 1.061405429f, -1.453152027f), 1.421413741f), -0.284496736f), 0.254829592f);
    const float er = fmaf(-pl, __builtin_amdgcn_exp2f(-1.4426950408889634f * x * x), 1.0f);
    return 0.5f * a * (1.0f + copysignf(er, x));
}
__device__ __forceinline__ unsigned pkmax16(unsigned a, unsigned b) { typedef unsigned short us2 __attribute__((ext_vector_type(2))); return __builtin_bit_cast(unsigned, __builtin_elementwise_max(__builtin_bit_cast(us2, a), __builtin_bit_cast(us2, b))); }
__device__ __forceinline__ void phase_gather(const Ctx& C, bool dry = false) {
    const Params& P = *C.p; unsigned char* ws = P.ws; const int lane = C.lane;
    bf16_t* HB = (bf16_t*)(ws + WS_ACTB); const float* rowss = (const float*)(ws + WS_CTL + WS_ROWSS2); float* rinv3 = (float*)(ws + WS_RINV3);
    bf16_t* HBW = dry ? (bf16_t*)(ws + WS_YCAT) : HB; float* R3W = dry ? (float*)(ws + WS_WIN) : rinv3;
    const auto rsT = __builtin_amdgcn_make_buffer_rsrc((void*)(ws + WS_UT), 0, 16 << 20, 0x00020000);
    const int* EI = (const int*)(ws + WS_EIDX); const float* GT = (const float*)(ws + WS_GATE);
    constexpr int WLDS = 9216;
    LAS u32x2* sl = (LAS u32x2*)(C.lds + C.wave * WLDS);
    LAS float* gl = (LAS float*)(C.lds + C.wave * WLDS + 1024);
    LAS int* el = (LAS int*)(C.lds + C.wave * WLDS + 5120);
    const unsigned lane16 = 16u * (unsigned)lane;
    const int mi = lane & 15, mg = lane >> 4;
    const bool xsel = mi < 8 && mg == (mi >> 1), nodd = lane & 1;
    for (int tok0 = (C.vcu * 8 + C.wave) * GT_T; tok0 < M_TOK; tok0 += C.G * 8 * GT_T) {
        h16x2 op[GT_T][8];
#pragma unroll
        for (int j = 0; j < GT_T; ++j) {
            const int tok = tok0 + j;
            const int e0 = EI[(size_t)tok * 128 + lane], e1 = EI[(size_t)tok * 128 + 64 + lane]; const float g0 = GT[(size_t)tok * 128 + lane], g1 = GT[(size_t)tok * 128 + 64 + lane];
            int pos0 = 0, pos1 = 0, base = 0;
#pragma unroll
            for (int b = 0; b < 16; ++b) {
                const bool q0 = (e0 >> 10) == b, q1 = (e1 >> 10) == b;
                const unsigned long long m0 = __ballot(q0), m1 = __ballot(q1);
                const int c0 = __builtin_popcountll(m0), c1 = __builtin_popcountll(m1);
                const int r0 = __builtin_amdgcn_mbcnt_hi((unsigned)(m0 >> 32), __builtin_amdgcn_mbcnt_lo((unsigned)m0, 0u));
                const int r1 = __builtin_amdgcn_mbcnt_hi((unsigned)(m1 >> 32), __builtin_amdgcn_mbcnt_lo((unsigned)m1, 0u));
                if (q0) pos0 = base + r0;
                if (q1) pos1 = base + c0 + r1;
                base += c0 + c1;
            }
            sl[pos0] = (u32x2){(unsigned)e0, __float_as_uint(g0)}; sl[pos1] = (u32x2){(unsigned)e1, __float_as_uint(g1)};
            const u32x2 a = sl[lane], b = sl[64 + lane];
            gl[j * 128 + lane] = __uint_as_float(a.y); gl[j * 128 + 64 + lane] = __uint_as_float(b.y);
            el[j * 128 + lane] = (int)a.x; el[j * 128 + 64 + lane] = (int)b.x;
        }
        v4i_t xb1[8], xb2[8]; float ascl;
        {
            const int tok = tok0 + (lane & 7); const bf16_t* hp = HB + (size_t)tok * DM + 32 * mg;
            unsigned mx = 0u;
#pragma unroll
            for (int st = 0; st < 8; ++st)
#pragma unroll
                for (int c = 0; c < 4; ++c) { const u32x4 hw = *(const u32x4*)(hp + 128 * st + 8 * c);
                    mx = pkmax16(mx, pkmax16(pkmax16(hw.x & 0x7fff7fffu, hw.y & 0x7fff7fffu), pkmax16(hw.z & 0x7fff7fffu, hw.w & 0x7fff7fffu))); }
            float am = __uint_as_float(((mx & 0xffffu) > (mx >> 16) ? (mx & 0xffffu) : (mx >> 16)) << 16);
            am = fmaxf(am, __shfl_xor(am, 16)); am = fmaxf(am, __shfl_xor(am, 32)); am = fmaxf(am, 1e-30f);
            const float sc = 6.0f / am, sc8 = 8.0f * sc;
            ascl = am * (1.0f / 6.0f) * rsqrtf(rowss[tok] * (1.0f / 1024.0f) + EPS) * (1.0f / U4SCALE);
#pragma unroll
            for (int st = 0; st < 8; ++st)
#pragma unroll
                for (int c = 0; c < 4; ++c) { const u32x4 hw = *(const u32x4*)(hp + 128 * ((st + lane) & 7) + 8 * c); unsigned q1 = 0u, q2 = 0u;
#define GX_BYTE(b, w) { const float h0 = bflo(w), h1 = bfhi(w); q1 = __builtin_amdgcn_cvt_scalef32_pk_fp4_f32(q1, h0 * sc, h1 * sc, 1.0f, b); \
                        const f32x2 d8 = __builtin_amdgcn_cvt_scalef32_pk_f32_fp4(q1, 8.0f, b); q2 = __builtin_amdgcn_cvt_scalef32_pk_fp4_f32(q2, fmaf(h0, sc8, -d8[0]), fmaf(h1, sc8, -d8[1]), 1.0f, b); }
                    GX_BYTE(0, hw.x) GX_BYTE(1, hw.y) GX_BYTE(2, hw.z) GX_BYTE(3, hw.w)
#undef GX_BYTE
                    xb1[st][c] = (int)q1; xb2[st][c] = (int)q2; }
        }
#pragma unroll
        for (int j = 0; j < GT_T; ++j)
#pragma unroll
            for (int i = 0; i < 8; ++i) op[j][i] = (h16x2){(_Float16)0.f, (_Float16)0.f};
        {
            const int ro = (mi >> 1) * 128 + (mi & 1);
            const LAS int* elp = el + ro; const LAS float* glw = gl + (lane & 7) * 128;
            unsigned rot[8];
#pragma unroll
            for (int st = 0; st < 8; ++st) rot[st] = 64u * (unsigned)((st + (mi >> 1)) & 7) + 16u * (unsigned)mg;
            int ev = elp[0];
            v4i_t a[8];
            { const unsigned vo = (unsigned)ev << 10;
#pragma unroll
              for (int st = 0; st < 8; ++st) a[st] = __builtin_bit_cast(v4i_t, __builtin_amdgcn_raw_buffer_load_b128(rsT, vo + rot[st], 0, 0)); }
#pragma unroll 1
            for (int k = 0; k < 64; ++k) {
                u32x2 w[16];
#pragma unroll
                for (int r = 0; r < 16; ++r) { const int e = __builtin_amdgcn_readlane(ev, r); w[r] = __builtin_amdgcn_raw_buffer_load_b64(rsT, (lane16 >> 1) + 512u, e << 10, 17); }
                __builtin_amdgcn_sched_barrier(0);
                f32x4 c1 = {0.f, 0.f, 0.f, 0.f}, c2 = {0.f, 0.f, 0.f, 0.f};
#pragma unroll
                for (int st = 0; st < 8; ++st) { c1 = mx4(a[st], xb1[st], c1); c2 = mx4(a[st], xb2[st], c2); }
                const float v0 = nodd ? c1[2] + 0.125f * c2[2] : c1[0] + 0.125f * c2[0], v1 = nodd ? c1[3] + 0.125f * c2[3] : c1[1] + 0.125f * c2[1];
                const f32x2 gt2 = *(const LAS f32x2*)(glw + 2 * k);
                __builtin_amdgcn_sched_barrier(0);
                { ev = elp[k < 63 ? 2 * k + 2 : 126]; const unsigned vo = (unsigned)ev << 10;
#pragma unroll
                    for (int st = 0; st < 8; ++st) a[st] = __builtin_bit_cast(v4i_t, __builtin_amdgcn_raw_buffer_load_b128(rsT, vo + rot[st], 0, 0)); }
                __builtin_amdgcn_sched_barrier(0);
                const float h0 = gelu_erf(v0 * ascl) * gt2[0] * (1.0f / V4SCALE), h1 = gelu_erf(v1 * ascl) * gt2[1] * (1.0f / V4SCALE);
                const h16x2 hh0 = {(_Float16)h0, (_Float16)h0}, hh1 = {(_Float16)h1, (_Float16)h1}; const unsigned hr0 = __builtin_bit_cast(unsigned, hh0), hr1 = __builtin_bit_cast(unsigned, hh1);
                __builtin_amdgcn_sched_barrier(0);
                unsigned scs[16];
#pragma unroll
                for (int r = 0; r < 16; ++r) scs[r] = (unsigned)__builtin_amdgcn_readlane((int)((r & 1) ? hr1 : hr0), (r >> 1) + 16 * (r >> 2));
#pragma unroll
                for (int r = 0; r < 16; ++r) { const int j = r >> 1; const h16x2 sc = __builtin_bit_cast(h16x2, scs[r]); u32x2 ww = w[r];
                    asm volatile("" : "+v"(ww));
#pragma unroll
                    for (int c = 0; c < 2; ++c) {
                        op[j][4 * c + 0] = __builtin_elementwise_fma(sc, __builtin_bit_cast(h16x2, __builtin_amdgcn_cvt_scalef32_pk_f16_fp4(ww[c], 1.0f, 0)), op[j][4 * c + 0]);
                        op[j][4 * c + 1] = __builtin_elementwise_fma(sc, __builtin_bit_cast(h16x2, __builtin_amdgcn_cvt_scalef32_pk_f16_fp4(ww[c], 1.0f, 1)), op[j][4 * c + 1]);
                        op[j][4 * c + 2] = __builtin_elementwise_fma(sc, __builtin_bit_cast(h16x2, __builtin_amdgcn_cvt_scalef32_pk_f16_fp4(ww[c], 1.0f, 2)), op[j][4 * c + 2]);
                        op[j][4 * c + 3] = __builtin_elementwise_fma(sc, __builtin_bit_cast(h16x2, __builtin_amdgcn_cvt_scalef32_pk_f16_fp4(ww[c], 1.0f, 3)), op[j][4 * c + 3]); }
                    asm volatile("" : "+v"(op[j][0]), "+v"(op[j][1]), "+v"(op[j][2]), "+v"(op[j][3]), "+v"(op[j][4]), "+v"(op[j][5]), "+v"(op[j][6]), "+v"(op[j][7])); }
                __builtin_amdgcn_sched_barrier(0);
            }
        }
#pragma unroll
        for (int j = 0; j < GT_T; ++j) {
            const int tok = tok0 + j; const bf16_t* hp0 = HB + (size_t)tok * DM + 16 * lane; f32x4 hv[4]; float ss = 0.f;
            const u32x4 hw0 = *(const u32x4*)hp0, hw1 = *(const u32x4*)(hp0 + 8);
            hv[0] = (f32x4){bflo(hw0.x), bfhi(hw0.x), bflo(hw0.y), bfhi(hw0.y)}; hv[1] = (f32x4){bflo(hw0.z), bfhi(hw0.z), bflo(hw0.w), bfhi(hw0.w)};
            hv[2] = (f32x4){bflo(hw1.x), bfhi(hw1.x), bflo(hw1.y), bfhi(hw1.y)}; hv[3] = (f32x4){bflo(hw1.z), bfhi(hw1.z), bflo(hw1.w), bfhi(hw1.w)};
#pragma unroll
            for (int i = 0; i < 4; ++i) { hv[i] = hv[i] + (f32x4){(float)op[j][2 * i].x, (float)op[j][2 * i].y, (float)op[j][2 * i + 1].x, (float)op[j][2 * i + 1].y};
                ss += (hv[i][0] * hv[i][0] + hv[i][1] * hv[i][1]) + (hv[i][2] * hv[i][2] + hv[i][3] * hv[i][3]); }
            ss = wave_sum(ss);
            bf16_t* bp = HBW + (size_t)tok * DM + 16 * lane;
            *(u32x4*)bp = (u32x4){cvtpk(hv[0][0], hv[0][1]), cvtpk(hv[0][2], hv[0][3]), cvtpk(hv[1][0], hv[1][1]), cvtpk(hv[1][2], hv[1][3])};
            *(u32x4*)(bp + 8) = (u32x4){cvtpk(hv[2][0], hv[2][1]), cvtpk(hv[2][2], hv[2][3]), cvtpk(hv[3][0], hv[3][1]), cvtpk(hv[3][2], hv[3][3])};
            if (lane == 0) R3W[tok] = rsqrtf(ss * (1.0f / 1024.0f) + EPS);
        }
    }
}

constexpr int N_PHASES = 9;
__global__ void __launch_bounds__(512, 2) mk_fwd(Params prm) {
    extern __shared__ __attribute__((aligned(16))) unsigned char lds_raw[];
    Ctx C; C.lds = (LAS unsigned char*)lds_raw; C.tid = threadIdx.x; C.lane = C.tid & 63; C.wave = __builtin_amdgcn_readfirstlane(C.tid >> 6);
    C.G = gridDim.x; { const int bx = blockIdx.x; C.vcu = (C.G % 8 == 0) ? (bx % 8) * (C.G / 8) + bx / 8 : bx; }
    C.p = &prm;
    unsigned char* ws = prm.ws;
    const int lo = prm.ph_lo, hi = prm.ph_hi;
#define IN(k) (lo <= (k) && (k) < hi)
    { volatile LAS unsigned* st = (volatile LAS unsigned*)(C.lds + LDS_BYTES - 64); if (C.tid < 2) st[C.tid] = 0u; __syncthreads(); }
    XcdBarrier xbar = xcd_barrier_post((unsigned*)(ws + WS_CTL) + 4096, (volatile LAS unsigned*)(C.lds + LDS_BYTES - 64));
#define SEAM(k) do { if (IN(k) && IN((k) + 1)) { xcd_barrier(xbar); } } while (0)
#if MK_COOP_SYNC0
    if (hi > N_PHASES) cg::this_grid().sync();
#endif
    bf16_t* ACTB = (bf16_t*)(ws + WS_ACTB); bf16_t* Z = (bf16_t*)(ws + WS_Z); bf16_t* YC = (bf16_t*)(ws + WS_YCAT); bf16_t* PPB = (bf16_t*)(ws + WS_PP);
    float* rowss2 = (float*)(ws + WS_CTL + WS_ROWSS2);
    if (IN(0)) { _Pragma("unroll 1") for (int rep = 0; rep <= PROBE_PREP; ++rep) { phase_prep(C); __syncthreads(); } }
    SEAM(0);
    if (IN(1)) for (int rep1 = 0; rep1 <= PROBE_G1; ++rep1) {
        { pg8::Gemm g{ACTB, (const bf16_t*)(ws + WS_WIN), M_TOK, 2048, 1024}; pg8::StaticOrder S; S.init(M_TOK, 2048, C.G, (int)blockIdx.x); pg8::EpiZ E{Z, ZLD, prm.in[I_QN], prm.in[I_KN], (const unsigned*)(ws + WS_CST)};
          pg8::gemm_phase<pg8::EpiZ, pg8::StaticOrder, true, true>(C.lds, g, S, E); }
        { pg8::Gemm g{(const bf16_t*)(ws + WS_PB), (const bf16_t*)(ws + WS_WP), M_TOK, 1024, 256}; pg8::StaticOrder S; S.init(M_TOK, 1024, C.G, (int)blockIdx.x); pg8::EpiStoreBf16 E{PPB, DM};
          pg8::gemm_phase<pg8::EpiStoreBf16, pg8::StaticOrder, true, true>(C.lds, g, S, E); }
    }
    SEAM(1);
    if (IN(2)) phase_rope_pool(C);
    for (int rep = 0; rep < PROBE_SYNC; ++rep) xcd_barrier(xbar);
    if (IN(3)) { _Pragma("unroll 1") for (int rep = 0; rep <= PROBE_ATTN; ++rep) phase_attn(C); }
    SEAM(3);
    if (IN(4)) { pg8::Gemm g{YC, (const bf16_t*)(ws + WS_WO), M_TOK, 1024, 1024}; pg8::StaticOrder S; S.init(M_TOK, 1024, C.G, (int)blockIdx.x); pg8::EpiWo E{prm.in[I_X], ACTB, rowss2};
        pg8::gemm_phase<pg8::EpiWo, pg8::StaticOrder, true, true>(C.lds, g, S, E); }
    SEAM(4);
    if (IN(5)) for (int rep5 = 0; rep5 <= PROBE_G5; ++rep5) { pg8::Gemm g{ACTB, (const bf16_t*)(ws + WS_WS), M_TOK, 2048, 1024}; pg8::StaticOrder S; S.init(M_TOK, 2048, C.G, (int)blockIdx.x); pg8::EpiScores E{(_Float16*)(ws + WS_Z), ZLD, rowss2};
        pg8::gemm_phase<pg8::EpiScores, pg8::StaticOrder, true, true>(C.lds, g, S, E); }
    SEAM(5);
    if (IN(6)) { _Pragma("unroll 1") for (int rep = 0; rep <= PROBE_TOPK; ++rep) phase_topk(C); }
    if (IN(6) && IN(7)) { asm volatile("s_waitcnt vmcnt(0)" ::: "memory"); __syncthreads(); } else { SEAM(6); }
    if (IN(7)) { _Pragma("unroll 1") for (int rep = 0; rep < PROBE_GATHER; ++rep) phase_gather(C, true); phase_gather(C); }
    SEAM(7);
    if (IN(8)) { pg8::Gemm g{ACTB, (const bf16_t*)(ws + WS_WG), M_TOK, 1024, 1024}; pg8::StaticOrder S; S.init(M_TOK, 1024, C.G, (int)blockIdx.x); pg8::EpiGate E{prm.out, ACTB, PPB, (const float*)(ws + WS_RINV3)};
        pg8::gemm_phase<pg8::EpiGate, pg8::StaticOrder, true, true>(C.lds, g, S, E); }
#undef IN
#undef SEAM
}

extern "C" void kernel_launch(void* const* d_in, const int* in_sizes, int n_in, void* d_out, int out_size, void* d_ws, size_t ws_size, hipStream_t stream) {
    static int grid = 0;
    if (grid == 0) {
        if (n_in != 23 || in_sizes[0] != M_TOK * DM || out_size != M_TOK * DM || ws_size < WS_END) { fprintf(stderr, "kernel_launch: unexpected shapes (n_in %d in0 %d out %d ws %zu)\n", n_in, n_in > 0 ? in_sizes[0] : -1, out_size, ws_size); grid = -1; return; }
        int dev = 0, cus = 0, per_cu = 0;
        hipGetDevice(&dev); hipDeviceGetAttribute(&cus, hipDeviceAttributeMultiprocessorCount, dev);
        hipFuncSetAttribute((const void*)mk_fwd, hipFuncAttributeMaxDynamicSharedMemorySize, LDS_BYTES);
        hipOccupancyMaxActiveBlocksPerMultiprocessor(&per_cu, (const void*)mk_fwd, 512, LDS_BYTES);
        if (per_cu < 1) { fprintf(stderr, "kernel_launch: occupancy query says %d blocks per CU\n", per_cu); per_cu = 1; }
        (void)hipGetLastError();
        grid = cus;
    }
    if (grid < 0) return;
    hipMemsetAsync((char*)d_ws + WS_CTL, 0, CTL_BYTES, stream);
    Params prm{};
    for (int i = 0; i < 23; ++i) prm.in[i] = (const float*)d_in[i];
    prm.out = (float*)d_out; prm.ws = (unsigned char*)d_ws;
#if MK_MULTI
    for (int ph = 0; ph < N_PHASES; ++ph) { prm.ph_lo = ph; prm.ph_hi = ph + 1; hipLaunchKernelGGL(mk_fwd, dim3(grid), dim3(512), LDS_BYTES, stream, prm); }
#else
    prm.ph_lo = 0; prm.ph_hi = N_PHASES;
#if MK_COOP_SYNC0
    void* args[] = {&prm};
    hipError_t e = hipLaunchCooperativeKernel((const void*)mk_fwd, dim3(grid), dim3(512), args, LDS_BYTES, stream);
    if (e != hipSuccess) fprintf(stderr, "cooperative launch failed: %s (grid %d)\n", hipGetErrorString(e), grid);
#else
    hipLaunchKernelGGL(mk_fwd, dim3(grid), dim3(512), LDS_BYTES, stream, prm);
#endif
#endif
}
```

```cpp
#include <hip/hip_runtime.h>
#include <hip/hip_cooperative_groups.h>
#include <cstdio>
#include <cstdint>
#include <cmath>
namespace cg = cooperative_groups;

#ifndef MK_COOP_SYNC0
#define MK_COOP_SYNC0 1
#endif
#ifndef MK_MULTI
#define MK_MULTI 0
#endif

#ifndef PROBE_ATTN2
#define PROBE_ATTN2 0
#endif
#ifndef PROBE_G1
#define PROBE_G1 0
#endif
#ifndef PROBE_G5
#define PROBE_G5 0
#endif
#ifndef PROBE_PREP
#define PROBE_PREP 0
#endif
#ifndef PROBE_ATTN
#define PROBE_ATTN 0
#endif
#ifndef PROBE_TOPK
#define PROBE_TOPK 0
#endif
#ifndef PROBE_GATHER
#define PROBE_GATHER 0
#endif
#ifndef PROBE_SYNC
#define PROBE_SYNC 0
#endif
#define LAS __attribute__((address_space(3)))
typedef unsigned short bf16_t;
typedef short bf16x8 __attribute__((ext_vector_type(8)));
typedef short s16x4 __attribute__((ext_vector_type(4)));
typedef float f32x4 __attribute__((ext_vector_type(4)));
typedef float f32x2 __attribute__((ext_vector_type(2)));
typedef float f32x16 __attribute__((ext_vector_type(16)));
typedef unsigned u32x4 __attribute__((ext_vector_type(4)));
typedef unsigned u32x2 __attribute__((ext_vector_type(2)));
typedef __bf16 bf16x2_t __attribute__((ext_vector_type(2)));
typedef _Float16 f16x8 __attribute__((ext_vector_type(8)));
typedef _Float16 f16x2 __attribute__((ext_vector_type(2)));

constexpr int M_TOK = 32768, DM = 1024, SEQ = 8192, NB = 4, ZLD = 2048, DPLE = 256;
constexpr float EPS = 1e-6f;
constexpr float U4SCALE = 64.0f, V4SCALE = 5.656854249f;
constexpr float QSCALE = 0.125f * 1.4426950408889634f;
constexpr size_t MiB = 1u << 20;
constexpr size_t WS_CTL = 0, CTL_BYTES = 1 * MiB;
constexpr size_t WS_ROWSS2 = 256 * 1024;
constexpr size_t WS_WIN = 1 * MiB, WS_WO = 5 * MiB, WS_WS = 7 * MiB, WS_WG = 11 * MiB, WS_WP = 13 * MiB, WS_RINV3 = 14 * MiB;
constexpr size_t WS_UT = 16 * MiB  , WS_VT = 48 * MiB  , WS_ACTB = 80 * MiB, WS_PB = 144 * MiB, WS_Z = 160 * MiB, WS_YCAT = 288 * MiB, WS_PP = 352 * MiB;
constexpr size_t WS_EIDX = 416 * MiB, WS_GATE = 432 * MiB, WS_CST = 448 * MiB, WS_END = 452 * MiB;
constexpr int LDS_BYTES = 147456;

__device__ __forceinline__ unsigned cvtpk(float lo, float hi) { f32x2 v = {lo, hi}; bf16x2_t b = __builtin_convertvector(v, bf16x2_t); return __builtin_bit_cast(unsigned, b); }
__device__ __forceinline__ float bflo(unsigned w) { return __uint_as_float(w << 16); }
__device__ __forceinline__ float bfhi(unsigned w) { return __uint_as_float(w & 0xffff0000u); }
__device__ __forceinline__ unsigned pack_i8(const f32x4 v) {
    int a = __float2int_rn(v[0]), b = __float2int_rn(v[1]), c = __float2int_rn(v[2]), d = __float2int_rn(v[3]);
    a = a < -127 ? -127 : (a > 127 ? 127 : a); b = b < -127 ? -127 : (b > 127 ? 127 : b); c = c < -127 ? -127 : (c > 127 ? 127 : c); d = d < -127 ? -127 : (d > 127 ? 127 : d);
    return ((unsigned)a & 0xffu) | (((unsigned)b & 0xffu) << 8) | (((unsigned)c & 0xffu) << 16) | ((unsigned)d << 24);
}
__device__ __forceinline__ unsigned pack_u4x8(const f32x4 a, const f32x4 b) {
    unsigned w = 0;
#pragma unroll
    for (int i = 0; i < 4; ++i) { int lo = __float2int_rn(a[i]), hi = __float2int_rn(b[i]); lo = lo < -8 ? -8 : (lo > 7 ? 7 : lo); hi = hi < -8 ? -8 : (hi > 7 ? 7 : hi);
        w |= ((unsigned)(lo + 8) | ((unsigned)(hi + 8) << 4)) << (8 * i); }
    return w;
}
__device__ __forceinline__ float wave_sum(float v) {
#pragma unroll
    for (int o = 1; o < 64; o <<= 1) v += __shfl_xor(v, o);
    return v;
}

namespace pg8 {
#define PG8_LAS __attribute__((address_space(3)))
constexpr int BM = 256, BK = 64, HALF = 128, HTB = HALF * BK * 2, STAGE_BYTES = 8 * HTB, NXCD = 8, WGM = 8;
__host__ __device__ __forceinline__ int lds_byte(int r, int c) { const int st = (r >> 4) * 2 + (c >> 5), rr = r & 15, cc = c & 31, ob = rr * 64 + cc * 2; return st * 1024 + (ob ^ (((ob >> 9) & 1) << 5)); }
__host__ __device__ __forceinline__ void stage_rc(int b, int& R, int& C) { const int st = b / 1024, sb = b % 1024, swz = sb ^ (((sb >> 9) & 1) << 5); R = (st >> 1) * 16 + swz / 64; C = (st & 1) * 32 + (swz % 64) / 2; }
__host__ __device__ __forceinline__ int perm32(int rho) { const int n = rho >> 4, i = rho & 15; return 8 * (i >> 2) + 4 * n + (i & 3); }
struct Unit { int pm, pn; };
struct Gemm { const bf16_t* A; const bf16_t* Bt; int M, N, K; };
struct StaticOrder {
    int nM, nN, nwg, G, c;
    __host__ __device__ void init(int M, int N, int G_, int c_) { nM = M / BM; nN = N / BM; nwg = nM * nN; G = G_; c = c_; }
    __host__ __device__ bool next(int i, Unit& u) const {
        const long L = (long)i * G + c; if (L >= nwg) return false;
        int wgid = (int)L; { const int q = nwg / NXCD, r = nwg % NXCD, xcd = wgid % NXCD, off = wgid / NXCD; wgid = (xcd < r ? xcd * (q + 1) : r * (q + 1) + (xcd - r) * q) + off; }
        const int nig = WGM * nN, gid = wgid / nig, fm = gid * WGM, gsz = (nM - fm) < WGM ? (nM - fm) : WGM;
        u.pm = fm + ((wgid % nig) % gsz); u.pn = (wgid % nig) / gsz; return true;
    }
    __device__ __forceinline__ void a_ready(const Unit&) const {}
    __device__ __forceinline__ void done(const Unit&) const {}
};
template <class Epi, class Sched, bool ALIGN_EPI = false, bool SP2 = false>
__device__ __forceinline__ void gemm_phase(PG8_LAS unsigned char* lds, const Gemm g, const Sched& S, const Epi& E) {
    int tid = threadIdx.x; asm volatile("" : "+v"(tid));
    const int wid = __builtin_amdgcn_readfirstlane(tid >> 6), lane = tid & 63, wr = wid >> 2, wc = wid & 3, fr = lane & 15, fq = lane >> 4;
    const int K = g.K, nt = K / BK;
    unsigned voffA[2], voffB[2];
#pragma unroll
    for (int i = 0; i < 2; ++i) { int R, C; stage_rc(tid * 16 + i * 8192, R, C); const int Rb = Epi::PAIRMAP ? (64 * (R >> 5) + perm32(R & 31)) : Epi::PERM ? ((R & ~31) + perm32(R & 31)) : R;
        voffA[i] = (unsigned)(R * K + C) * 2u; voffB[i] = (unsigned)(Rb * K + C) * 2u; }
    const size_t hstepB = (size_t)(Epi::PAIRMAP ? 32 : HALF) * K * 2;
    const size_t kstep = (size_t)(BK * 2);
    const size_t hstep = (size_t)HALF * K * 2;
    const size_t tstep = 2 * hstep;
    const unsigned ldsw = (unsigned)wid * 1024u;
    const int aoff = lds_byte(wr * 64 + fr, fq * 8), boff = lds_byte(wc * 32 + fr, fq * 8);
#define PG8_SA(b, h) (((b) * 2 + (h)) * HTB)
#define PG8_SB(b, h) ((4 + (b) * 2 + (h)) * HTB)
#define PG8_STAGE(bufoff, gbase, voff) do { _Pragma("unroll") for (int _i = 0; _i < 2; ++_i) \
        __builtin_amdgcn_global_load_lds((const unsigned*)((const char*)(gbase) + (voff)[_i]), (PG8_LAS unsigned*)(lds + (bufoff) + ldsw + _i * 8192), 16, 0, 0); } while (0)
#define PG8_LDA(dst, b, h) do { _Pragma("unroll") for (int m = 0; m < 4; ++m) _Pragma("unroll") for (int k = 0; k < 2; ++k) dst[m][k] = *(const PG8_LAS bf16x8*)(lds + PG8_SA(b, h) + aoff + m * 2048 + k * 1024); } while (0)
#define PG8_LDB(dst, b, h) do { _Pragma("unroll") for (int n = 0; n < 2; ++n) _Pragma("unroll") for (int k = 0; k < 2; ++k) dst[n][k] = *(const PG8_LAS bf16x8*)(lds + PG8_SB(b, h) + boff + n * 2048 + k * 1024); } while (0)
#define PG8_MMA(ai, bj, At, Bt) do { __builtin_amdgcn_s_setprio(1); _Pragma("unroll") for (int m = 0; m < 4; ++m) _Pragma("unroll") for (int n = 0; n < 2; ++n) _Pragma("unroll") for (int k = 0; k < 2; ++k) \
        acc[ai][bj][m][n] = __builtin_amdgcn_mfma_f32_16x16x32_bf16(Bt[n][k], At[m][k], acc[ai][bj][m][n], 0, 0, 0); __builtin_amdgcn_s_setprio(0); } while (0)
#define PG8_WAIT_V(n) asm volatile("s_waitcnt vmcnt(" #n ")" ::: "memory")
#define PG8_WAIT_L(n) asm volatile("s_waitcnt lgkmcnt(" #n ")" ::: "memory")
#define PG8_BAR __builtin_amdgcn_s_barrier()
#define PG8_SCHED __builtin_amdgcn_sched_barrier(0)
    Unit cur, nxt; int ui = 0;
    if (!S.next(0, cur)) return;
    f32x4 acc[2][2][4][2];
#pragma unroll
    for (int a = 0; a < 2; ++a)
#pragma unroll
        for (int b = 0; b < 2; ++b)
#pragma unroll
            for (int m = 0; m < 4; ++m)
#pragma unroll
                for (int n = 0; n < 2; ++n) acc[a][b][m][n] = (f32x4){0.f, 0.f, 0.f, 0.f};
    bf16x8 At[4][2], B0[2][2], B1[2][2];
    const char* cA = (const char*)g.A + (size_t)cur.pm * tstep; const char* cB = (const char*)g.Bt + (size_t)cur.pn * tstep;
    S.a_ready(cur);
    if constexpr (SP2) {
        PG8_STAGE(PG8_SB(0, 0), cB, voffB); PG8_STAGE(PG8_SB(0, 1), cB + hstepB, voffB); PG8_STAGE(PG8_SA(0, 0), cA, voffA); PG8_STAGE(PG8_SA(0, 1), cA + hstep, voffA);
        if (wr == 1) PG8_BAR;
        PG8_WAIT_V(2); PG8_BAR;
        PG8_STAGE(PG8_SB(1, 0), cB + kstep, voffB); PG8_STAGE(PG8_SA(1, 0), cA + kstep, voffA); PG8_STAGE(PG8_SB(1, 1), cB + hstepB + kstep, voffB);
        PG8_WAIT_V(6); PG8_BAR;
    } else {
        PG8_STAGE(PG8_SB(0, 0), cB, voffB); PG8_STAGE(PG8_SA(0, 0), cA, voffA); PG8_STAGE(PG8_SB(0, 1), cB + hstepB, voffB); PG8_STAGE(PG8_SA(0, 1), cA + hstep, voffA);
        if (wr == 1) PG8_BAR;
        PG8_WAIT_V(4); PG8_BAR;
        PG8_STAGE(PG8_SB(1, 0), cB + kstep, voffB); PG8_STAGE(PG8_SA(1, 0), cA + kstep, voffA); PG8_STAGE(PG8_SB(1, 1), cB + hstepB + kstep, voffB);
        PG8_WAIT_V(6); PG8_BAR;
    }
    for (;;) {
        const bool has_next = S.next(ui + 1, nxt);
        const char* nA = has_next ? (const char*)g.A + (size_t)nxt.pm * tstep : cA; const char* nB = has_next ? (const char*)g.Bt + (size_t)nxt.pn * tstep : cB;
#pragma unroll 1
        for (int t = 0; t < nt; t += 2) {
            const bool last = (t == nt - 2);
            const char* a1 = cA + (size_t)(t + 1) * kstep;
            const char* a2 = last ? nA : cA + (size_t)(t + 2) * kstep; const char* b2 = last ? nB : cB + (size_t)(t + 2) * kstep;
            const char* a3 = a2 + kstep; const char* b3 = b2 + kstep;
            if (last && has_next) S.a_ready(nxt);
            if constexpr (SP2) {
            PG8_LDB(B0, 0, 0); PG8_LDB(B1, 0, 1); PG8_SCHED; PG8_LDA(At, 0, 0); PG8_STAGE(PG8_SA(1, 1), a1 + hstep, voffA);
            PG8_WAIT_V(8); PG8_WAIT_L(0); PG8_BAR; PG8_MMA(0, 0, At, B0); PG8_MMA(0, 1, At, B1); PG8_BAR; PG8_SCHED;
            PG8_LDA(At, 0, 1); PG8_STAGE(PG8_SB(0, 0), b2, voffB); PG8_STAGE(PG8_SB(0, 1), b2 + hstepB, voffB); PG8_STAGE(PG8_SA(0, 0), a2, voffA);
            PG8_WAIT_V(8); PG8_WAIT_L(0); PG8_BAR; PG8_MMA(1, 0, At, B0); PG8_MMA(1, 1, At, B1); PG8_BAR; PG8_SCHED;
            PG8_LDB(B0, 1, 0); PG8_LDB(B1, 1, 1); PG8_SCHED; PG8_LDA(At, 1, 0); PG8_STAGE(PG8_SA(0, 1), a2 + hstep, voffA);
            PG8_WAIT_V(8); PG8_WAIT_L(0); PG8_BAR; PG8_MMA(0, 0, At, B0); PG8_MMA(0, 1, At, B1); PG8_BAR; PG8_SCHED;
            PG8_LDA(At, 1, 1); PG8_STAGE(PG8_SB(1, 0), b3, voffB); PG8_STAGE(PG8_SB(1, 1), b3 + hstepB, voffB); PG8_STAGE(PG8_SA(1, 0), a3, voffA);
            PG8_WAIT_V(8); PG8_WAIT_L(0); PG8_BAR; PG8_MMA(1, 0, At, B0); PG8_MMA(1, 1, At, B1); PG8_BAR; PG8_SCHED;
            } else {
            PG8_LDB(B0, 0, 0); PG8_SCHED; PG8_LDA(At, 0, 0); PG8_STAGE(PG8_SA(1, 1), a1 + hstep, voffA);
            PG8_WAIT_L(8); PG8_BAR; PG8_WAIT_L(0); PG8_MMA(0, 0, At, B0); PG8_BAR; PG8_SCHED;
            PG8_LDB(B1, 0, 1); PG8_STAGE(PG8_SB(0, 0), b2, voffB);
            PG8_BAR; PG8_WAIT_L(0); PG8_MMA(0, 1, At, B1); PG8_BAR;
            PG8_LDA(At, 0, 1); PG8_STAGE(PG8_SA(0, 0), a2, voffA);
            PG8_BAR; PG8_WAIT_L(0); PG8_MMA(1, 0, At, B0); PG8_BAR; PG8_SCHED;
            PG8_STAGE(PG8_SB(0, 1), b2 + hstepB, voffB);
            PG8_WAIT_V(6); PG8_BAR; PG8_MMA(1, 1, At, B1); PG8_BAR;
            PG8_LDB(B0, 1, 0); PG8_SCHED; PG8_LDA(At, 1, 0); PG8_STAGE(PG8_SA(0, 1), a2 + hstep, voffA);
            PG8_WAIT_L(8); PG8_BAR; PG8_WAIT_L(0); PG8_MMA(0, 0, At, B0); PG8_BAR; PG8_SCHED;
            PG8_LDB(B1, 1, 1); PG8_STAGE(PG8_SB(1, 0), b3, voffB);
            PG8_BAR; PG8_WAIT_L(0); PG8_MMA(0, 1, At, B1); PG8_BAR;
            PG8_LDA(At, 1, 1); PG8_STAGE(PG8_SA(1, 0), a3, voffA);
            PG8_BAR; PG8_WAIT_L(0); PG8_MMA(1, 0, At, B0); PG8_BAR; PG8_SCHED;
            PG8_STAGE(PG8_SB(1, 1), b3 + hstepB, voffB);
            PG8_WAIT_V(6); PG8_BAR; PG8_MMA(1, 1, At, B1); PG8_BAR;
            }
        }
        if constexpr (ALIGN_EPI) { if (wr == 0) PG8_BAR; }
        if constexpr (!Epi::AFTER_DRAIN) { E(acc, cur, wr, wc, fr, fq); S.done(cur); }
        if (!has_next) break;
#pragma unroll
        for (int a = 0; a < 2; ++a)
#pragma unroll
            for (int b = 0; b < 2; ++b)
#pragma unroll
                for (int m = 0; m < 4; ++m)
#pragma unroll
                    for (int n = 0; n < 2; ++n) acc[a][b][m][n] = (f32x4){0.f, 0.f, 0.f, 0.f};
        cur = nxt; cA = nA; cB = nB; ++ui;
        if constexpr (ALIGN_EPI) { if (wr == 1) PG8_BAR; }
    }
    PG8_WAIT_V(0);
    if constexpr (!ALIGN_EPI) { if (wr == 0) PG8_BAR; }
    PG8_BAR;
#undef PG8_SA
#undef PG8_SB
#undef PG8_STAGE
#undef PG8_LDA
#undef PG8_LDB
#undef PG8_MMA
#undef PG8_WAIT_V
#undef PG8_WAIT_L
#undef PG8_BAR
#undef PG8_SCHED
}

struct EpiStoreBf16 {
    static constexpr bool PERM = true, AFTER_DRAIN = false, PAIRMAP = false;
    bf16_t* O; int ldc;
    __device__ __forceinline__ void operator()(const f32x4 (&acc)[2][2][4][2], const Unit& u, int wr, int wc, int fr, int fq) const {
        const int row0 = u.pm * BM + wr * 64 + fr, col0 = u.pn * BM + wc * 32 + 8 * fq;
#pragma unroll
        for (int ai = 0; ai < 2; ++ai)
#pragma unroll
            for (int m = 0; m < 4; ++m) { bf16_t* rowp = O + (size_t)(row0 + ai * HALF + m * 16) * ldc + col0;
#pragma unroll
                for (int bj = 0; bj < 2; ++bj) { const f32x4 v0 = acc[ai][bj][m][0], v1 = acc[ai][bj][m][1];
                    u32x4 w; w.x = cvtpk(v0[0], v0[1]); w.y = cvtpk(v0[2], v0[3]); w.z = cvtpk(v1[0], v1[1]); w.w = cvtpk(v1[2], v1[3]);
                    *(u32x4*)(rowp + bj * HALF) = w; } }
    }
};
typedef _Float16 hf2 __attribute__((ext_vector_type(2)));
struct EpiZ {
    static constexpr bool PERM = true, AFTER_DRAIN = false, PAIRMAP = true;
    bf16_t* O; int ldc; const float* qn; const float* kn; const unsigned* cst;
    __device__ __forceinline__ void operator()(const f32x4 (&acc)[2][2][4][2], const Unit& u, int wr, int wc, int fr, int fq) const {
        asm volatile("" : "+v"(fr), "+v"(fq));
        const int row0 = u.pm * BM + wr * 64 + fr, col0 = u.pn * BM + wc * 64 + 8 * fq;
        const int kind = u.pn >> 1;
        if (kind == 0 || kind == 3) {
#pragma unroll
            for (int ai = 0; ai < 2; ++ai)
#pragma unroll
                for (int m = 0; m < 4; ++m) { bf16_t* rowp = O + (size_t)(row0 + ai * HALF + m * 16) * ldc + col0;
#pragma unroll
                    for (int bj = 0; bj < 2; ++bj) { const f32x4 v0 = acc[ai][bj][m][0], v1 = acc[ai][bj][m][1];
                        u32x4 w; w.x = cvtpk(v0[0], v0[1]); w.y = cvtpk(v0[2], v0[3]); w.z = cvtpk(v1[0], v1[1]); w.w = cvtpk(v1[2], v1[3]);
                        *(u32x4*)(rowp + bj * 32) = w; } }
            return;
        }
        const float* gn = kind == 1 ? qn : kn; const float osc = kind == 1 ? QSCALE : 1.0f;
        float g1[8], g2[8];
#pragma unroll
        for (int t = 0; t < 8; ++t) { g1[t] = gn[8 * fq + t] * osc; g2[t] = gn[32 + 8 * fq + t] * osc; }
        const unsigned* cp = cst + (size_t)row0 * 32 + 8 * fq;
        u32x4 c0 = *(const u32x4*)cp, c1 = *(const u32x4*)(cp + 4);
#pragma unroll
        for (int it = 0; it < 8; ++it) {
            const int ai = it >> 2, m = it & 3, row = row0 + ai * HALF + m * 16;
            u32x4 n0 = c0, n1 = c1;
            if (it < 7) { const unsigned* np = cp + (size_t)(((it + 1) >> 2) * HALF + ((it + 1) & 3) * 16) * 32; n0 = *(const u32x4*)np; n1 = *(const u32x4*)(np + 4); }
            const unsigned cw[8] = {c0.x, c0.y, c0.z, c0.w, c1.x, c1.y, c1.z, c1.w};
            float t1[8], t2[8];
#pragma unroll
            for (int t = 0; t < 8; ++t) { t1[t] = acc[ai][0][m][t >> 2][t & 3]; t2[t] = acc[ai][1][m][t >> 2][t & 3]; }
            float ss = 0.f;
#pragma unroll
            for (int t = 0; t < 8; ++t) ss += t1[t] * t1[t] + t2[t] * t2[t];
            ss += __shfl_xor(ss, 16); ss += __shfl_xor(ss, 32);
            const float ri = rsqrtf(ss * (1.0f / 64.0f) + EPS);
            float o1[8], o2[8];
#pragma unroll
            for (int t = 0; t < 8; ++t) {
                const hf2 cs2 = __builtin_bit_cast(hf2, cw[t]); const float cs = (float)cs2[0], sn = (float)cs2[1];
                const float x1 = t1[t] * (ri * g1[t]), x2 = t2[t] * (ri * g2[t]);
                o1[t] = x1 * cs - x2 * sn; o2[t] = x2 * cs + x1 * sn;
            }
            bf16_t* rowp = O + (size_t)row * ldc + col0;
            *(u32x4*)rowp = (u32x4){cvtpk(o1[0], o1[1]), cvtpk(o1[2], o1[3]), cvtpk(o1[4], o1[5]), cvtpk(o1[6], o1[7])};
            *(u32x4*)(rowp + 32) = (u32x4){cvtpk(o2[0], o2[1]), cvtpk(o2[2], o2[3]), cvtpk(o2[4], o2[5]), cvtpk(o2[6], o2[7])};
            __builtin_amdgcn_sched_barrier(0);
            c0 = n0; c1 = n1;
        }
    }
};
struct EpiScores {
    static constexpr bool PERM = true, AFTER_DRAIN = false, PAIRMAP = false;
    _Float16* O; int ldc; const float* rowss;
    __device__ __forceinline__ void operator()(const f32x4 (&acc)[2][2][4][2], const Unit& u, int wr, int wc, int fr, int fq) const {
        const int row0 = u.pm * BM + wr * 64 + fr, col0 = u.pn * BM + wc * 32 + 8 * fq;
#pragma unroll
        for (int ai = 0; ai < 2; ++ai)
#pragma unroll
            for (int m = 0; m < 4; ++m) { const int row = row0 + ai * HALF + m * 16; const float ri = rsqrtf(rowss[row] * (1.0f / 1024.0f) + EPS);
                _Float16* rowp = O + (size_t)row * ldc + col0;
#pragma unroll
                for (int bj = 0; bj < 2; ++bj) { const f32x4 v0 = acc[ai][bj][m][0] * ri, v1 = acc[ai][bj][m][1] * ri;
                    f16x8 w = {(_Float16)v0[0], (_Float16)v0[1], (_Float16)v0[2], (_Float16)v0[3], (_Float16)v1[0], (_Float16)v1[1], (_Float16)v1[2], (_Float16)v1[3]};
                    *(f16x8*)(rowp + bj * HALF) = w; } }
    }
};
struct EpiWo {
    static constexpr bool PERM = false, AFTER_DRAIN = false, PAIRMAP = false;
    const float* X; bf16_t* HB; float* rowss;
    __device__ __forceinline__ void operator()(const f32x4 (&acc)[2][2][4][2], const Unit& u, int wr, int wc, int fr, int fq) const {
        const int row0 = u.pm * BM + wr * 64 + fr, col0 = u.pn * BM + wc * 32 + 4 * fq;
#pragma unroll
        for (int ai = 0; ai < 2; ++ai)
#pragma unroll
            for (int m = 0; m < 4; ++m) { const int row = row0 + ai * HALF + m * 16; const size_t off = (size_t)row * DM + col0; float ss = 0.f;
#pragma unroll
                for (int bj = 0; bj < 2; ++bj)
#pragma unroll
                    for (int n = 0; n < 2; ++n) { const size_t o2 = off + bj * HALF + n * 16; const f32x4 h = *(const f32x4*)(X + o2) + acc[ai][bj][m][n];
                        u32x2 w; w.x = cvtpk(h[0], h[1]); w.y = cvtpk(h[2], h[3]); *(u32x2*)(HB + o2) = w;
                        ss += (h[0] * h[0] + h[1] * h[1]) + (h[2] * h[2] + h[3] * h[3]); }
                ss += __shfl_xor(ss, 16); ss += __shfl_xor(ss, 32);
                if (fq == 0) atomicAdd(rowss + row, ss); }
    }
};
struct EpiGate {
    static constexpr bool PERM = false, AFTER_DRAIN = false, PAIRMAP = false;
    float* HO; const bf16_t* HB; const bf16_t* PP; const float* rinv;
    __device__ __forceinline__ void operator()(const f32x4 (&acc)[2][2][4][2], const Unit& u, int wr, int wc, int fr, int fq) const {
        const int row0 = u.pm * BM + wr * 64 + fr, col0 = u.pn * BM + wc * 32 + 4 * fq;
#pragma unroll
        for (int ai = 0; ai < 2; ++ai)
#pragma unroll
            for (int m = 0; m < 4; ++m) { const int row = row0 + ai * HALF + m * 16; const size_t off = (size_t)row * DM + col0; const float ri = rinv[row];
#pragma unroll
                for (int bj = 0; bj < 2; ++bj)
#pragma unroll
                    for (int n = 0; n < 2; ++n) { const size_t o2 = off + bj * HALF + n * 16; const u32x2 hw = *(const u32x2*)(HB + o2); const f32x4 h = {bflo(hw.x), bfhi(hw.x), bflo(hw.y), bfhi(hw.y)}; const u32x2 pw = *(const u32x2*)(PP + o2);
                        const f32x4 a = acc[ai][bj][m][n] * ri; f32x4 o;
                        o[0] = h[0] + bflo(pw.x) / (1.0f + __expf(-a[0])); o[1] = h[1] + bfhi(pw.x) / (1.0f + __expf(-a[1]));
                        o[2] = h[2] + bflo(pw.y) / (1.0f + __expf(-a[2])); o[3] = h[3] + bfhi(pw.y) / (1.0f + __expf(-a[3]));
                        *(f32x4*)(HO + o2) = o; } }
    }
};
}

#define XB_TMO      128
#define XB_XCNT(j)  (256  + 64 * (j))
#define XB_XSUB(j)  (1280 + 64 * (j))
#define XB_XGEN(j)  (2304 + 64 * (j))
#define XB_TOP      3328
#define XB_TOPGEN   3392
#define XCD_BAR_WORDS 3456
#define XB_SPIN_CAP (1u << 18)
__device__ __forceinline__ unsigned xb_ld(unsigned* p)              { return __hip_atomic_load(p, __ATOMIC_RELAXED, __HIP_MEMORY_SCOPE_AGENT); }
__device__ __forceinline__ unsigned xb_add(unsigned* p, unsigned v) { return __hip_atomic_fetch_add(p, v, __ATOMIC_RELAXED, __HIP_MEMORY_SCOPE_AGENT); }
__device__ __forceinline__ unsigned xb_xcc_id() { return (unsigned)__builtin_amdgcn_s_getreg((3 << 11) | 20) & 0xFu; }
#define XB_SPIN(cond, bar) do { unsigned _sp = 0; while (cond) { __builtin_amdgcn_s_sleep(1); \
    if ((++_sp & 255u) == 0u) { if (xb_ld(&(bar)[XB_TMO])) break; if (_sp > XB_SPIN_CAP) { atomicAdd(&(bar)[XB_TMO], 1u); break; } } } } while (0)
struct XcdBarrier { unsigned* bar; unsigned x; volatile LAS unsigned* st; };
__device__ __forceinline__ XcdBarrier xcd_barrier_post(unsigned* bar, volatile LAS unsigned* st) {
    XcdBarrier b; b.bar = bar; b.x = xb_xcc_id(); b.st = st;
    if (threadIdx.x == 0) (void)xb_add(&bar[XB_XCNT(b.x)], 1u);
    return b;
}
__device__ __forceinline__ void xcd_barrier_complete(unsigned* bar, unsigned x, unsigned& nloc, unsigned& nx) {
    const unsigned G = gridDim.x * gridDim.y * gridDim.z;
    unsigned sum, cnt, mine, sp = 0u;
    for (;;) {
        sum = 0u; cnt = 0u; mine = 0u;
#pragma unroll
        for (unsigned j = 0; j < 16; ++j) { const unsigned c = xb_ld(&bar[XB_XCNT(j)]); sum += c; cnt += (c > 0u) ? 1u : 0u; mine = (j == x) ? c : mine; }
        if (sum == G) break;
        __builtin_amdgcn_s_sleep(1);
        if ((++sp & 255u) == 0u) { if (xb_ld(&bar[XB_TMO])) break; if (sp > XB_SPIN_CAP) { atomicAdd(&bar[XB_TMO], 1u); break; } }
    }
    nloc = mine > 0u ? mine : 1u; nx = cnt > 0u ? cnt : 1u;
}
__device__ __forceinline__ void xcd_barrier(const XcdBarrier& b) {
    asm volatile("s_waitcnt vmcnt(0)" ::: "memory");
    __syncthreads();
    if (threadIdx.x == 0) {
        unsigned* bar = b.bar;
        __builtin_amdgcn_s_waitcnt(0);
        unsigned nloc = b.st[0], nx = b.st[1];
        if (nloc == 0u) { xcd_barrier_complete(bar, b.x, nloc, nx); b.st[0] = nloc; b.st[1] = nx; }
        const unsigned old = xb_add(&bar[XB_XSUB(b.x)], 1u);
        const unsigned gen = old / nloc;
        if (old + 1u == (gen + 1u) * nloc) {
            __builtin_amdgcn_fence(__ATOMIC_RELEASE, "agent");
            asm volatile("s_waitcnt vmcnt(0)" ::: "memory");
            const unsigned og = xb_add(&bar[XB_TOP], 1u);
            const unsigned tg = og / nx;
            if (og + 1u == (tg + 1u) * nx) xb_add(&bar[XB_TOPGEN], 1u);
            else XB_SPIN(xb_ld(&bar[XB_TOPGEN]) == tg, bar);
            __builtin_amdgcn_fence(__ATOMIC_ACQUIRE, "agent");
            xb_add(&bar[XB_XGEN(b.x)], 1u);
            asm volatile("s_waitcnt vmcnt(0)" ::: "memory");
        } else {
            __builtin_amdgcn_fence(__ATOMIC_ACQUIRE, "agent");
            asm volatile("s_waitcnt vmcnt(0)" ::: "memory");
            XB_SPIN(xb_ld(&bar[XB_XGEN(b.x)]) == gen, bar);
        }
    }
    __syncthreads();
}

struct Params { const float* in[23]; float* out; unsigned char* ws; int ph_lo, ph_hi; };
enum { I_X = 0, I_P, I_POS, I_LNMIX, I_WIN, I_POOLW, I_POOLS, I_QN, I_KN, I_LQ1, I_LK1, I_LQ2, I_LK2, I_SUBLN, I_WO, I_LNFFN, I_WPQ, I_SUBK, I_PU, I_PV, I_LNPE, I_WG, I_WPP };

struct Ctx {
    LAS unsigned char* lds; int tid, lane, wave, G, vcu;
    const Params* p;
};

__device__ __forceinline__ void transpose_item(const float* W, int ldw, int coff, const float* gain, bf16_t* WT, int ldk, int roff, int nblk, LAS float* scr, int item, int lane) {
    const int kb = item / nblk, nb = item % nblk, k0 = 64 * kb, n0 = 32 * nb;
#pragma unroll 8
    for (int i = 0; i < 32; ++i) { const int kk = 2 * i + (lane >> 5); const float gsc = gain ? gain[k0 + kk] : 1.0f; scr[kk * 33 + (lane & 31)] = W[(size_t)(k0 + kk) * ldw + coff + n0 + (lane & 31)] * gsc; }
    asm volatile("s_waitcnt lgkmcnt(0)" ::: "memory");
    const int c = lane & 7;
#pragma unroll
    for (int j = 0; j < 4; ++j) { const int n = (lane >> 3) + 8 * j; const LAS float* s = scr + (8 * c) * 33 + n;
        u32x4 o; o.x = cvtpk(s[0 * 33], s[1 * 33]); o.y = cvtpk(s[2 * 33], s[3 * 33]); o.z = cvtpk(s[4 * 33], s[5 * 33]); o.w = cvtpk(s[6 * 33], s[7 * 33]);
        *(u32x4*)(WT + (size_t)(roff + n0 + n) * ldk + k0 + 8 * c) = o; }
    asm volatile("s_waitcnt lgkmcnt(0)" ::: "memory");
}

template <int ROWS, bool POOL> __device__ __forceinline__ void fold_items(const Ctx& C) {
    const Params& P = *C.p; unsigned char* ws = P.ws; const int tid = C.tid;
    bf16_t* WinT = (bf16_t*)(ws + WS_WIN); bf16_t* WsT = (bf16_t*)(ws + WS_WS);
    constexpr int KT = 1024 / ROWS, NIT = (POOL ? 4 : 16) * KT, RPT = ROWS / 4;
    LAS float* As = (LAS float*)C.lds;
    LAS float* Bs = (LAS float*)(C.lds + 32768);
    for (int it = blockIdx.x; it < NIT; it += C.G) {
        const int blk = it / KT, k0 = (it % KT) * ROWS;
        const float* Asrc = (POOL ? P.in[I_WIN] : P.in[I_WPQ]) + blk * 128;
        const float* Bsrc = (POOL ? P.in[I_POOLW] : P.in[I_SUBK]) + (size_t)blk * 128 * 128;
#pragma unroll
        for (int i = 0; i < ROWS / 16; ++i) { const int v = tid + 512 * i, r = v >> 5, c4 = v & 31; *(LAS f32x4*)(As + r * 128 + c4 * 4) = *(const f32x4*)(Asrc + (size_t)(k0 + r) * 2048 + c4 * 4); }
        { f32x4 bv[8];
#pragma unroll
          for (int i = 0; i < 8; ++i) bv[i] = *(const f32x4*)(Bsrc + 4 * (tid + 512 * i));
#pragma unroll
          for (int i = 0; i < 8; ++i) { const int idx = 4 * (tid + 512 * i), r = idx >> 7, c = idx & 127;
#pragma unroll
              for (int q = 0; q < 4; ++q) { if (POOL) Bs[r * 129 + c + q] = bv[i][q]; else Bs[(c + q) * 129 + r] = bv[i][q]; } } }
        __syncthreads();
        const int n = tid & 127, kg = tid >> 7;
        float acc[RPT];
#pragma unroll
        for (int i = 0; i < RPT; ++i) acc[i] = 0.f;
        for (int c = 0; c < 128; c += 4) {
            const float b0 = Bs[(c + 0) * 129 + n], b1 = Bs[(c + 1) * 129 + n], b2 = Bs[(c + 2) * 129 + n], b3 = Bs[(c + 3) * 129 + n];
#pragma unroll
            for (int i = 0; i < RPT; ++i) { const f32x4 a = *(const LAS f32x4*)(As + (kg * RPT + i) * 128 + c); acc[i] += a[0] * b0 + a[1] * b1 + a[2] * b2 + a[3] * b3; }
        }
        const float cs = POOL ? P.in[I_POOLS][blk * 128 + n] : 1.0f; const float* gain = POOL ? P.in[I_LNMIX] : P.in[I_LNFFN];
        bf16_t* dst = (POOL ? WinT : WsT) + (size_t)(blk * 128 + n) * 1024 + k0 + kg * RPT;
        float v[RPT];
#pragma unroll
        for (int i = 0; i < RPT; ++i) v[i] = acc[i] * cs * gain[k0 + kg * RPT + i];
#pragma unroll
        for (int i = 0; i < RPT; i += 4) *(u32x2*)(dst + i) = (u32x2){cvtpk(v[i], v[i + 1]), cvtpk(v[i + 2], v[i + 3])};
        __syncthreads();
    }
}

__device__ __forceinline__ void phase_prep(const Ctx& C) {
    const Params& P = *C.p; unsigned char* ws = P.ws; const int tid = C.tid, lane = C.lane;
    bf16_t* WinT = (bf16_t*)(ws + WS_WIN); bf16_t* WoT = (bf16_t*)(ws + WS_WO); bf16_t* WsT = (bf16_t*)(ws + WS_WS); bf16_t* WgT = (bf16_t*)(ws + WS_WG); bf16_t* WpT = (bf16_t*)(ws + WS_WP);
    fold_items<16, true>(C);
    {
        LAS float* scr = (LAS float*)(C.lds + C.wave * 8448);
        const int gw = C.vcu * 8 + C.wave, NGW = C.G * 8;
        constexpr int I1 = 16 * 48, I2 = 16 * 32, I3 = 16 * 32, I4 = 4 * 32;
        for (int it = gw; it < I1 + I2 + I3 + I4; it += NGW) {
            int r = it;
            if (r < I1) { transpose_item(P.in[I_WIN], 2048, 512, P.in[I_LNMIX], WinT, 1024, 512, 48, scr, r, lane); continue; } r -= I1;
            if (r < I2) { transpose_item(P.in[I_WO], 1024, 0, nullptr, WoT, 1024, 0, 32, scr, r, lane); continue; } r -= I2;
            if (r < I3) { transpose_item(P.in[I_WG], 1024, 0, P.in[I_LNPE], WgT, 1024, 0, 32, scr, r, lane); continue; } r -= I3;
            transpose_item(P.in[I_WPP], 1024, 0, nullptr, WpT, 256, 0, 32, scr, r, lane);
        }
        bf16_t* XB = (bf16_t*)(ws + WS_ACTB);
        for (int m0 = gw; m0 < M_TOK; m0 += 4 * NGW) {
            f32x4 v[4][4]; float s[4];
#pragma unroll
            for (int q = 0; q < 4; ++q) { const int m = m0 + q * NGW; const f32x4* xr = (const f32x4*)(P.in[I_X] + (size_t)(m < M_TOK ? m : m0) * DM) + lane;
#pragma unroll
                for (int j = 0; j < 4; ++j) v[q][j] = xr[64 * j]; }
#pragma unroll
            for (int q = 0; q < 4; ++q) { s[q] = 0.f;
#pragma unroll
                for (int j = 0; j < 4; ++j) s[q] += (v[q][j][0] * v[q][j][0] + v[q][j][1] * v[q][j][1]) + (v[q][j][2] * v[q][j][2] + v[q][j][3] * v[q][j][3]); }
#pragma unroll
            for (int q = 0; q < 4; ++q) { const int m = m0 + q * NGW; if (m >= M_TOK) break;
                const float ri = rsqrtf(wave_sum(s[q]) * (1.0f / DM) + EPS);
                u32x2* o = (u32x2*)(XB + (size_t)m * DM) + lane;
#pragma unroll
                for (int j = 0; j < 4; ++j) { u32x2 w; w.x = cvtpk(v[q][j][0] * ri, v[q][j][1] * ri); w.y = cvtpk(v[q][j][2] * ri, v[q][j][3] * ri); o[64 * j] = w; } }
        }
    }
    {
        const size_t gt = (size_t)C.vcu * 512 + tid, NT = (size_t)C.G * 512;
        { const float* s = P.in[I_P]; bf16_t* d = (bf16_t*)(ws + WS_PB); const size_t n = (size_t)M_TOK * DPLE / 8;
          for (size_t i0 = gt; i0 < n; i0 += 4 * NT) { f32x4 v0[4], v1[4];
#pragma unroll
              for (int q = 0; q < 4; ++q) { const size_t i = i0 + q * NT < n ? i0 + q * NT : i0; v0[q] = *(const f32x4*)(s + i * 8); v1[q] = *(const f32x4*)(s + i * 8 + 4); }
#pragma unroll
              for (int q = 0; q < 4; ++q) { const size_t i = i0 + q * NT; if (i >= n) break;
                  u32x4 w; w.x = cvtpk(v0[q][0], v0[q][1]); w.y = cvtpk(v0[q][2], v0[q][3]); w.z = cvtpk(v1[q][0], v1[q][1]); w.w = cvtpk(v1[q][2], v1[q][3]); *(u32x4*)(d + i * 8) = w; } } }
        { const float* s = P.in[I_PV]; unsigned char* d = ws + WS_UT; const size_t n = (size_t)16384 * 1024 / 16;
          for (size_t i0 = gt; i0 < n; i0 += 2 * NT) { f32x4 v[2][4];
#pragma unroll
              for (int q = 0; q < 2; ++q) { const size_t i = i0 + q * NT < n ? i0 + q * NT : i0;
#pragma unroll
                  for (int c = 0; c < 4; ++c) v[q][c] = *(const f32x4*)(s + i * 16 + 4 * c) * V4SCALE; }
#pragma unroll
              for (int q = 0; q < 2; ++q) { const size_t i = i0 + q * NT; if (i >= n) break; u32x2 o;
#pragma unroll
                  for (int c = 0; c < 2; ++c) { unsigned w = 0;
                      w = __builtin_amdgcn_cvt_scalef32_pk_fp4_f32(w, v[q][2 * c][0], v[q][2 * c][1], 1.0f, 0); w = __builtin_amdgcn_cvt_scalef32_pk_fp4_f32(w, v[q][2 * c][2], v[q][2 * c][3], 1.0f, 1);
                      w = __builtin_amdgcn_cvt_scalef32_pk_fp4_f32(w, v[q][2 * c + 1][0], v[q][2 * c + 1][1], 1.0f, 2); w = __builtin_amdgcn_cvt_scalef32_pk_fp4_f32(w, v[q][2 * c + 1][2], v[q][2 * c + 1][3], 1.0f, 3); o[c] = w; }
                  *(u32x2*)(d + (i >> 6) * 1024 + 512 + (i & 63) * 8) = o; } } }
        { const int* pos = (const int*)P.in[I_POS]; unsigned* cst = (unsigned*)(ws + WS_CST);
          for (size_t i = gt; i < (size_t)M_TOK * 4; i += NT) { const int m = (int)(i >> 2), a = (int)(i & 3); const float fp = (float)pos[m]; unsigned w[8];
#pragma unroll
              for (int t = 0; t < 8; ++t) { const float invf = exp2f(-(float)(2 * (8 * a + t)) * (13.287712379549449f / 64.0f)); float tr = fp * invf * 0.15915494309189535f; tr = tr - floorf(tr);
                  const pg8::hf2 cs = {(_Float16)__builtin_amdgcn_cosf(tr), (_Float16)__builtin_amdgcn_sinf(tr)}; w[t] = __builtin_bit_cast(unsigned, cs); }
              *(u32x4*)(cst + i * 8) = (u32x4){w[0], w[1], w[2], w[3]}; *(u32x4*)(cst + i * 8 + 4) = (u32x4){w[4], w[5], w[6], w[7]}; } }
        { const float* s = P.in[I_PU]; unsigned char* d = ws + WS_UT; const size_t n = (size_t)16384 * 1024 / 16; const float* gn = P.in[I_LNFFN];
          for (size_t i0 = gt; i0 < n; i0 += 2 * NT) { f32x4 v[2][4];
#pragma unroll
              for (int q = 0; q < 2; ++q) { const size_t i = i0 + q * NT < n ? i0 + q * NT : i0;
#pragma unroll
                  for (int c = 0; c < 4; ++c) v[q][c] = *(const f32x4*)(s + i * 16 + 4 * c) * *(const f32x4*)(gn + (i & 63) * 16 + 4 * c) * U4SCALE; }
#pragma unroll
              for (int q = 0; q < 2; ++q) { const size_t i = i0 + q * NT; if (i >= n) break; u32x2 o;
#pragma unroll
                  for (int c = 0; c < 2; ++c) { unsigned w = 0;
                      w = __builtin_amdgcn_cvt_scalef32_pk_fp4_f32(w, v[q][2 * c][0], v[q][2 * c][1], 1.0f, 0); w = __builtin_amdgcn_cvt_scalef32_pk_fp4_f32(w, v[q][2 * c][2], v[q][2 * c][3], 1.0f, 1);
                      w = __builtin_amdgcn_cvt_scalef32_pk_fp4_f32(w, v[q][2 * c + 1][0], v[q][2 * c + 1][1], 1.0f, 2); w = __builtin_amdgcn_cvt_scalef32_pk_fp4_f32(w, v[q][2 * c + 1][2], v[q][2 * c + 1][3], 1.0f, 3); o[c] = w; }
                  *(u32x2*)(d + (i >> 6) * 1024 + (i & 63) * 8) = o; } } }
    }
}

__device__ __forceinline__ void phase_rope_pool(const Ctx& C) {
    fold_items<64, false>(C);
    const Params& P = *C.p; unsigned char* ws = P.ws; const int lane = C.lane;
    bf16_t* Z = (bf16_t*)(ws + WS_Z); bf16_t* Y = (bf16_t*)(ws + WS_YCAT);
    const int gw = C.vcu * 8 + C.wave, NGW = C.G * 8;
    constexpr int RP_ROWS = 16;
    const int w = 2 << (lane >> 4);
    for (int mb = gw * RP_ROWS; mb < M_TOK; mb += NGW * RP_ROWS) {
        const int s0 = mb & (SEQ - 1);
        const bf16_t* zp0 = Z + (size_t)mb * ZLD + 8 * lane;
        float acc[8];
#pragma unroll
        for (int i = 0; i < 8; ++i) acc[i] = 0.f;
        { u32x4 pv[15];
#pragma unroll
          for (int i = 1; i < 16; ++i) pv[i - 1] = (i < w && s0 - i >= 0) ? *(const u32x4*)(zp0 - (size_t)i * ZLD) : (u32x4){0u, 0u, 0u, 0u};
#pragma unroll
          for (int i = 0; i < 15; ++i) { acc[0] += bflo(pv[i].x); acc[1] += bfhi(pv[i].x); acc[2] += bflo(pv[i].y); acc[3] += bfhi(pv[i].y); acc[4] += bflo(pv[i].z); acc[5] += bfhi(pv[i].z); acc[6] += bflo(pv[i].w); acc[7] += bfhi(pv[i].w); } }
#pragma unroll 1
        for (int r4 = 0; r4 < RP_ROWS; r4 += 4) {
            u32x4 cv[4], ov[4];
#pragma unroll
            for (int q = 0; q < 4; ++q) { const int r = r4 + q; cv[q] = *(const u32x4*)(zp0 + (size_t)r * ZLD);
                ov[q] = (s0 + r - w + 1 >= 0) ? *(const u32x4*)(zp0 + ((long)r - w + 1) * ZLD) : (u32x4){0u, 0u, 0u, 0u}; }
#pragma unroll
            for (int q = 0; q < 4; ++q) { const int r = r4 + q, s = s0 + r;
                const float c[8] = {bflo(cv[q].x), bfhi(cv[q].x), bflo(cv[q].y), bfhi(cv[q].y), bflo(cv[q].z), bfhi(cv[q].z), bflo(cv[q].w), bfhi(cv[q].w)};
                const float od[8] = {bflo(ov[q].x), bfhi(ov[q].x), bflo(ov[q].y), bfhi(ov[q].y), bflo(ov[q].z), bfhi(ov[q].z), bflo(ov[q].w), bfhi(ov[q].w)};
                const float rc = 1.0f / (float)((s + 1) < w ? (s + 1) : w);
                float ov8[8];
#pragma unroll
                for (int i = 0; i < 8; ++i) { acc[i] += c[i]; ov8[i] = acc[i] * rc - c[i]; acc[i] -= od[i]; }
                u32x4 o; o.x = cvtpk(ov8[0], ov8[1]); o.y = cvtpk(ov8[2], ov8[3]); o.z = cvtpk(ov8[4], ov8[5]); o.w = cvtpk(ov8[6], ov8[7]);
                *(u32x4*)(Y + (size_t)(mb + r) * DM + 8 * lane) = o; }
        }
    }
}

namespace att {
constexpr int SLOT = 32768, KB = 8192;
typedef short v4i16_t __attribute__((ext_vector_type(4)));
__device__ __forceinline__ int crow(int r, int hi) { return (r & 3) + 8 * (r >> 2) + 4 * hi; }
__device__ __forceinline__ s16x4 vtr(const LAS unsigned char* p) { return __builtin_bit_cast(s16x4, __builtin_amdgcn_ds_read_tr16_b64_v4i16((LAS v4i16_t*)p)); }
__device__ __forceinline__ void glds16(const void* gsrc, unsigned lds_dst) { unsigned keep;
    asm volatile("s_mov_b32 %0, m0\n\ts_mov_b32 m0, %2\n\ts_nop 0\n\tglobal_load_lds_dwordx4 %1, off\n\ts_mov_b32 m0, %0" : "=&s"(keep) : "v"(gsrc), "s"(lds_dst) : "memory"); }
__device__ __forceinline__ float swapadd(float v) { auto rr = __builtin_amdgcn_permlane32_swap(__float_as_uint(v), __float_as_uint(v), false, false); return __uint_as_float(rr[0]) + __uint_as_float(rr[1]); }
__device__ __forceinline__ float swapmax(float v) { auto rr = __builtin_amdgcn_permlane32_swap(__float_as_uint(v), __float_as_uint(v), false, false); return fmaxf(__uint_as_float(rr[0]), __uint_as_float(rr[1])); }

template <bool BOUNDED> __device__ __forceinline__ void attn_unit(int b, int h, int qb, const bf16_t* Z, bf16_t* Y, const float* subln, float lam, LAS unsigned char* lds) {
    const int tid = threadIdx.x, lane = tid & 63, r32 = lane & 31, hi = lane >> 5; const int wid = __builtin_amdgcn_readfirstlane(tid >> 6);
    const int m = wid >> 2, wq = wid & 3;
    const size_t rowbase = (size_t)b * SEQ; const int q0 = qb * 128, NT = 2 * qb + 2;
    const int qabs = q0 + wq * 32 + r32;
    bf16x8 qr[4];
    { const bf16_t* Qw = Z + (rowbase + qabs) * ZLD + 512 + h * 128 + m * 64;
#pragma unroll
      for (int d0 = 0; d0 < 4; ++d0) qr[d0] = *(const bf16x8*)(Qw + d0 * 16 + hi * 8); }
    const bf16_t* Zbh = Z + rowbase * ZLD + h * 128;
    unsigned kog[2], vog[2];
#pragma unroll
    for (int j = 0; j < 2; ++j) { const unsigned r = 8u * wid + 4u * j + (lane >> 4), cp = lane & 15;
        kog[j] = r * ZLD + 1024u + 8u * (cp ^ (r & 15u)); vog[j] = r * ZLD + 1536u + 8u * (cp ^ (((r & 3u) << 2) | ((r >> 2) & 3u))); }
    const unsigned wbase = (unsigned)wid * 2048u;
    const unsigned lds0 = (unsigned)(uintptr_t)lds;
#define ATT_DMA(t, slot) do { const bf16_t* zt_ = Zbh + (size_t)(t) * 64 * ZLD; const unsigned d_ = (unsigned)__builtin_amdgcn_readfirstlane(lds0 + (slot) + wbase); \
        glds16(zt_ + kog[0], d_); glds16(zt_ + kog[1], d_ + 1024); glds16(zt_ + vog[0], d_ + 2 * KB); glds16(zt_ + vog[1], d_ + 2 * KB + 1024); } while (0)
    f32x16 o[4];
#pragma unroll
    for (int d = 0; d < 4; ++d)
#pragma unroll
        for (int r = 0; r < 16; ++r) o[d][r] = 0.f;
    float mref = -1e30f, lsum = 0.f;
    int koffs[4], voffs[4][2];
#pragma unroll
    for (int d0 = 0; d0 < 4; ++d0) koffs[d0] = r32 * 256 + (((m * 8 + 2 * d0 + hi) ^ (r32 & 15)) * 16);
    { const int L2 = (lane >> 2) & 3, a = (lane >> 4) & 1, bb = (lane & 3) >> 1;
#pragma unroll
      for (int d = 0; d < 4; ++d)
#pragma unroll
          for (int h2 = 0; h2 < 2; ++h2) voffs[d][h2] = 2 * KB + 256 * (8 * h2 + 4 * hi + L2) + 16 * ((((d ^ L2) & 3) << 2) | (((2 * a + bb) ^ (2 * h2 + hi)) & 3)) + 8 * (lane & 1); }
    ATT_DMA(0, 0); ATT_DMA(1, SLOT);
    asm volatile("s_waitcnt vmcnt(4)" ::: "memory");
    __syncthreads();
    int slot = 0, slot2 = 2 * SLOT;
    for (int t = 0; t < NT; ++t) {
        if (t + 2 < NT) ATT_DMA(t + 2, slot2);
        const bool band = t >= NT - 2;
        bf16x8 kf[8];
        { const LAS unsigned char* kb = lds + slot;
#pragma unroll
          for (int d0 = 0; d0 < 4; ++d0) { kf[2 * d0] = *(const LAS bf16x8*)(kb + koffs[d0]); kf[2 * d0 + 1] = *(const LAS bf16x8*)(kb + koffs[d0] + 8192); } }
        __builtin_amdgcn_sched_barrier(0);
        f32x16 p0, p1;
#pragma unroll
        for (int r = 0; r < 16; ++r) { p0[r] = 0.f; p1[r] = 0.f; }
#pragma unroll
        for (int d0 = 0; d0 < 4; ++d0) { p0 = __builtin_amdgcn_mfma_f32_32x32x16_bf16(kf[2 * d0], qr[d0], p0, 0, 0, 0); p1 = __builtin_amdgcn_mfma_f32_32x32x16_bf16(kf[2 * d0 + 1], qr[d0], p1, 0, 0, 0); }
        const LAS unsigned char* vb = lds + slot;
        s16x4 loA[8], hhA[8], loB[8], hhB[8];
#pragma unroll
        for (int i = 0; i < 8; ++i) { const int d = (i >> 2), ks = i & 3; loA[i] = vtr(vb + voffs[d][0] + ks * 4096); hhA[i] = vtr(vb + voffs[d][1] + ks * 4096); }
        __builtin_amdgcn_sched_barrier(0);
        if (band) {
            const int kb0 = 64 * t + 4 * hi;
#pragma unroll
            for (int r = 0; r < 16; ++r) { const int kv = kb0 + (r & 3) + 8 * (r >> 2); if (kv > qabs) p0[r] = -INFINITY; if (kv + 32 > qabs) p1[r] = -INFINITY; }
        }
        float ls = 0.f;
        if constexpr (BOUNDED) {
#pragma unroll
            for (int r = 0; r < 16; ++r) { p0[r] = __builtin_amdgcn_exp2f(p0[r]); p1[r] = __builtin_amdgcn_exp2f(p1[r]); ls += p0[r] + p1[r]; }
        } else {
            float rm = fmaxf(p0[0], p1[0]);
#pragma unroll
            for (int r = 1; r < 16; ++r) rm = fmaxf(rm, fmaxf(p0[r], p1[r]));
            rm = swapmax(rm);
            if (__any(rm - mref > 8.0f)) {
                const float mn = fmaxf(mref, rm), al = exp2f(mref - mn);
                mref = mn; lsum *= al;
#pragma unroll
                for (int d = 0; d < 4; ++d)
#pragma unroll
                    for (int r = 0; r < 16; ++r) o[d][r] *= al;
            }
#pragma unroll
            for (int r = 0; r < 16; ++r) { p0[r] = __builtin_amdgcn_exp2f(p0[r] - mref); p1[r] = __builtin_amdgcn_exp2f(p1[r] - mref); ls += p0[r] + p1[r]; }
        }
        lsum += ls;
        u32x4 pw[4];
        pw[0] = (u32x4){cvtpk(p0[0], p0[1]), cvtpk(p0[2], p0[3]), cvtpk(p0[4], p0[5]), cvtpk(p0[6], p0[7])};
        pw[1] = (u32x4){cvtpk(p0[8], p0[9]), cvtpk(p0[10], p0[11]), cvtpk(p0[12], p0[13]), cvtpk(p0[14], p0[15])};
        pw[2] = (u32x4){cvtpk(p1[0], p1[1]), cvtpk(p1[2], p1[3]), cvtpk(p1[4], p1[5]), cvtpk(p1[6], p1[7])};
        pw[3] = (u32x4){cvtpk(p1[8], p1[9]), cvtpk(p1[10], p1[11]), cvtpk(p1[12], p1[13]), cvtpk(p1[14], p1[15])};
        __builtin_amdgcn_sched_barrier(0);
#pragma unroll
        for (int i = 0; i < 8; ++i) { const int d = 2 + (i >> 2), ks = i & 3; loB[i] = vtr(vb + voffs[d][0] + ks * 4096); hhB[i] = vtr(vb + voffs[d][1] + ks * 4096); }
        __builtin_amdgcn_sched_barrier(0);
#pragma unroll
        for (int i = 0; i < 8; ++i) { const int d = (i >> 2), ks = i & 3;
            const bf16x8 vf = {loA[i][0], loA[i][1], loA[i][2], loA[i][3], hhA[i][0], hhA[i][1], hhA[i][2], hhA[i][3]};
            o[d] = __builtin_amdgcn_mfma_f32_32x32x16_bf16(vf, __builtin_bit_cast(bf16x8, pw[ks]), o[d], 0, 0, 0); }
#pragma unroll
        for (int i = 0; i < 8; ++i) { const int d = 2 + (i >> 2), ks = i & 3;
            const bf16x8 vf = {loB[i][0], loB[i][1], loB[i][2], loB[i][3], hhB[i][0], hhB[i][1], hhB[i][2], hhB[i][3]};
            o[d] = __builtin_amdgcn_mfma_f32_32x32x16_bf16(vf, __builtin_bit_cast(bf16x8, pw[ks]), o[d], 0, 0, 0); }
        if (t + 2 < NT) asm volatile("s_waitcnt vmcnt(4)" ::: "memory"); else asm volatile("s_waitcnt vmcnt(0)" ::: "memory");
        __syncthreads();
        slot2 = slot; slot = (slot == 2 * SLOT) ? 0 : slot + SLOT;
    }
#undef ATT_DMA
    const float inv = 1.0f / swapadd(lsum);
    LAS float* xch = (LAS float*)(lds + wq * 16384);
    if (m == 1) {
        const float sc = inv * lam;
#pragma unroll
        for (int d = 0; d < 4; ++d)
#pragma unroll
            for (int r = 0; r < 16; ++r) xch[(d * 16 + r) * 64 + lane] = o[d][r] * sc;
    }
    __syncthreads();
    if (m == 0) {
        float ss = 0.f;
#pragma unroll
        for (int d = 0; d < 4; ++d)
#pragma unroll
            for (int r = 0; r < 16; ++r) { const float v = o[d][r] * inv - xch[(d * 16 + r) * 64 + lane]; o[d][r] = v; ss += v * v; }
        ss = swapadd(ss);
        const float rn = rsqrtf(ss * (1.0f / 128.0f) + EPS) * 0.8f;
        bf16_t* yp = Y + (rowbase + qabs) * DM + 512 + h * 128;
#pragma unroll
        for (int d = 0; d < 4; ++d)
#pragma unroll
            for (int rq = 0; rq < 4; ++rq) { const int dc = 32 * d + 8 * rq + 4 * hi; const f32x4 g = *(const f32x4*)(subln + dc);
                u32x2 w; w.x = cvtpk(o[d][4 * rq] * rn * g[0], o[d][4 * rq + 1] * rn * g[1]); w.y = cvtpk(o[d][4 * rq + 2] * rn * g[2], o[d][4 * rq + 3] * rn * g[3]);
                *(u32x2*)(yp + dc) = w; }
    }
    __syncthreads();
}

__device__ __forceinline__ void attn_unit_pipe(int b, int h, int qb, const bf16_t* Z, bf16_t* Y, const float* subln, float lam, LAS unsigned char* lds) {
    int tid = threadIdx.x; asm volatile("" : "+v"(tid));
    const int lane = tid & 63, r32 = lane & 31, hi = lane >> 5; const int wid = __builtin_amdgcn_readfirstlane(tid >> 6);
    const int m = wid >> 2, wq = wid & 3;
    const size_t rowbase = (size_t)b * SEQ; const int q0 = qb * 128, NT = 2 * qb + 2;
    const int qabs = q0 + wq * 32 + r32;
    bf16x8 qr[4];
    { const bf16_t* Qw = Z + (rowbase + qabs) * ZLD + 512 + h * 128 + m * 64;
#pragma unroll
      for (int d0 = 0; d0 < 4; ++d0) qr[d0] = *(const bf16x8*)(Qw + d0 * 16 + hi * 8); }
    const bf16_t* Zbh = Z + rowbase * ZLD + h * 128;
    unsigned kog[2], vog[2];
#pragma unroll
    for (int j = 0; j < 2; ++j) { const unsigned r = 8u * wid + 4u * j + (lane >> 4), cp = lane & 15;
        kog[j] = r * ZLD + 1024u + 8u * (cp ^ (r & 15u)); vog[j] = r * ZLD + 1536u + 8u * (cp ^ (((r & 3u) << 2) | ((r >> 2) & 3u))); }
    const unsigned wbase = (unsigned)wid * 2048u;
    const unsigned lds0 = (unsigned)(uintptr_t)lds;
#define ATP_DMA(t) do { const bf16_t* zt_ = Zbh + (size_t)(t) * 64 * ZLD; const unsigned d_ = (unsigned)__builtin_amdgcn_readfirstlane(lds0 + ((t) & 3) * SLOT + wbase); \
        glds16(zt_ + kog[0], d_); glds16(zt_ + kog[1], d_ + 1024); glds16(zt_ + vog[0], d_ + 2 * KB); glds16(zt_ + vog[1], d_ + 2 * KB + 1024); } while (0)
    f32x16 o[4];
#pragma unroll
    for (int d = 0; d < 4; ++d)
#pragma unroll
        for (int r = 0; r < 16; ++r) o[d][r] = 0.f;
    float lsum = 0.f;
    const int kbase = r32 * 256 + (((m * 8 + hi) ^ (r32 & 15)) * 16);
    int vbase[2];
    { const int L2 = (lane >> 2) & 3, a = (lane >> 4) & 1, bb = (lane & 3) >> 1;
#pragma unroll
      for (int h2 = 0; h2 < 2; ++h2) vbase[h2] = 2 * KB + 256 * (8 * h2 + 4 * hi + L2) + 16 * ((L2 << 2) | (((2 * a + bb) ^ (2 * h2 + hi)) & 3)) + 8 * (lane & 1); }
#define ATP_PIN(x) asm volatile("" : "+v"(x))
#define ATP_SB() __builtin_amdgcn_sched_barrier(0)
#define ATP_MASK(C0, C1, t) do { if ((t) >= NT - 2) { const int kb0_ = 64 * (t) + 4 * hi; \
        _Pragma("unroll") for (int r = 0; r < 16; ++r) { const int kv = kb0_ + (r & 3) + 8 * (r >> 2); if (kv > qabs) C0[r] = -INFINITY; if (kv + 32 > qabs) C1[r] = -INFINITY; } } } while (0)
#define ATP_KLOAD(t) do { const LAS unsigned char* kb_ = lds + ((t) & 3) * SLOT; \
        _Pragma("unroll") for (int d0 = 0; d0 < 4; ++d0) { kf[2 * d0] = *(const LAS bf16x8*)(kb_ + (kbase ^ (32 * d0))); kf[2 * d0 + 1] = *(const LAS bf16x8*)(kb_ + (kbase ^ (32 * d0)) + 8192); } } while (0)
#define ATP_VLOAD(vf, vb, d) do { _Pragma("unroll") for (int ks = 0; ks < 4; ++ks) { const s16x4 lo_ = vtr((vb) + (vbase[0] ^ (64 * (d))) + ks * 4096), hh_ = vtr((vb) + (vbase[1] ^ (64 * (d))) + ks * 4096); \
        vf[ks] = (bf16x8){lo_[0], lo_[1], lo_[2], lo_[3], hh_[0], hh_[1], hh_[2], hh_[3]}; } } while (0)
#define ATP_WAIT(t) do { if ((t) + 2 < NT) asm volatile("s_waitcnt vmcnt(4)" ::: "memory"); else asm volatile("s_waitcnt vmcnt(0)" ::: "memory"); __syncthreads(); } while (0)
    bf16x8 kf[8], vfA[4], vfB[4]; u32x4 pw[4];
    f32x16 pA0, pA1, pB0, pB1;
    ATP_DMA(0); ATP_DMA(1);
    asm volatile("s_waitcnt vmcnt(4)" ::: "memory");
    __syncthreads();
    if (2 < NT) ATP_DMA(2);
    ATP_KLOAD(0); ATP_SB();
#pragma unroll
    for (int r = 0; r < 16; ++r) { pA0[r] = 0.f; pA1[r] = 0.f; }
#pragma unroll
    for (int d0 = 0; d0 < 4; ++d0) { pA0 = __builtin_amdgcn_mfma_f32_32x32x16_bf16(kf[2 * d0], qr[d0], pA0, 0, 0, 0); pA1 = __builtin_amdgcn_mfma_f32_32x32x16_bf16(kf[2 * d0 + 1], qr[d0], pA1, 0, 0, 0); }
    ATP_MASK(pA0, pA1, 0);
#pragma unroll
    for (int r = 0; r < 16; ++r) { pA0[r] = __builtin_amdgcn_exp2f(pA0[r]); pA1[r] = __builtin_amdgcn_exp2f(pA1[r]); }
    ATP_WAIT(0);
#define ATP_GAPA(i, C0, C1, P0, P1) do { \
        if ((i) & 1) { C1 = __builtin_amdgcn_mfma_f32_32x32x16_bf16(kf[i], qr[(i) >> 1], C1, 0, 0, 0); ATP_PIN(C1); } else { C0 = __builtin_amdgcn_mfma_f32_32x32x16_bf16(kf[i], qr[(i) >> 1], C0, 0, 0, 0); ATP_PIN(C0); } \
        if ((i) < 4) { sacc += (P0[4 * (i)] + P0[4 * (i) + 1]) + (P0[4 * (i) + 2] + P0[4 * (i) + 3]); pw[(i) >> 1][2 * ((i) & 1)] = cvtpk(P0[4 * (i)], P0[4 * (i) + 1]); pw[(i) >> 1][2 * ((i) & 1) + 1] = cvtpk(P0[4 * (i) + 2], P0[4 * (i) + 3]); } \
        else { sacc += (P1[4 * ((i) - 4)] + P1[4 * ((i) - 4) + 1]) + (P1[4 * ((i) - 4) + 2] + P1[4 * ((i) - 4) + 3]); pw[(i) >> 1][2 * ((i) & 1)] = cvtpk(P1[4 * ((i) - 4)], P1[4 * ((i) - 4) + 1]); pw[(i) >> 1][2 * ((i) & 1) + 1] = cvtpk(P1[4 * ((i) - 4) + 2], P1[4 * ((i) - 4) + 3]); } \
        ATP_PIN(sacc); ATP_PIN(pw[(i) >> 1]); ATP_SB(); } while (0)
#define ATP_GAPB(vf, d, ks, X, e0) do { o[d] = __builtin_amdgcn_mfma_f32_32x32x16_bf16(vf[ks], __builtin_bit_cast(bf16x8, pw[ks]), o[d], 0, 0, 0); \
        X[e0] = __builtin_amdgcn_exp2f(X[e0]); X[(e0) + 1] = __builtin_amdgcn_exp2f(X[(e0) + 1]); ATP_PIN(X); ATP_SB(); } while (0)
#define ATP_STEP(C0, C1, P0, P1, t) do { \
        if ((t) + 2 < NT) ATP_DMA((t) + 2); \
        ATP_KLOAD(t); ATP_SB(); \
        const LAS unsigned char* vb_ = lds + (((t) - 1) & 3) * SLOT; \
        _Pragma("unroll") for (int r = 0; r < 16; ++r) { C0[r] = 0.f; C1[r] = 0.f; } \
        float sacc = 0.f; \
        ATP_GAPA(0, C0, C1, P0, P1); ATP_GAPA(1, C0, C1, P0, P1); ATP_GAPA(2, C0, C1, P0, P1); ATP_GAPA(3, C0, C1, P0, P1); \
        ATP_GAPA(4, C0, C1, P0, P1); ATP_GAPA(5, C0, C1, P0, P1); ATP_GAPA(6, C0, C1, P0, P1); ATP_GAPA(7, C0, C1, P0, P1); \
        lsum += sacc; \
        ATP_VLOAD(vfA, vb_, 0); ATP_VLOAD(vfB, vb_, 1); ATP_SB(); \
        ATP_MASK(C0, C1, t); ATP_SB(); \
        ATP_GAPB(vfA, 0, 0, C0, 0); ATP_GAPB(vfA, 0, 1, C0, 2); ATP_GAPB(vfA, 0, 2, C0, 4); ATP_GAPB(vfA, 0, 3, C0, 6); \
        ATP_VLOAD(vfA, vb_, 2); ATP_SB(); \
        ATP_GAPB(vfB, 1, 0, C0, 8); ATP_GAPB(vfB, 1, 1, C0, 10); ATP_GAPB(vfB, 1, 2, C0, 12); ATP_GAPB(vfB, 1, 3, C0, 14); \
        ATP_VLOAD(vfB, vb_, 3); ATP_SB(); \
        ATP_GAPB(vfA, 2, 0, C1, 0); ATP_GAPB(vfA, 2, 1, C1, 2); ATP_GAPB(vfA, 2, 2, C1, 4); ATP_GAPB(vfA, 2, 3, C1, 6); \
        ATP_GAPB(vfB, 3, 0, C1, 8); ATP_GAPB(vfB, 3, 1, C1, 10); ATP_GAPB(vfB, 3, 2, C1, 12); ATP_GAPB(vfB, 3, 3, C1, 14); \
        ATP_WAIT(t); } while (0)
    int t = 1;
    for (; t + 1 < NT; t += 2) { ATP_STEP(pB0, pB1, pA0, pA1, t); ATP_STEP(pA0, pA1, pB0, pB1, t + 1); }
    ATP_STEP(pB0, pB1, pA0, pA1, t);
    { float sacc = 0.f;
#pragma unroll
      for (int r = 0; r < 16; ++r) sacc += pB0[r] + pB1[r];
      lsum += sacc;
      pw[0] = (u32x4){cvtpk(pB0[0], pB0[1]), cvtpk(pB0[2], pB0[3]), cvtpk(pB0[4], pB0[5]), cvtpk(pB0[6], pB0[7])};
      pw[1] = (u32x4){cvtpk(pB0[8], pB0[9]), cvtpk(pB0[10], pB0[11]), cvtpk(pB0[12], pB0[13]), cvtpk(pB0[14], pB0[15])};
      pw[2] = (u32x4){cvtpk(pB1[0], pB1[1]), cvtpk(pB1[2], pB1[3]), cvtpk(pB1[4], pB1[5]), cvtpk(pB1[6], pB1[7])};
      pw[3] = (u32x4){cvtpk(pB1[8], pB1[9]), cvtpk(pB1[10], pB1[11]), cvtpk(pB1[12], pB1[13]), cvtpk(pB1[14], pB1[15])};
      const LAS unsigned char* vb_ = lds + ((NT - 1) & 3) * SLOT;
#pragma unroll
      for (int d = 0; d < 4; ++d) { ATP_VLOAD(vfA, vb_, d);
#pragma unroll
          for (int ks = 0; ks < 4; ++ks) o[d] = __builtin_amdgcn_mfma_f32_32x32x16_bf16(vfA[ks], __builtin_bit_cast(bf16x8, pw[ks]), o[d], 0, 0, 0); } }
    __syncthreads();
#undef ATP_DMA
#undef ATP_PIN
#undef ATP_SB
#undef ATP_MASK
#undef ATP_KLOAD
#undef ATP_VLOAD
#undef ATP_WAIT
#undef ATP_GAPA
#undef ATP_GAPB
#undef ATP_STEP
    const float inv = 1.0f / swapadd(lsum);
    LAS float* xch = (LAS float*)(lds + wq * 16384);
    if (m == 1) {
        const float sc = inv * lam;
#pragma unroll
        for (int d = 0; d < 4; ++d)
#pragma unroll
            for (int r = 0; r < 16; ++r) xch[(d * 16 + r) * 64 + lane] = o[d][r] * sc;
    }
    __syncthreads();
    if (m == 0) {
        float ss = 0.f;
#pragma unroll
        for (int d = 0; d < 4; ++d)
#pragma unroll
            for (int r = 0; r < 16; ++r) { const float v = o[d][r] * inv - xch[(d * 16 + r) * 64 + lane]; o[d][r] = v; ss += v * v; }
        ss = swapadd(ss);
        const float rn = rsqrtf(ss * (1.0f / 128.0f) + EPS) * 0.8f;
        bf16_t* yp = Y + (rowbase + qabs) * DM + 512 + h * 128;
#pragma unroll
        for (int d = 0; d < 4; ++d)
#pragma unroll
            for (int rq = 0; rq < 4; ++rq) { const int dc = 32 * d + 8 * rq + 4 * hi; const f32x4 g = *(const f32x4*)(subln + dc);
                u32x2 w; w.x = cvtpk(o[d][4 * rq] * rn * g[0], o[d][4 * rq + 1] * rn * g[1]); w.y = cvtpk(o[d][4 * rq + 2] * rn * g[2], o[d][4 * rq + 3] * rn * g[3]);
                *(u32x2*)(yp + dc) = w; }
    }
    __syncthreads();
}
}

__device__ __forceinline__ void phase_attn(const Ctx& C) {
    const Params& P = *C.p; unsigned char* ws = P.ws;
    const bf16_t* Z = (const bf16_t*)(ws + WS_Z); bf16_t* Y = (bf16_t*)(ws + WS_YCAT);
    const float d1 = wave_sum(P.in[I_LQ1][C.lane] * P.in[I_LK1][C.lane]), d2 = wave_sum(P.in[I_LQ2][C.lane] * P.in[I_LK2][C.lane]);
    const float lam = expf(d1) - expf(d2) + 0.2f;
    float gq = fabsf(P.in[I_QN][C.lane]), gk = fabsf(P.in[I_KN][C.lane]);
#pragma unroll
    for (int o = 1; o < 64; o <<= 1) { gq = fmaxf(gq, __shfl_xor(gq, o)); gk = fmaxf(gk, __shfl_xor(gk, o)); }
    const bool bounded = 8.0f * 1.4426950408889634f * gq * gk <= 40.0f;
#pragma unroll 1
    for (int rep = 0; rep <= PROBE_ATTN2; ++rep)
#pragma unroll 1
    for (int pi = C.vcu; pi < 512; pi += C.G) {
        const int bh = pi >> 5, s = pi & 31;
        if (bounded) {
#pragma unroll 1
            for (int u = 0; u < 2; ++u) att::attn_unit_pipe(bh >> 2, bh & 3, u ? s : 63 - s, Z, Y, P.in[I_SUBLN], lam, C.lds);
        } else {
#pragma unroll 1
            for (int u = 0; u < 2; ++u) att::attn_unit<false>(bh >> 2, bh & 3, u ? s : 63 - s, Z, Y, P.in[I_SUBLN], lam, C.lds);
        }
    }
}

__device__ __forceinline__ unsigned mono(float f) { const unsigned u = __float_as_uint(f); return (u & 0x80000000u) ? ~u : (u | 0x80000000u); }
__device__ __forceinline__ float unmono(unsigned u) { return __uint_as_float((u & 0x80000000u) ? (u & 0x7fffffffu) : ~u); }
template <class T> __device__ __forceinline__ void sort16_desc(T (&a)[16]) {
#define CE(i, j) { const T mx = a[i] > a[j] ? a[i] : a[j], mn = a[i] > a[j] ? a[j] : a[i]; a[i] = mx; a[j] = mn; }
    CE(0, 13) CE(1, 12) CE(2, 15) CE(3, 14) CE(4, 8) CE(5, 6) CE(7, 11) CE(9, 10)
    CE(0, 5) CE(1, 7) CE(2, 9) CE(3, 4) CE(6, 13) CE(8, 14) CE(10, 15) CE(11, 12)
    CE(0, 1) CE(2, 3) CE(4, 5) CE(6, 8) CE(7, 9) CE(10, 11) CE(12, 13) CE(14, 15)
    CE(0, 2) CE(1, 3) CE(4, 10) CE(5, 11) CE(6, 7) CE(8, 9) CE(12, 14) CE(13, 15)
    CE(1, 2) CE(3, 12) CE(4, 6) CE(5, 7) CE(8, 10) CE(9, 11) CE(13, 14)
    CE(1, 4) CE(2, 6) CE(5, 8) CE(7, 10) CE(9, 13) CE(11, 14)
    CE(2, 4) CE(3, 6) CE(9, 12) CE(11, 13)
    CE(3, 5) CE(6, 8) CE(7, 9) CE(10, 12)
    CE(3, 4) CE(5, 6) CE(7, 8) CE(9, 10) CE(11, 12)
    CE(6, 7) CE(8, 9)
#undef CE
}
template <class T> __device__ __forceinline__ void merge16_desc(T (&a)[16], const T (&b)[16]) {
#pragma unroll
    for (int i = 0; i < 16; ++i) a[i] = a[i] > b[15 - i] ? a[i] : b[15 - i];
#pragma unroll
    for (int j = 8; j > 0; j >>= 1)
#pragma unroll
        for (int i = 0; i < 16; ++i) { const int l = i ^ j; if (l > i) { const T mx = a[i] > a[l] ? a[i] : a[l], mn = a[i] > a[l] ? a[l] : a[i]; a[i] = mx; a[l] = mn; } }
}
__device__ __forceinline__ void top16_of_128(const _Float16* sc, unsigned (&a)[16]) {
    f16x8 n0 = *(const f16x8*)sc, n1 = *(const f16x8*)(sc + 8);
#pragma unroll 1
    for (int g = 0; g < 8; ++g) {
        const f16x8 h0 = n0, h1 = n1;
        { const int gn = g < 7 ? g + 1 : 7; n0 = *(const f16x8*)(sc + 16 * gn); n1 = *(const f16x8*)(sc + 16 * gn + 8); }
        unsigned b[16];
#pragma unroll
        for (int i = 0; i < 8; ++i) { b[i] = (mono((float)h0[i]) & ~127u) | (unsigned)(127 - (16 * g + i)); b[8 + i] = (mono((float)h1[i]) & ~127u) | (unsigned)(127 - (16 * g + 8 + i)); }
        sort16_desc(b);
        if (g == 0) {
#pragma unroll
            for (int i = 0; i < 16; ++i) a[i] = b[i];
        } else merge16_desc(a, b);
    }
}
typedef unsigned long long u64;
__device__ __forceinline__ void phase_topk(const Ctx& C) {
    const Params& P = *C.p; unsigned char* ws = P.ws;
    const _Float16* SC = (const _Float16*)(ws + WS_Z); int* EI = (int*)(ws + WS_EIDX); float* GT = (float*)(ws + WS_GATE);
    const int gt = C.vcu * 512 + C.tid, NT = C.G * 512;
    for (int it = gt; it < M_TOK * 8; it += NT) {
        const _Float16* sc = SC + (size_t)it * 256;
        unsigned a0[16], a1[16];
        top16_of_128(sc, a0); top16_of_128(sc + 128, a1);
        float v0[16], v1[16]; unsigned e0[16], e1[16];
#pragma unroll
        for (int i = 0; i < 16; ++i) { v0[i] = unmono(a0[i] & ~127u); v1[i] = unmono(a1[i] & ~127u); e0[i] = (127u - (a0[i] & 127u)) << 7; e1[i] = 127u - (a1[i] & 127u); }
#define CAND(i, j) ((((u64)mono(v0[i] + v1[j])) << 32) | (u64)(((255u - (unsigned)((i) * 16 + (j))) << 16) | e0[i] | e1[j]))
        u64 a[16], bq[16];
#pragma unroll
        for (int j = 0; j < 16; ++j) a[j] = CAND(0, j);
#pragma unroll
        for (int i = 0; i < 15; ++i) bq[i] = CAND(i + 1, 0);
        bq[15] = 0ull; merge16_desc(a, bq);
#pragma unroll
        for (int i = 0; i < 16; ++i) bq[i] = 0ull;
#pragma unroll
        for (int j = 1; j < 8; ++j) bq[j - 1] = CAND(1, j);
        merge16_desc(a, bq);
#pragma unroll
        for (int i = 0; i < 16; ++i) bq[i] = 0ull;
#pragma unroll
        for (int i = 2; i < 8; ++i) bq[i - 2] = CAND(i, 1);
        merge16_desc(a, bq);
#pragma unroll
        for (int i = 0; i < 16; ++i) bq[i] = 0ull;
        bq[0] = CAND(2, 2); bq[1] = CAND(2, 3); bq[2] = CAND(2, 4); bq[3] = CAND(3, 2); bq[4] = CAND(4, 2); bq[5] = CAND(3, 3);
        sort16_desc(bq); merge16_desc(a, bq);
#undef CAND
        float sv[16]; const float smax = unmono((unsigned)(a[0] >> 32)); float den = 0.f;
#pragma unroll
        for (int i = 0; i < 16; ++i) { sv[i] = __expf(unmono((unsigned)(a[i] >> 32)) - smax); den += sv[i]; }
        const float rd = 1.0f / den;
        int* eo = EI + (size_t)it * 16; float* go = GT + (size_t)it * 16;
#pragma unroll
        for (int q = 0; q < 4; ++q) {
            *(u32x4*)(eo + 4 * q) = (u32x4){(unsigned)a[4 * q] & 0x3fffu, (unsigned)a[4 * q + 1] & 0x3fffu, (unsigned)a[4 * q + 2] & 0x3fffu, (unsigned)a[4 * q + 3] & 0x3fffu};
            *(f32x4*)(go + 4 * q) = (f32x4){sv[4 * q] * rd, sv[4 * q + 1] * rd, sv[4 * q + 2] * rd, sv[4 * q + 3] * rd};
        }
    }
}

constexpr int GT_T = 8;
typedef _Float16 h16x2 __attribute__((ext_vector_type(2)));
typedef int v4i_t __attribute__((ext_vector_type(4)));
typedef int v8i_t __attribute__((ext_vector_type(8)));
__device__ __forceinline__ f32x4 mx4(const v4i_t a, const v4i_t b, const f32x4 c) {
    const v8i_t A = {a[0], a[1], a[2], a[3], 0, 0, 0, 0}, B = {b[0], b[1], b[2], b[3], 0, 0, 0, 0};
    return __builtin_amdgcn_mfma_scale_f32_16x16x128_f8f6f4(A, B, c, 4, 4, 0, 0x7f7f7f7f, 0, 0x7f7f7f7f);
}
__device__ __forceinline__ float gelu_erf(float a) {
    const float x = a * 0.70710678118654752f, ax = fabsf(x);
    const float t = __builtin_amdgcn_rcpf(fmaf(0.3275911f, ax, 1.0f));
    const float pl = t * fmaf(t, fmaf(t, fmaf(t, fmaf(t, 1.061405429f, -1.453152027f), 1.421413741f), -0.284496736f), 0.254829592f);
    const float er = fmaf(-pl, __builtin_amdgcn_exp2f(-1.4426950408889634f * x * x), 1.0f);
    return 0.5f * a * (1.0f + copysignf(er, x));
}
__device__ __forceinline__ unsigned pkmax16(unsigned a, unsigned b) { typedef unsigned short us2 __attribute__((ext_vector_type(2))); return __builtin_bit_cast(unsigned, __builtin_elementwise_max(__builtin_bit_cast(us2, a), __builtin_bit_cast(us2, b))); }
__device__ __forceinline__ void phase_gather(const Ctx& C, bool dry = false) {
    const Params& P = *C.p; unsigned char* ws = P.ws; const int lane = C.lane;
    bf16_t* HB = (bf16_t*)(ws + WS_ACTB); const float* rowss = (const float*)(ws + WS_CTL + WS_ROWSS2); float* rinv3 = (float*)(ws + WS_RINV3);
    bf16_t* HBW = dry ? (bf16_t*)(ws + WS_YCAT) : HB; float* R3W = dry ? (float*)(ws + WS_WIN) : rinv3;
    const auto rsT = __builtin_amdgcn_make_buffer_rsrc((void*)(ws + WS_UT), 0, 16 << 20, 0x00020000);
    const int* EI = (const int*)(ws + WS_EIDX); const float* GT = (const float*)(ws + WS_GATE);
    constexpr int WLDS = 9216;
    LAS u32x2* sl = (LAS u32x2*)(C.lds + C.wave * WLDS);
    LAS float* gl = (LAS float*)(C.lds + C.wave * WLDS + 1024);
    LAS int* el = (LAS int*)(C.lds + C.wave * WLDS + 5120);
    const unsigned lane16 = 16u * (unsigned)lane;
    const int mi = lane & 15, mg = lane >> 4;
    const bool xsel = mi < 8 && mg == (mi >> 1), nodd = lane & 1;
    for (int tok0 = (C.vcu * 8 + C.wave) * GT_T; tok0 < M_TOK; tok0 += C.G * 8 * GT_T) {
        h16x2 op[GT_T][8];
#pragma unroll
        for (int j = 0; j < GT_T; ++j) {
            const int tok = tok0 + j;
            const int e0 = EI[(size_t)tok * 128 + lane], e1 = EI[(size_t)tok * 128 + 64 + lane]; const float g0 = GT[(size_t)tok * 128 + lane], g1 = GT[(size_t)tok * 128 + 64 + lane];
            int pos0 = 0, pos1 = 0, base = 0;
#pragma unroll
            for (int b = 0; b < 16; ++b) {
                const bool q0 = (e0 >> 10) == b, q1 = (e1 >> 10) == b;
                const unsigned long long m0 = __ballot(q0), m1 = __ballot(q1);
                const int c0 = __builtin_popcountll(m0), c1 = __builtin_popcountll(m1);
                const int r0 = __builtin_amdgcn_mbcnt_hi((unsigned)(m0 >> 32), __builtin_amdgcn_mbcnt_lo((unsigned)m0, 0u));
                const int r1 = __builtin_amdgcn_mbcnt_hi((unsigned)(m1 >> 32), __builtin_amdgcn_mbcnt_lo((unsigned)m1, 0u));
                if (q0) pos0 = base + r0;
                if (q1) pos1 = base + c0 + r1;
                base += c0 + c1;
            }
            sl[pos0] = (u32x2){(unsigned)e0, __float_as_uint(g0)}; sl[pos1] = (u32x2){(unsigned)e1, __float_as_uint(g1)};
            const u32x2 a = sl[lane], b = sl[64 + lane];
            gl[j * 128 + lane] = __uint_as_float(a.y); gl[j * 128 + 64 + lane] = __uint_as_float(b.y);
            el[j * 128 + lane] = (int)a.x; el[j * 128 + 64 + lane] = (int)b.x;
        }
        v4i_t xb1[8], xb2[8]; float ascl;
        {
            const int tok = tok0 + (lane & 7); const bf16_t* hp = HB + (size_t)tok * DM + 32 * mg;
            unsigned mx = 0u;
#pragma unroll
            for (int st = 0; st < 8; ++st)
#pragma unroll
                for (int c = 0; c < 4; ++c) { const u32x4 hw = *(const u32x4*)(hp + 128 * st + 8 * c);
                    mx = pkmax16(mx, pkmax16(pkmax16(hw.x & 0x7fff7fffu, hw.y & 0x7fff7fffu), pkmax16(hw.z & 0x7fff7fffu, hw.w & 0x7fff7fffu))); }
            float am = __uint_as_float(((mx & 0xffffu) > (mx >> 16) ? (mx & 0xffffu) : (mx >> 16)) << 16);
            am = fmaxf(am, __shfl_xor(am, 16)); am = fmaxf(am, __shfl_xor(am, 32)); am = fmaxf(am, 1e-30f);
            const float sc = 6.0f / am, sc8 = 8.0f * sc;
            ascl = am * (1.0f / 6.0f) * rsqrtf(rowss[tok] * (1.0f / 1024.0f) + EPS) * (1.0f / U4SCALE);
#pragma unroll
            for (int st = 0; st < 8; ++st)
#pragma unroll
                for (int c = 0; c < 4; ++c) { const u32x4 hw = *(const u32x4*)(hp + 128 * ((st + lane) & 7) + 8 * c); unsigned q1 = 0u, q2 = 0u;
#define GX_BYTE(b, w) { const float h0 = bflo(w), h1 = bfhi(w); q1 = __builtin_amdgcn_cvt_scalef32_pk_fp4_f32(q1, h0 * sc, h1 * sc, 1.0f, b); \
                        const f32x2 d8 = __builtin_amdgcn_cvt_scalef32_pk_f32_fp4(q1, 8.0f, b); q2 = __builtin_amdgcn_cvt_scalef32_pk_fp4_f32(q2, fmaf(h0, sc8, -d8[0]), fmaf(h1, sc8, -d8[1]), 1.0f, b); }
                    GX_BYTE(0, hw.x) GX_BYTE(1, hw.y) GX_BYTE(2, hw.z) GX_BYTE(3, hw.w)
#undef GX_BYTE
                    xb1[st][c] = (int)q1; xb2[st][c] = (int)q2; }
        }
#pragma unroll
        for (int j = 0; j < GT_T; ++j)
#pragma unroll
            for (int i = 0; i < 8; ++i) op[j][i] = (h16x2){(_Float16)0.f, (_Float16)0.f};
        {
            const int ro = (mi >> 1) * 128 + (mi & 1);
            const LAS int* elp = el + ro; const LAS float* glw = gl + (lane & 7) * 128;
            unsigned rot[8];
#pragma unroll
            for (int st = 0; st < 8; ++st) rot[st] = 64u * (unsigned)((st + (mi >> 1)) & 7) + 16u * (unsigned)mg;
            int ev = elp[0];
            v4i_t a[8];
            { const unsigned vo = (unsigned)ev << 10;
#pragma unroll
              for (int st = 0; st < 8; ++st) a[st] = __builtin_bit_cast(v4i_t, __builtin_amdgcn_raw_buffer_load_b128(rsT, vo + rot[st], 0, 0)); }
#pragma unroll 1
            for (int k = 0; k < 64; ++k) {
                u32x2 w[16];
#pragma unroll
                for (int r = 0; r < 16; ++r) { const int e = __builtin_amdgcn_readlane(ev, r); w[r] = __builtin_amdgcn_raw_buffer_load_b64(rsT, (lane16 >> 1) + 512u, e << 10, 17); }
                __builtin_amdgcn_sched_barrier(0);
                f32x4 c1 = {0.f, 0.f, 0.f, 0.f}, c2 = {0.f, 0.f, 0.f, 0.f};
#pragma unroll
                for (int st = 0; st < 8; ++st) { c1 = mx4(a[st], xb1[st], c1); c2 = mx4(a[st], xb2[st], c2); }
                const float v0 = nodd ? c1[2] + 0.125f * c2[2] : c1[0] + 0.125f * c2[0], v1 = nodd ? c1[3] + 0.125f * c2[3] : c1[1] + 0.125f * c2[1];
                const f32x2 gt2 = *(const LAS f32x2*)(glw + 2 * k);
                __builtin_amdgcn_sched_barrier(0);
                { ev = elp[k < 63 ? 2 * k + 2 : 126]; const unsigned vo = (unsigned)ev << 10;
#pragma unroll
                    for (int st = 0; st < 8; ++st) a[st] = __builtin_bit_cast(v4i_t, __builtin_amdgcn_raw_buffer_load_b128(rsT, vo + rot[st], 0, 0)); }
                __builtin_amdgcn_sched_barrier(0);
                const float h0 = gelu_erf(v0 * ascl) * gt2[0] * (1.0f / V4SCALE), h1 = gelu_erf(v1 * ascl) * gt2[1] * (1.0f / V4SCALE);
                const h16x2 hh0 = {(_Float16)h0, (_Float16)h0}, hh1 = {(_Float16)h1, (_Float16)h1}; const unsigned hr0 = __builtin_bit_cast(unsigned, hh0), hr1 = __builtin_bit_cast(unsigned, hh1);
                __builtin_amdgcn_sched_barrier(0);
                unsigned scs[16];
#pragma unroll
                for (int r = 0; r < 16; ++r) scs[r] = (unsigned)__builtin_amdgcn_readlane((int)((r & 1) ? hr1 : hr0), (r >> 1) + 16 * (r >> 2));
#pragma unroll
                for (int r = 0; r < 16; ++r) { const int j = r >> 1; const h16x2 sc = __builtin_bit_cast(h16x2, scs[r]); u32x2 ww = w[r];
                    asm volatile("" : "+v"(ww));
#pragma unroll
                    for (int c = 0; c < 2; ++c) {
                        op[j][4 * c + 0] = __builtin_elementwise_fma(sc, __builtin_bit_cast(h16x2, __builtin_amdgcn_cvt_scalef32_pk_f16_fp4(ww[c], 1.0f, 0)), op[j][4 * c + 0]);
                        op[j][4 * c + 1] = __builtin_elementwise_fma(sc, __builtin_bit_cast(h16x2, __builtin_amdgcn_cvt_scalef32_pk_f16_fp4(ww[c], 1.0f, 1)), op[j][4 * c + 1]);
                        op[j][4 * c + 2] = __builtin_elementwise_fma(sc, __builtin_bit_cast(h16x2, __builtin_amdgcn_cvt_scalef32_pk_f16_fp4(ww[c], 1.0f, 2)), op[j][4 * c + 2]);
                        op[j][4 * c + 3] = __builtin_elementwise_fma(sc, __builtin_bit_cast(h16x2, __builtin_amdgcn_cvt_scalef32_pk_f16_fp4(ww[c], 1.0f, 3)), op[j][4 * c + 3]); }
                    asm volatile("" : "+v"(op[j][0]), "+v"(op[j][1]), "+v"(op[j][2]), "+v"(op[j][3]), "+v"(op[j][4]), "+v"(op[j][5]), "+v"(op[j][6]), "+v"(op[j][7])); }
                __builtin_amdgcn_sched_barrier(0);
            }
        }
#pragma unroll
        for (int j = 0; j < GT_T; ++j) {
            const int tok = tok0 + j; const bf16_t* hp0 = HB + (size_t)tok * DM + 16 * lane; f32x4 hv[4]; float ss = 0.f;
            const u32x4 hw0 = *(const u32x4*)hp0, hw1 = *(const u32x4*)(hp0 + 8);
            hv[0] = (f32x4){bflo(hw0.x), bfhi(hw0.x), bflo(hw0.y), bfhi(hw0.y)}; hv[1] = (f32x4){bflo(hw0.z), bfhi(hw0.z), bflo(hw0.w), bfhi(hw0.w)};
            hv[2] = (f32x4){bflo(hw1.x), bfhi(hw1.x), bflo(hw1.y), bfhi(hw1.y)}; hv[3] = (f32x4){bflo(hw1.z), bfhi(hw1.z), bflo(hw1.w), bfhi(hw1.w)};
#pragma unroll
            for (int i = 0; i < 4; ++i) { hv[i] = hv[i] + (f32x4){(float)op[j][2 * i].x, (float)op[j][2 * i].y, (float)op[j][2 * i + 1].x, (float)op[j][2 * i + 1].y};
                ss += (hv[i][0] * hv[i][0] + hv[i][1] * hv[i][1]) + (hv[i][2] * hv[i][2] + hv[i][3] * hv[i][3]); }
            ss = wave_sum(ss);
            bf16_t* bp = HBW + (size_t)tok * DM + 16 * lane;
            *(u32x4*)bp = (u32x4){cvtpk(hv[0][0], hv[0][1]), cvtpk(hv[0][2], hv[0][3]), cvtpk(hv[1][0], hv[1][1]), cvtpk(hv[1][2], hv[1][3])};
            *(u32x4*)(bp + 8) = (u32x4){cvtpk(hv[2][0], hv[2][1]), cvtpk(hv[2][2], hv[2][3]), cvtpk(hv[3][0], hv[3][1]), cvtpk(hv[3][2], hv[3][3])};
            if (lane == 0) R3W[tok] = rsqrtf(ss * (1.0f / 1024.0f) + EPS);
        }
    }
}

constexpr int N_PHASES = 9;
__global__ void __launch_bounds__(512, 2) mk_fwd(Params prm) {
    extern __shared__ __attribute__((aligned(16))) unsigned char lds_raw[];
    Ctx C; C.lds = (LAS unsigned char*)lds_raw; C.tid = threadIdx.x; C.lane = C.tid & 63; C.wave = __builtin_amdgcn_readfirstlane(C.tid >> 6);
    C.G = gridDim.x; { const int bx = blockIdx.x; C.vcu = (C.G % 8 == 0) ? (bx % 8) * (C.G / 8) + bx / 8 : bx; }
    C.p = &prm;
    unsigned char* ws = prm.ws;
    const int lo = prm.ph_lo, hi = prm.ph_hi;
#define IN(k) (lo <= (k) && (k) < hi)
    { volatile LAS unsigned* st = (volatile LAS unsigned*)(C.lds + LDS_BYTES - 64); if (C.tid < 2) st[C.tid] = 0u; __syncthreads(); }
    XcdBarrier xbar = xcd_barrier_post((unsigned*)(ws + WS_CTL) + 4096, (volatile LAS unsigned*)(C.lds + LDS_BYTES - 64));
#define SEAM(k) do { if (IN(k) && IN((k) + 1)) { xcd_barrier(xbar); } } while (0)
#if MK_COOP_SYNC0
    if (hi > N_PHASES) cg::this_grid().sync();
#endif
    bf16_t* ACTB = (bf16_t*)(ws + WS_ACTB); bf16_t* Z = (bf16_t*)(ws + WS_Z); bf16_t* YC = (bf16_t*)(ws + WS_YCAT); bf16_t* PPB = (bf16_t*)(ws + WS_PP);
    float* rowss2 = (float*)(ws + WS_CTL + WS_ROWSS2);
    if (IN(0)) { _Pragma("unroll 1") for (int rep = 0; rep <= PROBE_PREP; ++rep) { phase_prep(C); __syncthreads(); } }
    SEAM(0);
    if (IN(1)) for (int rep1 = 0; rep1 <= PROBE_G1; ++rep1) {
        { pg8::Gemm g{ACTB, (const bf16_t*)(ws + WS_WIN), M_TOK, 2048, 1024}; pg8::StaticOrder S; S.init(M_TOK, 2048, C.G, (int)blockIdx.x); pg8::EpiZ E{Z, ZLD, prm.in[I_QN], prm.in[I_KN], (const unsigned*)(ws + WS_CST)};
          pg8::gemm_phase<pg8::EpiZ, pg8::StaticOrder, true, true>(C.lds, g, S, E); }
        { pg8::Gemm g{(const bf16_t*)(ws + WS_PB), (const bf16_t*)(ws + WS_WP), M_TOK, 1024, 256}; pg8::StaticOrder S; S.init(M_TOK, 1024, C.G, (int)blockIdx.x); pg8::EpiStoreBf16 E{PPB, DM};
          pg8::gemm_phase<pg8::EpiStoreBf16, pg8::StaticOrder, true, true>(C.lds, g, S, E); }
    }
    SEAM(1);
    if (IN(2)) phase_rope_pool(C);
    for (int rep = 0; rep < PROBE_SYNC; ++rep) xcd_barrier(xbar);
    if (IN(3)) { _Pragma("unroll 1") for (int rep = 0; rep <= PROBE_ATTN; ++rep) phase_attn(C); }
    SEAM(3);
    if (IN(4)) { pg8::Gemm g{YC, (const bf16_t*)(ws + WS_WO), M_TOK, 1024, 1024}; pg8::StaticOrder S; S.init(M_TOK, 1024, C.G, (int)blockIdx.x); pg8::EpiWo E{prm.in[I_X], ACTB, rowss2};
        pg8::gemm_phase<pg8::EpiWo, pg8::StaticOrder, true, true>(C.lds, g, S, E); }
    SEAM(4);
    if (IN(5)) for (int rep5 = 0; rep5 <= PROBE_G5; ++rep5) { pg8::Gemm g{ACTB, (const bf16_t*)(ws + WS_WS), M_TOK, 2048, 1024}; pg8::StaticOrder S; S.init(M_TOK, 2048, C.G, (int)blockIdx.x); pg8::EpiScores E{(_Float16*)(ws + WS_Z), ZLD, rowss2};
        pg8::gemm_phase<pg8::EpiScores, pg8::StaticOrder, true, true>(C.lds, g, S, E); }
    SEAM(5);
    if (IN(6)) { _Pragma("unroll 1") for (int rep = 0; rep <= PROBE_TOPK; ++rep) phase_topk(C); }
    if (IN(6) && IN(7)) { asm volatile("s_waitcnt vmcnt(0)" ::: "memory"); __syncthreads(); } else { SEAM(6); }
    if (IN(7)) { _Pragma("unroll 1") for (int rep = 0; rep < PROBE_GATHER; ++rep) phase_gather(C, true); phase_gather(C); }
    SEAM(7);
    if (IN(8)) { pg8::Gemm g{ACTB, (const bf16_t*)(ws + WS_WG), M_TOK, 1024, 1024}; pg8::StaticOrder S; S.init(M_TOK, 1024, C.G, (int)blockIdx.x); pg8::EpiGate E{prm.out, ACTB, PPB, (const float*)(ws + WS_RINV3)};
        pg8::gemm_phase<pg8::EpiGate, pg8::StaticOrder, true, true>(C.lds, g, S, E); }
#undef IN
#undef SEAM
}

extern "C" void kernel_launch(void* const* d_in, const int* in_sizes, int n_in, void* d_out, int out_size, void* d_ws, size_t ws_size, hipStream_t stream) {
    static int grid = 0;
    if (grid == 0) {
        if (n_in != 23 || in_sizes[0] != M_TOK * DM || out_size != M_TOK * DM || ws_size < WS_END) { fprintf(stderr, "kernel_launch: unexpected shapes (n_in %d in0 %d out %d ws %zu)\n", n_in, n_in > 0 ? in_sizes[0] : -1, out_size, ws_size); grid = -1; return; }
        int dev = 0, cus = 0, per_cu = 0;
        hipGetDevice(&dev); hipDeviceGetAttribute(&cus, hipDeviceAttributeMultiprocessorCount, dev);
        hipFuncSetAttribute((const void*)mk_fwd, hipFuncAttributeMaxDynamicSharedMemorySize, LDS_BYTES);
        hipOccupancyMaxActiveBlocksPerMultiprocessor(&per_cu, (const void*)mk_fwd, 512, LDS_BYTES);
        if (per_cu < 1) { fprintf(stderr, "kernel_launch: occupancy query says %d blocks per CU\n", per_cu); per_cu = 1; }
        (void)hipGetLastError();
        grid = cus;
    }
    if (grid < 0) return;
    hipMemsetAsync((char*)d_ws + WS_CTL, 0, CTL_BYTES, stream);
    Params prm{};
    for (int i = 0; i < 23; ++i) prm.in[i] = (const float*)d_in[i];
    prm.out = (float*)d_out; prm.ws = (unsigned char*)d_ws;
#if MK_MULTI
    for (int ph = 0; ph < N_PHASES; ++ph) { prm.ph_lo = ph; prm.ph_hi = ph + 1; hipLaunchKernelGGL(mk_fwd, dim3(grid), dim3(512), LDS_BYTES, stream, prm); }
#else
    prm.ph_lo = 0; prm.ph_hi = N_PHASES;
#if MK_COOP_SYNC0
    void* args[] = {&prm};
    hipError_t e = hipLaunchCooperativeKernel((const void*)mk_fwd, dim3(grid), dim3(512), args, LDS_BYTES, stream);
    if (e != hipSuccess) fprintf(stderr, "cooperative launch failed: %s (grid %d)\n", hipGetErrorString(e), grid);
#else
    hipLaunchKernelGGL(mk_fwd, dim3(grid), dim3(512), LDS_BYTES, stream, prm);
#endif
#endif
}
```

```cpp
#include <hip/hip_runtime.h>
#include <hip/hip_cooperative_groups.h>
#include <cstdio>
#include <cstdint>
#include <cmath>
namespace cg = cooperative_groups;

#ifndef MK_COOP_SYNC0
#define MK_COOP_SYNC0 1
#endif
#ifndef MK_MULTI
#define MK_MULTI 0
#endif

#ifndef PROBE_ATTN2
#define PROBE_ATTN2 0
#endif
#ifndef PROBE_G1
#define PROBE_G1 0
#endif
#ifndef PROBE_G5
#define PROBE_G5 0
#endif
#ifndef PROBE_PREP
#define PROBE_PREP 0
#endif
#ifndef PROBE_ATTN
#define PROBE_ATTN 0
#endif
#ifndef PROBE_TOPK
#define PROBE_TOPK 0
#endif
#ifndef XSCALE_ARG
#define XSCALE_ARG scl
#endif
#ifndef PROBE_GATHER
#define PROBE_GATHER 0
#endif
#ifndef PROBE_SYNC
#define PROBE_SYNC 0
#endif
#define LAS __attribute__((address_space(3)))
typedef unsigned short bf16_t;
typedef short bf16x8 __attribute__((ext_vector_type(8)));
typedef short s16x4 __attribute__((ext_vector_type(4)));
typedef float f32x4 __attribute__((ext_vector_type(4)));
typedef float f32x2 __attribute__((ext_vector_type(2)));
typedef float f32x16 __attribute__((ext_vector_type(16)));
typedef unsigned u32x4 __attribute__((ext_vector_type(4)));
typedef unsigned u32x2 __attribute__((ext_vector_type(2)));
typedef __bf16 bf16x2_t __attribute__((ext_vector_type(2)));
typedef _Float16 f16x8 __attribute__((ext_vector_type(8)));
typedef _Float16 f16x2 __attribute__((ext_vector_type(2)));

constexpr int M_TOK = 32768, DM = 1024, SEQ = 8192, NB = 4, ZLD = 2048, DPLE = 256;
constexpr float EPS = 1e-6f;
constexpr float U4SCALE = 64.0f, V4SCALE = 5.656854249f;
constexpr float QSCALE = 0.125f * 1.4426950408889634f;
constexpr size_t MiB = 1u << 20;
constexpr size_t WS_CTL = 0, CTL_BYTES = 1 * MiB;
constexpr size_t WS_ROWSS2 = 256 * 1024;
constexpr size_t WS_WIN = 1 * MiB, WS_WO = 5 * MiB, WS_WS = 7 * MiB, WS_WG = 11 * MiB, WS_WP = 13 * MiB, WS_RINV3 = 14 * MiB;
constexpr size_t WS_UT = 16 * MiB  , WS_VT = 48 * MiB  , WS_ACTB = 80 * MiB, WS_PB = 144 * MiB, WS_Z = 160 * MiB, WS_YCAT = 288 * MiB, WS_PP = 352 * MiB;
constexpr size_t WS_EIDX = 416 * MiB, WS_GATE = 432 * MiB, WS_CST = 448 * MiB, WS_END = 452 * MiB;
constexpr int LDS_BYTES = 147456;

__device__ __forceinline__ unsigned cvtpk(float lo, float hi) { f32x2 v = {lo, hi}; bf16x2_t b = __builtin_convertvector(v, bf16x2_t); return __builtin_bit_cast(unsigned, b); }
__device__ __forceinline__ float bflo(unsigned w) { return __uint_as_float(w << 16); }
__device__ __forceinline__ float bfhi(unsigned w) { return __uint_as_float(w & 0xffff0000u); }
__device__ __forceinline__ unsigned pack_i8(const f32x4 v) {
    int a = __float2int_rn(v[0]), b = __float2int_rn(v[1]), c = __float2int_rn(v[2]), d = __float2int_rn(v[3]);
    a = a < -127 ? -127 : (a > 127 ? 127 : a); b = b < -127 ? -127 : (b > 127 ? 127 : b); c = c < -127 ? -127 : (c > 127 ? 127 : c); d = d < -127 ? -127 : (d > 127 ? 127 : d);
    return ((unsigned)a & 0xffu) | (((unsigned)b & 0xffu) << 8) | (((unsigned)c & 0xffu) << 16) | ((unsigned)d << 24);
}
__device__ __forceinline__ unsigned pack_u4x8(const f32x4 a, const f32x4 b) {
    unsigned w = 0;
#pragma unroll
    for (int i = 0; i < 4; ++i) { int lo = __float2int_rn(a[i]), hi = __float2int_rn(b[i]); lo = lo < -8 ? -8 : (lo > 7 ? 7 : lo); hi = hi < -8 ? -8 : (hi > 7 ? 7 : hi);
        w |= ((unsigned)(lo + 8) | ((unsigned)(hi + 8) << 4)) << (8 * i); }
    return w;
}
__device__ __forceinline__ float wave_sum(float v) {
#pragma unroll
    for (int o = 1; o < 64; o <<= 1) v += __shfl_xor(v, o);
    return v;
}

namespace pg8 {
#define PG8_LAS __attribute__((address_space(3)))
constexpr int BM = 256, BK = 64, HALF = 128, HTB = HALF * BK * 2, STAGE_BYTES = 8 * HTB, NXCD = 8, WGM = 8;
__host__ __device__ __forceinline__ int lds_byte(int r, int c) { const int st = (r >> 4) * 2 + (c >> 5), rr = r & 15, cc = c & 31, ob = rr * 64 + cc * 2; return st * 1024 + (ob ^ (((ob >> 9) & 1) << 5)); }
__host__ __device__ __forceinline__ void stage_rc(int b, int& R, int& C) { const int st = b / 1024, sb = b % 1024, swz = sb ^ (((sb >> 9) & 1) << 5); R = (st >> 1) * 16 + swz / 64; C = (st & 1) * 32 + (swz % 64) / 2; }
__host__ __device__ __forceinline__ int perm32(int rho) { const int n = rho >> 4, i = rho & 15; return 8 * (i >> 2) + 4 * n + (i & 3); }
struct Unit { int pm, pn; };
struct Gemm { const bf16_t* A; const bf16_t* Bt; int M, N, K; };
struct StaticOrder {
    int nM, nN, nwg, G, c;
    __host__ __device__ void init(int M, int N, int G_, int c_) { nM = M / BM; nN = N / BM; nwg = nM * nN; G = G_; c = c_; }
    __host__ __device__ bool next(int i, Unit& u) const {
        const long L = (long)i * G + c; if (L >= nwg) return false;
        int wgid = (int)L; { const int q = nwg / NXCD, r = nwg % NXCD, xcd = wgid % NXCD, off = wgid / NXCD; wgid = (xcd < r ? xcd * (q + 1) : r * (q + 1) + (xcd - r) * q) + off; }
        const int nig = WGM * nN, gid = wgid / nig, fm = gid * WGM, gsz = (nM - fm) < WGM ? (nM - fm) : WGM;
        u.pm = fm + ((wgid % nig) % gsz); u.pn = (wgid % nig) / gsz; return true;
    }
    __device__ __forceinline__ void a_ready(const Unit&) const {}
    __device__ __forceinline__ void done(const Unit&) const {}
};
template <class Epi, class Sched, bool ALIGN_EPI = false, bool SP2 = false>
__device__ __forceinline__ void gemm_phase(PG8_LAS unsigned char* lds, const Gemm g, const Sched& S, const Epi& E) {
    int tid = threadIdx.x; asm volatile("" : "+v"(tid));
    const int wid = __builtin_amdgcn_readfirstlane(tid >> 6), lane = tid & 63, wr = wid >> 2, wc = wid & 3, fr = lane & 15, fq = lane >> 4;
    const int K = g.K, nt = K / BK;
    unsigned voffA[2], voffB[2];
#pragma unroll
    for (int i = 0; i < 2; ++i) { int R, C; stage_rc(tid * 16 + i * 8192, R, C); const int Rb = Epi::PAIRMAP ? (64 * (R >> 5) + perm32(R & 31)) : Epi::PERM ? ((R & ~31) + perm32(R & 31)) : R;
        voffA[i] = (unsigned)(R * K + C) * 2u; voffB[i] = (unsigned)(Rb * K + C) * 2u; }
    const size_t hstepB = (size_t)(Epi::PAIRMAP ? 32 : HALF) * K * 2;
    const size_t kstep = (size_t)(BK * 2);
    const size_t hstep = (size_t)HALF * K * 2;
    const size_t tstep = 2 * hstep;
    const unsigned ldsw = (unsigned)wid * 1024u;
    const int aoff = lds_byte(wr * 64 + fr, fq * 8), boff = lds_byte(wc * 32 + fr, fq * 8);
#define PG8_SA(b, h) (((b) * 2 + (h)) * HTB)
#define PG8_SB(b, h) ((4 + (b) * 2 + (h)) * HTB)
#define PG8_STAGE(bufoff, gbase, voff) do { _Pragma("unroll") for (int _i = 0; _i < 2; ++_i) \
        __builtin_amdgcn_global_load_lds((const unsigned*)((const char*)(gbase) + (voff)[_i]), (PG8_LAS unsigned*)(lds + (bufoff) + ldsw + _i * 8192), 16, 0, 0); } while (0)
#define PG8_LDA(dst, b, h) do { _Pragma("unroll") for (int m = 0; m < 4; ++m) _Pragma("unroll") for (int k = 0; k < 2; ++k) dst[m][k] = *(const PG8_LAS bf16x8*)(lds + PG8_SA(b, h) + aoff + m * 2048 + k * 1024); } while (0)
#define PG8_LDB(dst, b, h) do { _Pragma("unroll") for (int n = 0; n < 2; ++n) _Pragma("unroll") for (int k = 0; k < 2; ++k) dst[n][k] = *(const PG8_LAS bf16x8*)(lds + PG8_SB(b, h) + boff + n * 2048 + k * 1024); } while (0)
#define PG8_MMA(ai, bj, At, Bt) do { __builtin_amdgcn_s_setprio(1); _Pragma("unroll") for (int m = 0; m < 4; ++m) _Pragma("unroll") for (int n = 0; n < 2; ++n) _Pragma("unroll") for (int k = 0; k < 2; ++k) \
        acc[ai][bj][m][n] = __builtin_amdgcn_mfma_f32_16x16x32_bf16(Bt[n][k], At[m][k], acc[ai][bj][m][n], 0, 0, 0); __builtin_amdgcn_s_setprio(0); } while (0)
#define PG8_WAIT_V(n) asm volatile("s_waitcnt vmcnt(" #n ")" ::: "memory")
#define PG8_WAIT_L(n) asm volatile("s_waitcnt lgkmcnt(" #n ")" ::: "memory")
#define PG8_BAR __builtin_amdgcn_s_barrier()
#define PG8_SCHED __builtin_amdgcn_sched_barrier(0)
    Unit cur, nxt; int ui = 0;
    if (!S.next(0, cur)) return;
    f32x4 acc[2][2][4][2];
#pragma unroll
    for (int a = 0; a < 2; ++a)
#pragma unroll
        for (int b = 0; b < 2; ++b)
#pragma unroll
            for (int m = 0; m < 4; ++m)
#pragma unroll
                for (int n = 0; n < 2; ++n) acc[a][b][m][n] = (f32x4){0.f, 0.f, 0.f, 0.f};
    bf16x8 At[4][2], B0[2][2], B1[2][2];
    const char* cA = (const char*)g.A + (size_t)cur.pm * tstep; const char* cB = (const char*)g.Bt + (size_t)cur.pn * tstep;
    S.a_ready(cur);
    if constexpr (SP2) {
        PG8_STAGE(PG8_SB(0, 0), cB, voffB); PG8_STAGE(PG8_SB(0, 1), cB + hstepB, voffB); PG8_STAGE(PG8_SA(0, 0), cA, voffA); PG8_STAGE(PG8_SA(0, 1), cA + hstep, voffA);
        if (wr == 1) PG8_BAR;
        PG8_WAIT_V(2); PG8_BAR;
        PG8_STAGE(PG8_SB(1, 0), cB + kstep, voffB); PG8_STAGE(PG8_SA(1, 0), cA + kstep, voffA); PG8_STAGE(PG8_SB(1, 1), cB + hstepB + kstep, voffB);
        PG8_WAIT_V(6); PG8_BAR;
    } else {
        PG8_STAGE(PG8_SB(0, 0), cB, voffB); PG8_STAGE(PG8_SA(0, 0), cA, voffA); PG8_STAGE(PG8_SB(0, 1), cB + hstepB, voffB); PG8_STAGE(PG8_SA(0, 1), cA + hstep, voffA);
        if (wr == 1) PG8_BAR;
        PG8_WAIT_V(4); PG8_BAR;
        PG8_STAGE(PG8_SB(1, 0), cB + kstep, voffB); PG8_STAGE(PG8_SA(1, 0), cA + kstep, voffA); PG8_STAGE(PG8_SB(1, 1), cB + hstepB + kstep, voffB);
        PG8_WAIT_V(6); PG8_BAR;
    }
    for (;;) {
        const bool has_next = S.next(ui + 1, nxt);
        const char* nA = has_next ? (const char*)g.A + (size_t)nxt.pm * tstep : cA; const char* nB = has_next ? (const char*)g.Bt + (size_t)nxt.pn * tstep : cB;
#pragma unroll 1
        for (int t = 0; t < nt; t += 2) {
            const bool last = (t == nt - 2);
            const char* a1 = cA + (size_t)(t + 1) * kstep;
            const char* a2 = last ? nA : cA + (size_t)(t + 2) * kstep; const char* b2 = last ? nB : cB + (size_t)(t + 2) * kstep;
            const char* a3 = a2 + kstep; const char* b3 = b2 + kstep;
            if (last && has_next) S.a_ready(nxt);
            if constexpr (SP2) {
            PG8_LDB(B0, 0, 0); PG8_LDB(B1, 0, 1); PG8_SCHED; PG8_LDA(At, 0, 0); PG8_STAGE(PG8_SA(1, 1), a1 + hstep, voffA);
            PG8_WAIT_V(8); PG8_WAIT_L(0); PG8_BAR; PG8_MMA(0, 0, At, B0); PG8_MMA(0, 1, At, B1); PG8_BAR; PG8_SCHED;
            PG8_LDA(At, 0, 1); PG8_STAGE(PG8_SB(0, 0), b2, voffB); PG8_STAGE(PG8_SB(0, 1), b2 + hstepB, voffB); PG8_STAGE(PG8_SA(0, 0), a2, voffA);
            PG8_WAIT_V(8); PG8_WAIT_L(0); PG8_BAR; PG8_MMA(1, 0, At, B0); PG8_MMA(1, 1, At, B1); PG8_BAR; PG8_SCHED;
            PG8_LDB(B0, 1, 0); PG8_LDB(B1, 1, 1); PG8_SCHED; PG8_LDA(At, 1, 0); PG8_STAGE(PG8_SA(0, 1), a2 + hstep, voffA);
            PG8_WAIT_V(8); PG8_WAIT_L(0); PG8_BAR; PG8_MMA(0, 0, At, B0); PG8_MMA(0, 1, At, B1); PG8_BAR; PG8_SCHED;
            PG8_LDA(At, 1, 1); PG8_STAGE(PG8_SB(1, 0), b3, voffB); PG8_STAGE(PG8_SB(1, 1), b3 + hstepB, voffB); PG8_STAGE(PG8_SA(1, 0), a3, voffA);
            PG8_WAIT_V(8); PG8_WAIT_L(0); PG8_BAR; PG8_MMA(1, 0, At, B0); PG8_MMA(1, 1, At, B1); PG8_BAR; PG8_SCHED;
            } else {
            PG8_LDB(B0, 0, 0); PG8_SCHED; PG8_LDA(At, 0, 0); PG8_STAGE(PG8_SA(1, 1), a1 + hstep, voffA);
            PG8_WAIT_L(8); PG8_BAR; PG8_WAIT_L(0); PG8_MMA(0, 0, At, B0); PG8_BAR; PG8_SCHED;
            PG8_LDB(B1, 0, 1); PG8_STAGE(PG8_SB(0, 0), b2, voffB);
            PG8_BAR; PG8_WAIT_L(0); PG8_MMA(0, 1, At, B1); PG8_BAR;
            PG8_LDA(At, 0, 1); PG8_STAGE(PG8_SA(0, 0), a2, voffA);
            PG8_BAR; PG8_WAIT_L(0); PG8_MMA(1, 0, At, B0); PG8_BAR; PG8_SCHED;
            PG8_STAGE(PG8_SB(0, 1), b2 + hstepB, voffB);
            PG8_WAIT_V(6); PG8_BAR; PG8_MMA(1, 1, At, B1); PG8_BAR;
            PG8_LDB(B0, 1, 0); PG8_SCHED; PG8_LDA(At, 1, 0); PG8_STAGE(PG8_SA(0, 1), a2 + hstep, voffA);
            PG8_WAIT_L(8); PG8_BAR; PG8_WAIT_L(0); PG8_MMA(0, 0, At, B0); PG8_BAR; PG8_SCHED;
            PG8_LDB(B1, 1, 1); PG8_STAGE(PG8_SB(1, 0), b3, voffB);
            PG8_BAR; PG8_WAIT_L(0); PG8_MMA(0, 1, At, B1); PG8_BAR;
            PG8_LDA(At, 1, 1); PG8_STAGE(PG8_SA(1, 0), a3, voffA);
            PG8_BAR; PG8_WAIT_L(0); PG8_MMA(1, 0, At, B0); PG8_BAR; PG8_SCHED;
            PG8_STAGE(PG8_SB(1, 1), b3 + hstepB, voffB);
            PG8_WAIT_V(6); PG8_BAR; PG8_MMA(1, 1, At, B1); PG8_BAR;
            }
        }
        if constexpr (ALIGN_EPI) { if (wr == 0) PG8_BAR; }
        if constexpr (!Epi::AFTER_DRAIN) { E(acc, cur, wr, wc, fr, fq); S.done(cur); }
        if (!has_next) break;
#pragma unroll
        for (int a = 0; a < 2; ++a)
#pragma unroll
            for (int b = 0; b < 2; ++b)
#pragma unroll
                for (int m = 0; m < 4; ++m)
#pragma unroll
                    for (int n = 0; n < 2; ++n) acc[a][b][m][n] = (f32x4){0.f, 0.f, 0.f, 0.f};
        cur = nxt; cA = nA; cB = nB; ++ui;
        if constexpr (ALIGN_EPI) { if (wr == 1) PG8_BAR; }
    }
    PG8_WAIT_V(0);
    if constexpr (!ALIGN_EPI) { if (wr == 0) PG8_BAR; }
    PG8_BAR;
#undef PG8_SA
#undef PG8_SB
#undef PG8_STAGE
#undef PG8_LDA
#undef PG8_LDB
#undef PG8_MMA
#undef PG8_WAIT_V
#undef PG8_WAIT_L
#undef PG8_BAR
#undef PG8_SCHED
}

struct EpiStoreBf16 {
    static constexpr bool PERM = true, AFTER_DRAIN = false, PAIRMAP = false;
    bf16_t* O; int ldc;
    __device__ __forceinline__ void operator()(const f32x4 (&acc)[2][2][4][2], const Unit& u, int wr, int wc, int fr, int fq) const {
        const int row0 = u.pm * BM + wr * 64 + fr, col0 = u.pn * BM + wc * 32 + 8 * fq;
#pragma unroll
        for (int ai = 0; ai < 2; ++ai)
#pragma unroll
            for (int m = 0; m < 4; ++m) { bf16_t* rowp = O + (size_t)(row0 + ai * HALF + m * 16) * ldc + col0;
#pragma unroll
                for (int bj = 0; bj < 2; ++bj) { const f32x4 v0 = acc[ai][bj][m][0], v1 = acc[ai][bj][m][1];
                    u32x4 w; w.x = cvtpk(v0[0], v0[1]); w.y = cvtpk(v0[2], v0[3]); w.z = cvtpk(v1[0], v1[1]); w.w = cvtpk(v1[2], v1[3]);
                    __builtin_nontemporal_store(w, (u32x4*)(rowp + bj * HALF)); } }
    }
};
typedef _Float16 hf2 __attribute__((ext_vector_type(2)));
struct EpiZ {
    static constexpr bool PERM = true, AFTER_DRAIN = false, PAIRMAP = true;
    bf16_t* O; int ldc; const float* qn; const float* kn; const unsigned* cst;
    __device__ __forceinline__ void operator()(const f32x4 (&acc)[2][2][4][2], const Unit& u, int wr, int wc, int fr, int fq) const {
        asm volatile("" : "+v"(fr), "+v"(fq));
        const int row0 = u.pm * BM + wr * 64 + fr, col0 = u.pn * BM + wc * 64 + 8 * fq;
        const int kind = u.pn >> 1;
        if (kind == 0 || kind == 3) {
#pragma unroll
            for (int ai = 0; ai < 2; ++ai)
#pragma unroll
                for (int m = 0; m < 4; ++m) { bf16_t* rowp = O + (size_t)(row0 + ai * HALF + m * 16) * ldc + col0;
#pragma unroll
                    for (int bj = 0; bj < 2; ++bj) { const f32x4 v0 = acc[ai][bj][m][0], v1 = acc[ai][bj][m][1];
                        u32x4 w; w.x = cvtpk(v0[0], v0[1]); w.y = cvtpk(v0[2], v0[3]); w.z = cvtpk(v1[0], v1[1]); w.w = cvtpk(v1[2], v1[3]);
                        *(u32x4*)(rowp + bj * 32) = w; } }
            return;
        }
        const float* gn = kind == 1 ? qn : kn; const float osc = kind == 1 ? QSCALE : 1.0f;
        float g1[8], g2[8];
#pragma unroll
        for (int t = 0; t < 8; ++t) { g1[t] = gn[8 * fq + t] * osc; g2[t] = gn[32 + 8 * fq + t] * osc; }
        const unsigned* cp = cst + (size_t)row0 * 32 + 8 * fq;
        u32x4 ct0[2], ct1[2];
#pragma unroll
        for (int it = 0; it < 2; ++it) { const unsigned* np = cp + (size_t)(it * 16) * 32; ct0[it] = *(const u32x4*)np; ct1[it] = *(const u32x4*)(np + 4); }
        float ri[8];
#pragma unroll
        for (int it = 0; it < 8; ++it) { const int ai = it >> 2, m = it & 3; float ss = 0.f;
#pragma unroll
            for (int t = 0; t < 8; ++t) { const float a = acc[ai][0][m][t >> 2][t & 3], b = acc[ai][1][m][t >> 2][t & 3]; ss += a * a + b * b; }
            ri[it] = ss; }
#pragma unroll
        for (int it = 0; it < 8; ++it) ri[it] += __shfl_xor(ri[it], 16);
#pragma unroll
        for (int it = 0; it < 8; ++it) ri[it] += __shfl_xor(ri[it], 32);
#pragma unroll
        for (int it = 0; it < 8; ++it) ri[it] = rsqrtf(ri[it] * (1.0f / 64.0f) + EPS);
        __builtin_amdgcn_sched_barrier(0);
#pragma unroll
        for (int it = 0; it < 8; ++it) {
            const int ai = it >> 2, m = it & 3, row = row0 + ai * HALF + m * 16;
            const u32x4 c0 = ct0[it & 1], c1 = ct1[it & 1];
            if (it < 6) { const unsigned* np = cp + (size_t)((((it + 2) >> 2) * HALF) + ((it + 2) & 3) * 16) * 32; ct0[it & 1] = *(const u32x4*)np; ct1[it & 1] = *(const u32x4*)(np + 4); }
            const unsigned cw[8] = {c0.x, c0.y, c0.z, c0.w, c1.x, c1.y, c1.z, c1.w};
            float o1[8], o2[8];
#pragma unroll
            for (int t = 0; t < 8; ++t) {
                const hf2 cs2 = __builtin_bit_cast(hf2, cw[t]); const float cs = (float)cs2[0], sn = (float)cs2[1];
                const float x1 = acc[ai][0][m][t >> 2][t & 3] * (ri[it] * g1[t]), x2 = acc[ai][1][m][t >> 2][t & 3] * (ri[it] * g2[t]);
                o1[t] = x1 * cs - x2 * sn; o2[t] = x2 * cs + x1 * sn;
            }
            bf16_t* rowp = O + (size_t)row * ldc + col0;
            *(u32x4*)rowp = (u32x4){cvtpk(o1[0], o1[1]), cvtpk(o1[2], o1[3]), cvtpk(o1[4], o1[5]), cvtpk(o1[6], o1[7])};
            *(u32x4*)(rowp + 32) = (u32x4){cvtpk(o2[0], o2[1]), cvtpk(o2[2], o2[3]), cvtpk(o2[4], o2[5]), cvtpk(o2[6], o2[7])};
            __builtin_amdgcn_sched_barrier(0);
        }
    }
};
struct EpiScores {
    static constexpr bool PERM = true, AFTER_DRAIN = false, PAIRMAP = false;
    _Float16* O; int ldc; const float* rowss;
    __device__ __forceinline__ void operator()(const f32x4 (&acc)[2][2][4][2], const Unit& u, int wr, int wc, int fr, int fq) const {
        const int row0 = u.pm * BM + wr * 64 + fr, col0 = u.pn * BM + wc * 32 + 8 * fq;
#pragma unroll
        for (int ai = 0; ai < 2; ++ai)
#pragma unroll
            for (int m = 0; m < 4; ++m) { const int row = row0 + ai * HALF + m * 16; const float ri = rsqrtf(rowss[row] * (1.0f / 1024.0f) + EPS);
                _Float16* rowp = O + (size_t)row * ldc + col0;
#pragma unroll
                for (int bj = 0; bj < 2; ++bj) { const f32x4 v0 = acc[ai][bj][m][0] * ri, v1 = acc[ai][bj][m][1] * ri;
                    f16x8 w = {(_Float16)v0[0], (_Float16)v0[1], (_Float16)v0[2], (_Float16)v0[3], (_Float16)v1[0], (_Float16)v1[1], (_Float16)v1[2], (_Float16)v1[3]};
                    *(f16x8*)(rowp + bj * HALF) = w; } }
    }
};
struct EpiWo {
    static constexpr bool PERM = true, AFTER_DRAIN = false, PAIRMAP = false;
    const float* XS; bf16_t* HB; float* rowss;
    __device__ __forceinline__ void operator()(const f32x4 (&acc)[2][2][4][2], const Unit& u, int wr, int wc, int fr, int fq) const {
        const int row0 = u.pm * BM + wr * 64 + fr, col0 = u.pn * BM + wc * 32 + 8 * fq;
#pragma unroll
        for (int ai = 0; ai < 2; ++ai)
#pragma unroll
            for (int m = 0; m < 4; ++m) { const int row = row0 + ai * HALF + m * 16; const size_t off = (size_t)row * DM + col0; float ss = 0.f; const float xs = XS[row];
#pragma unroll
                for (int bj = 0; bj < 2; ++bj) { const size_t o2 = off + bj * HALF; const u32x4 xw = *(const u32x4*)(HB + o2);
                    const f32x4 h0 = (f32x4){bflo(xw.x), bfhi(xw.x), bflo(xw.y), bfhi(xw.y)} * xs + acc[ai][bj][m][0], h1 = (f32x4){bflo(xw.z), bfhi(xw.z), bflo(xw.w), bfhi(xw.w)} * xs + acc[ai][bj][m][1];
                    *(u32x4*)(HB + o2) = (u32x4){cvtpk(h0[0], h0[1]), cvtpk(h0[2], h0[3]), cvtpk(h1[0], h1[1]), cvtpk(h1[2], h1[3])};
                    ss += ((h0[0] * h0[0] + h0[1] * h0[1]) + (h0[2] * h0[2] + h0[3] * h0[3])) + ((h1[0] * h1[0] + h1[1] * h1[1]) + (h1[2] * h1[2] + h1[3] * h1[3])); }
                ss += __shfl_xor(ss, 16); ss += __shfl_xor(ss, 32);
                if (fq == 0) atomicAdd(rowss + row, ss); }
    }
};
#define SIGM(a) __builtin_amdgcn_rcpf(1.0f + __builtin_amdgcn_exp2f(-1.4426950408889634f * (a)))
struct EpiGate {
    static constexpr bool PERM = true, AFTER_DRAIN = false, PAIRMAP = false;
    float* HO; const bf16_t* HB; const bf16_t* PP; const float* rinv;
    __device__ __forceinline__ void operator()(const f32x4 (&acc)[2][2][4][2], const Unit& u, int wr, int wc, int fr, int fq) const {
        const int row0 = u.pm * BM + wr * 64 + fr, col0 = u.pn * BM + wc * 32 + 8 * fq;
#pragma unroll
        for (int ai = 0; ai < 2; ++ai)
#pragma unroll
            for (int m = 0; m < 4; ++m) { const int row = row0 + ai * HALF + m * 16; const size_t off = (size_t)row * DM + col0; const float ri = rinv[row];
#pragma unroll
                for (int bj = 0; bj < 2; ++bj) { const size_t o2 = off + bj * HALF; const u32x4 hw = *(const u32x4*)(HB + o2), pw = __builtin_nontemporal_load((const u32x4*)(PP + o2));
                    const f32x4 a0 = acc[ai][bj][m][0] * ri, a1 = acc[ai][bj][m][1] * ri; f32x4 o0, o1;
                    o0[0] = bflo(hw.x) + bflo(pw.x) * SIGM(a0[0]); o0[1] = bfhi(hw.x) + bfhi(pw.x) * SIGM(a0[1]);
                    o0[2] = bflo(hw.y) + bflo(pw.y) * SIGM(a0[2]); o0[3] = bfhi(hw.y) + bfhi(pw.y) * SIGM(a0[3]);
                    o1[0] = bflo(hw.z) + bflo(pw.z) * SIGM(a1[0]); o1[1] = bfhi(hw.z) + bfhi(pw.z) * SIGM(a1[1]);
                    o1[2] = bflo(hw.w) + bflo(pw.w) * SIGM(a1[2]); o1[3] = bfhi(hw.w) + bfhi(pw.w) * SIGM(a1[3]);
                    __builtin_nontemporal_store(o0, (f32x4*)(HO + o2)); __builtin_nontemporal_store(o1, (f32x4*)(HO + o2 + 4)); } }
    }
};
}

#define XB_TMO      128
#define XB_XCNT(j)  (256  + 64 * (j))
#define XB_XSUB(j)  (1280 + 64 * (j))
#define XB_XGEN(j)  (2304 + 64 * (j))
#define XB_TOP      3328
#define XB_TOPGEN   3392
#define XCD_BAR_WORDS 3456
#define XB_SPIN_CAP (1u << 18)
__device__ __forceinline__ unsigned xb_ld(unsigned* p)              { return __hip_atomic_load(p, __ATOMIC_RELAXED, __HIP_MEMORY_SCOPE_AGENT); }
__device__ __forceinline__ unsigned xb_add(unsigned* p, unsigned v) { return __hip_atomic_fetch_add(p, v, __ATOMIC_RELAXED, __HIP_MEMORY_SCOPE_AGENT); }
__device__ __forceinline__ unsigned xb_xcc_id() { return (unsigned)__builtin_amdgcn_s_getreg((3 << 11) | 20) & 0xFu; }
#define XB_SPIN(cond, bar) do { unsigned _sp = 0; while (cond) { __builtin_amdgcn_s_sleep(1); \
    if ((++_sp & 255u) == 0u) { if (xb_ld(&(bar)[XB_TMO])) break; if (_sp > XB_SPIN_CAP) { atomicAdd(&(bar)[XB_TMO], 1u); break; } } } } while (0)
struct XcdBarrier { unsigned* bar; unsigned x; volatile LAS unsigned* st; };
__device__ __forceinline__ XcdBarrier xcd_barrier_post(unsigned* bar, volatile LAS unsigned* st) {
    XcdBarrier b; b.bar = bar; b.x = xb_xcc_id(); b.st = st;
    if (threadIdx.x == 0) (void)xb_add(&bar[XB_XCNT(b.x)], 1u);
    return b;
}
__device__ __forceinline__ void xcd_barrier_complete(unsigned* bar, unsigned x, unsigned& nloc, unsigned& nx) {
    const unsigned G = gridDim.x * gridDim.y * gridDim.z;
    unsigned sum, cnt, mine, sp = 0u;
    for (;;) {
        sum = 0u; cnt = 0u; mine = 0u;
#pragma unroll
        for (unsigned j = 0; j < 16; ++j) { const unsigned c = xb_ld(&bar[XB_XCNT(j)]); sum += c; cnt += (c > 0u) ? 1u : 0u; mine = (j == x) ? c : mine; }
        if (sum == G) break;
        __builtin_amdgcn_s_sleep(1);
        if ((++sp & 255u) == 0u) { if (xb_ld(&bar[XB_TMO])) break; if (sp > XB_SPIN_CAP) { atomicAdd(&bar[XB_TMO], 1u); break; } }
    }
    nloc = mine > 0u ? mine : 1u; nx = cnt > 0u ? cnt : 1u;
}
__device__ __forceinline__ void xcd_barrier(const XcdBarrier& b) {
    asm volatile("s_waitcnt vmcnt(0)" ::: "memory");
    __syncthreads();
    if (threadIdx.x == 0) {
        unsigned* bar = b.bar;
        __builtin_amdgcn_s_waitcnt(0);
        unsigned nloc = b.st[0], nx = b.st[1];
        if (nloc == 0u) { xcd_barrier_complete(bar, b.x, nloc, nx); b.st[0] = nloc; b.st[1] = nx; }
        const unsigned old = xb_add(&bar[XB_XSUB(b.x)], 1u);
        const unsigned gen = old / nloc;
        if (old + 1u == (gen + 1u) * nloc) {
            __builtin_amdgcn_fence(__ATOMIC_RELEASE, "agent");
            asm volatile("s_waitcnt vmcnt(0)" ::: "memory");
            const unsigned og = xb_add(&bar[XB_TOP], 1u);
            const unsigned tg = og / nx;
            if (og + 1u == (tg + 1u) * nx) xb_add(&bar[XB_TOPGEN], 1u);
            else XB_SPIN(xb_ld(&bar[XB_TOPGEN]) == tg, bar);
            __builtin_amdgcn_fence(__ATOMIC_ACQUIRE, "agent");
            xb_add(&bar[XB_XGEN(b.x)], 1u);
            asm volatile("s_waitcnt vmcnt(0)" ::: "memory");
        } else {
            XB_SPIN(xb_ld(&bar[XB_XGEN(b.x)]) == gen, bar);
            __builtin_amdgcn_fence(__ATOMIC_ACQUIRE, "agent");
            asm volatile("s_waitcnt vmcnt(0)" ::: "memory");
        }
    }
    __syncthreads();
}

struct Params { const float* in[23]; float* out; unsigned char* ws; int ph_lo, ph_hi; };
enum { I_X = 0, I_P, I_POS, I_LNMIX, I_WIN, I_POOLW, I_POOLS, I_QN, I_KN, I_LQ1, I_LK1, I_LQ2, I_LK2, I_SUBLN, I_WO, I_LNFFN, I_WPQ, I_SUBK, I_PU, I_PV, I_LNPE, I_WG, I_WPP };

struct Ctx {
    LAS unsigned char* lds; int tid, lane, wave, G, vcu;
    const Params* p;
};

__device__ __forceinline__ void transpose_item(const float* W, int ldw, int coff, const float* gain, bf16_t* WT, int ldk, int roff, int nblk, LAS float* scr, int item, int lane) {
    const int kb = item / nblk, nb = item % nblk, k0 = 64 * kb, n0 = 32 * nb;
#pragma unroll 8
    for (int i = 0; i < 32; ++i) { const int kk = 2 * i + (lane >> 5); const float gsc = gain ? gain[k0 + kk] : 1.0f; scr[kk * 33 + (lane & 31)] = W[(size_t)(k0 + kk) * ldw + coff + n0 + (lane & 31)] * gsc; }
    asm volatile("s_waitcnt lgkmcnt(0)" ::: "memory");
    const int c = lane & 7;
#pragma unroll
    for (int j = 0; j < 4; ++j) { const int n = (lane >> 3) + 8 * j; const LAS float* s = scr + (8 * c) * 33 + n;
        u32x4 o; o.x = cvtpk(s[0 * 33], s[1 * 33]); o.y = cvtpk(s[2 * 33], s[3 * 33]); o.z = cvtpk(s[4 * 33], s[5 * 33]); o.w = cvtpk(s[6 * 33], s[7 * 33]);
        *(u32x4*)(WT + (size_t)(roff + n0 + n) * ldk + k0 + 8 * c) = o; }
    asm volatile("s_waitcnt lgkmcnt(0)" ::: "memory");
}

template <int ROWS, bool POOL> __device__ __forceinline__ void fold_items(const Ctx& C) {
    const Params& P = *C.p; unsigned char* ws = P.ws; const int tid = C.tid;
    bf16_t* WinT = (bf16_t*)(ws + WS_WIN); bf16_t* WsT = (bf16_t*)(ws + WS_WS);
    constexpr int KT = 1024 / ROWS, NIT = (POOL ? 4 : 16) * KT, RPT = ROWS / 4;
    LAS float* As = (LAS float*)C.lds;
    LAS float* Bs = (LAS float*)(C.lds + 32768);
    for (int it = blockIdx.x; it < NIT; it += C.G) {
        const int blk = it / KT, k0 = (it % KT) * ROWS;
        const float* Asrc = (POOL ? P.in[I_WIN] : P.in[I_WPQ]) + blk * 128;
        const float* Bsrc = (POOL ? P.in[I_POOLW] : P.in[I_SUBK]) + (size_t)blk * 128 * 128;
#pragma unroll
        for (int i = 0; i < ROWS / 16; ++i) { const int v = tid + 512 * i, r = v >> 5, c4 = v & 31; *(LAS f32x4*)(As + r * 128 + c4 * 4) = *(const f32x4*)(Asrc + (size_t)(k0 + r) * 2048 + c4 * 4); }
        { f32x4 bv[8];
#pragma unroll
          for (int i = 0; i < 8; ++i) bv[i] = *(const f32x4*)(Bsrc + 4 * (tid + 512 * i));
#pragma unroll
          for (int i = 0; i < 8; ++i) { const int idx = 4 * (tid + 512 * i), r = idx >> 7, c = idx & 127;
#pragma unroll
              for (int q = 0; q < 4; ++q) { if (POOL) Bs[r * 129 + c + q] = bv[i][q]; else Bs[(c + q) * 129 + r] = bv[i][q]; } } }
        __syncthreads();
        const int n = tid & 127, kg = tid >> 7;
        float acc[RPT];
#pragma unroll
        for (int i = 0; i < RPT; ++i) acc[i] = 0.f;
        for (int c = 0; c < 128; c += 4) {
            const float b0 = Bs[(c + 0) * 129 + n], b1 = Bs[(c + 1) * 129 + n], b2 = Bs[(c + 2) * 129 + n], b3 = Bs[(c + 3) * 129 + n];
#pragma unroll
            for (int i = 0; i < RPT; ++i) { const f32x4 a = *(const LAS f32x4*)(As + (kg * RPT + i) * 128 + c); acc[i] += a[0] * b0 + a[1] * b1 + a[2] * b2 + a[3] * b3; }
        }
        const float cs = POOL ? P.in[I_POOLS][blk * 128 + n] : 1.0f; const float* gain = POOL ? P.in[I_LNMIX] : P.in[I_LNFFN];
        bf16_t* dst = (POOL ? WinT : WsT) + (size_t)(blk * 128 + n) * 1024 + k0 + kg * RPT;
        float v[RPT];
#pragma unroll
        for (int i = 0; i < RPT; ++i) v[i] = acc[i] * cs * gain[k0 + kg * RPT + i];
#pragma unroll
        for (int i = 0; i < RPT; i += 4) *(u32x2*)(dst + i) = (u32x2){cvtpk(v[i], v[i + 1]), cvtpk(v[i + 2], v[i + 3])};
        __syncthreads();
    }
}

__device__ __forceinline__ void phase_prep(const Ctx& C) {
    const Params& P = *C.p; unsigned char* ws = P.ws; const int tid = C.tid, lane = C.lane;
    bf16_t* WinT = (bf16_t*)(ws + WS_WIN); bf16_t* WoT = (bf16_t*)(ws + WS_WO); bf16_t* WsT = (bf16_t*)(ws + WS_WS); bf16_t* WgT = (bf16_t*)(ws + WS_WG); bf16_t* WpT = (bf16_t*)(ws + WS_WP);
    fold_items<16, true>(C);
    {
        LAS float* scr = (LAS float*)(C.lds + C.wave * 8448);
        const int gw = C.vcu * 8 + C.wave, NGW = C.G * 8;
        constexpr int I1 = 16 * 48, I2 = 16 * 32, I3 = 16 * 32, I4 = 4 * 32;
        for (int it = gw; it < I1 + I2 + I3 + I4; it += NGW) {
            int r = it;
            if (r < I1) { transpose_item(P.in[I_WIN], 2048, 512, P.in[I_LNMIX], WinT, 1024, 512, 48, scr, r, lane); continue; } r -= I1;
            if (r < I2) { transpose_item(P.in[I_WO], 1024, 0, nullptr, WoT, 1024, 0, 32, scr, r, lane); continue; } r -= I2;
            if (r < I3) { transpose_item(P.in[I_WG], 1024, 0, P.in[I_LNPE], WgT, 1024, 0, 32, scr, r, lane); continue; } r -= I3;
            transpose_item(P.in[I_WPP], 1024, 0, nullptr, WpT, 256, 0, 32, scr, r, lane);
        }
        bf16_t* XB = (bf16_t*)(ws + WS_ACTB);
        for (int m0 = gw; m0 < M_TOK; m0 += 4 * NGW) {
            f32x4 v[4][4]; float s[4];
#pragma unroll
            for (int q = 0; q < 4; ++q) { const int m = m0 + q * NGW; const f32x4* xr = (const f32x4*)(P.in[I_X] + (size_t)(m < M_TOK ? m : m0) * DM) + lane;
#pragma unroll
                for (int j = 0; j < 4; ++j) v[q][j] = __builtin_nontemporal_load(xr + 64 * j); }
#pragma unroll
            for (int q = 0; q < 4; ++q) { s[q] = 0.f;
#pragma unroll
                for (int j = 0; j < 4; ++j) s[q] += (v[q][j][0] * v[q][j][0] + v[q][j][1] * v[q][j][1]) + (v[q][j][2] * v[q][j][2] + v[q][j][3] * v[q][j][3]); }
#pragma unroll
            for (int q = 0; q < 4; ++q) { const int m = m0 + q * NGW; if (m >= M_TOK) break;
                const float ri = rsqrtf(wave_sum(s[q]) * (1.0f / DM) + EPS);
                if (lane == 0) ((float*)(ws + WS_RINV3 + 512 * 1024))[m] = 1.0f / ri;
                u32x2* o = (u32x2*)(XB + (size_t)m * DM) + lane;
#pragma unroll
                for (int j = 0; j < 4; ++j) { u32x2 w; w.x = cvtpk(v[q][j][0] * ri, v[q][j][1] * ri); w.y = cvtpk(v[q][j][2] * ri, v[q][j][3] * ri); o[64 * j] = w; } }
        }
    }
    {
        const size_t gt = (size_t)C.vcu * 512 + tid, NT = (size_t)C.G * 512;
        { const float* s = P.in[I_P]; bf16_t* d = (bf16_t*)(ws + WS_PB); const size_t n = (size_t)M_TOK * DPLE / 8;
          for (size_t i0 = gt; i0 < n; i0 += 4 * NT) { f32x4 v0[4], v1[4];
#pragma unroll
              for (int q = 0; q < 4; ++q) { const size_t i = i0 + q * NT < n ? i0 + q * NT : i0; v0[q] = __builtin_nontemporal_load((const f32x4*)(s + i * 8)); v1[q] = __builtin_nontemporal_load((const f32x4*)(s + i * 8 + 4)); }
#pragma unroll
              for (int q = 0; q < 4; ++q) { const size_t i = i0 + q * NT; if (i >= n) break;
                  u32x4 w; w.x = cvtpk(v0[q][0], v0[q][1]); w.y = cvtpk(v0[q][2], v0[q][3]); w.z = cvtpk(v1[q][0], v1[q][1]); w.w = cvtpk(v1[q][2], v1[q][3]); *(u32x4*)(d + i * 8) = w; } } }
        { const float* s = P.in[I_PV]; unsigned char* d = ws + WS_UT; const size_t n = (size_t)16384 * 1024 / 16;
          for (size_t i0 = gt; i0 < n; i0 += 2 * NT) { f32x4 v[2][4];
#pragma unroll
              for (int q = 0; q < 2; ++q) { const size_t i = i0 + q * NT < n ? i0 + q * NT : i0;
#pragma unroll
                  for (int c = 0; c < 4; ++c) v[q][c] = __builtin_nontemporal_load((const f32x4*)(s + i * 16 + 4 * c)) * V4SCALE; }
#pragma unroll
              for (int q = 0; q < 2; ++q) { const size_t i = i0 + q * NT; if (i >= n) break; u32x2 o;
#pragma unroll
                  for (int c = 0; c < 2; ++c) { unsigned w = 0;
                      w = __builtin_amdgcn_cvt_scalef32_pk_fp4_f32(w, v[q][2 * c][0], v[q][2 * c][1], 1.0f, 0); w = __builtin_amdgcn_cvt_scalef32_pk_fp4_f32(w, v[q][2 * c][2], v[q][2 * c][3], 1.0f, 1);
                      w = __builtin_amdgcn_cvt_scalef32_pk_fp4_f32(w, v[q][2 * c + 1][0], v[q][2 * c + 1][1], 1.0f, 2); w = __builtin_amdgcn_cvt_scalef32_pk_fp4_f32(w, v[q][2 * c + 1][2], v[q][2 * c + 1][3], 1.0f, 3); o[c] = w; }
                  __builtin_nontemporal_store(o, (u32x2*)(d + (i >> 6) * 1024 + 512 + (i & 63) * 8)); } } }
        { const int* pos = (const int*)P.in[I_POS]; unsigned* cst = (unsigned*)(ws + WS_CST);
          for (size_t i = gt; i < (size_t)M_TOK * 4; i += NT) { const int m = (int)(i >> 2), a = (int)(i & 3); const float fp = (float)pos[m]; unsigned w[8];
#pragma unroll
              for (int t = 0; t < 8; ++t) { const float invf = exp2f(-(float)(2 * (8 * a + t)) * (13.287712379549449f / 64.0f)); float tr = fp * invf * 0.15915494309189535f; tr = tr - floorf(tr);
                  const pg8::hf2 cs = {(_Float16)__builtin_amdgcn_cosf(tr), (_Float16)__builtin_amdgcn_sinf(tr)}; w[t] = __builtin_bit_cast(unsigned, cs); }
              *(u32x4*)(cst + i * 8) = (u32x4){w[0], w[1], w[2], w[3]}; *(u32x4*)(cst + i * 8 + 4) = (u32x4){w[4], w[5], w[6], w[7]}; } }
        { const float* s = P.in[I_PU]; unsigned char* d = ws + WS_UT; const size_t n = (size_t)16384 * 1024 / 16; const float* gn = P.in[I_LNFFN];
          for (size_t i0 = gt; i0 < n; i0 += 2 * NT) { f32x4 v[2][4];
#pragma unroll
              for (int q = 0; q < 2; ++q) { const size_t i = i0 + q * NT < n ? i0 + q * NT : i0;
#pragma unroll
                  for (int c = 0; c < 4; ++c) v[q][c] = __builtin_nontemporal_load((const f32x4*)(s + i * 16 + 4 * c)) * *(const f32x4*)(gn + (i & 63) * 16 + 4 * c) * U4SCALE; }
#pragma unroll
              for (int q = 0; q < 2; ++q) { const size_t i = i0 + q * NT; if (i >= n) break; u32x2 o;
#pragma unroll
                  for (int c = 0; c < 2; ++c) { unsigned w = 0;
                      w = __builtin_amdgcn_cvt_scalef32_pk_fp4_f32(w, v[q][2 * c][0], v[q][2 * c][1], 1.0f, 0); w = __builtin_amdgcn_cvt_scalef32_pk_fp4_f32(w, v[q][2 * c][2], v[q][2 * c][3], 1.0f, 1);
                      w = __builtin_amdgcn_cvt_scalef32_pk_fp4_f32(w, v[q][2 * c + 1][0], v[q][2 * c + 1][1], 1.0f, 2); w = __builtin_amdgcn_cvt_scalef32_pk_fp4_f32(w, v[q][2 * c + 1][2], v[q][2 * c + 1][3], 1.0f, 3); o[c] = w; }
                  __builtin_nontemporal_store(o, (u32x2*)(d + (i >> 6) * 1024 + (i & 63) * 8)); } } }
    }
}

__device__ __forceinline__ void phase_rope_pool(const Ctx& C) {
    fold_items<64, false>(C);
    const Params& P = *C.p; unsigned char* ws = P.ws; const int lane = C.lane;
    bf16_t* Z = (bf16_t*)(ws + WS_Z); bf16_t* Y = (bf16_t*)(ws + WS_YCAT);
    const int gw = C.vcu * 8 + C.wave, NGW = C.G * 8;
    constexpr int RP_ROWS = 16;
    const int w = 2 << (lane >> 4);
    for (int mb = gw * RP_ROWS; mb < M_TOK; mb += NGW * RP_ROWS) {
        const int s0 = mb & (SEQ - 1);
        const bf16_t* zp0 = Z + (size_t)mb * ZLD + 8 * lane;
        float acc[8];
#pragma unroll
        for (int i = 0; i < 8; ++i) acc[i] = 0.f;
        { u32x4 pv[15];
#pragma unroll
          for (int i = 1; i < 16; ++i) pv[i - 1] = (i < w && s0 - i >= 0) ? *(const u32x4*)(zp0 - (size_t)i * ZLD) : (u32x4){0u, 0u, 0u, 0u};
#pragma unroll
          for (int i = 0; i < 15; ++i) { acc[0] += bflo(pv[i].x); acc[1] += bfhi(pv[i].x); acc[2] += bflo(pv[i].y); acc[3] += bfhi(pv[i].y); acc[4] += bflo(pv[i].z); acc[5] += bfhi(pv[i].z); acc[6] += bflo(pv[i].w); acc[7] += bfhi(pv[i].w); } }
#pragma unroll 1
        for (int r4 = 0; r4 < RP_ROWS; r4 += 4) {
            u32x4 cv[4], ov[4];
#pragma unroll
            for (int q = 0; q < 4; ++q) { const int r = r4 + q; cv[q] = *(const u32x4*)(zp0 + (size_t)r * ZLD);
                ov[q] = (s0 + r - w + 1 >= 0) ? *(const u32x4*)(zp0 + ((long)r - w + 1) * ZLD) : (u32x4){0u, 0u, 0u, 0u}; }
#pragma unroll
            for (int q = 0; q < 4; ++q) { const int r = r4 + q, s = s0 + r;
                const float c[8] = {bflo(cv[q].x), bfhi(cv[q].x), bflo(cv[q].y), bfhi(cv[q].y), bflo(cv[q].z), bfhi(cv[q].z), bflo(cv[q].w), bfhi(cv[q].w)};
                const float od[8] = {bflo(ov[q].x), bfhi(ov[q].x), bflo(ov[q].y), bfhi(ov[q].y), bflo(ov[q].z), bfhi(ov[q].z), bflo(ov[q].w), bfhi(ov[q].w)};
                const float rc = __builtin_amdgcn_rcpf((float)((s + 1) < w ? (s + 1) : w));
                float ov8[8];
#pragma unroll
                for (int i = 0; i < 8; ++i) { acc[i] += c[i]; ov8[i] = acc[i] * rc - c[i]; acc[i] -= od[i]; }
                u32x4 o; o.x = cvtpk(ov8[0], ov8[1]); o.y = cvtpk(ov8[2], ov8[3]); o.z = cvtpk(ov8[4], ov8[5]); o.w = cvtpk(ov8[6], ov8[7]);
                *(u32x4*)(Y + (size_t)(mb + r) * DM + 8 * lane) = o; }
        }
    }
}

namespace att {
constexpr int SLOT = 32768, KB = 8192;
typedef short v4i16_t __attribute__((ext_vector_type(4)));
__device__ __forceinline__ int crow(int r, int hi) { return (r & 3) + 8 * (r >> 2) + 4 * hi; }
__device__ __forceinline__ s16x4 vtr(const LAS unsigned char* p) { return __builtin_bit_cast(s16x4, __builtin_amdgcn_ds_read_tr16_b64_v4i16((LAS v4i16_t*)p)); }
__device__ __forceinline__ void glds16(const void* gsrc, unsigned lds_dst) { unsigned keep;
    asm volatile("s_mov_b32 %0, m0\n\ts_mov_b32 m0, %2\n\ts_nop 0\n\tglobal_load_lds_dwordx4 %1, off\n\ts_mov_b32 m0, %0" : "=&s"(keep) : "v"(gsrc), "s"(lds_dst) : "memory"); }
__device__ __forceinline__ void glds16_sc(const void* gsrc, unsigned lds_dst) { unsigned keep;
    asm volatile("s_mov_b32 %0, m0\n\ts_mov_b32 m0, %2\n\ts_nop 0\n\tglobal_load_lds_dwordx4 %1, off sc0 sc1\n\ts_mov_b32 m0, %0" : "=&s"(keep) : "v"(gsrc), "s"(lds_dst) : "memory"); }
__device__ __forceinline__ float swapadd(float v) { auto rr = __builtin_amdgcn_permlane32_swap(__float_as_uint(v), __float_as_uint(v), false, false); return __uint_as_float(rr[0]) + __uint_as_float(rr[1]); }
__device__ __forceinline__ float swapmax(float v) { auto rr = __builtin_amdgcn_permlane32_swap(__float_as_uint(v), __float_as_uint(v), false, false); return fmaxf(__uint_as_float(rr[0]), __uint_as_float(rr[1])); }

template <bool BOUNDED> __device__ __forceinline__ void attn_unit(int b, int h, int qb, const bf16_t* Z, bf16_t* Y, const float* subln, float lam, LAS unsigned char* lds) {
    const int tid = threadIdx.x, lane = tid & 63, r32 = lane & 31, hi = lane >> 5; const int wid = __builtin_amdgcn_readfirstlane(tid >> 6);
    const int m = wid >> 2, wq = wid & 3;
    const size_t rowbase = (size_t)b * SEQ; const int q0 = qb * 128, NT = 2 * qb + 2;
    const int qabs = q0 + wq * 32 + r32;
    bf16x8 qr[4];
    { const bf16_t* Qw = Z + (rowbase + qabs) * ZLD + 512 + h * 128 + m * 64;
#pragma unroll
      for (int d0 = 0; d0 < 4; ++d0) qr[d0] = __builtin_nontemporal_load((const bf16x8*)(Qw + d0 * 16 + hi * 8)); }
    const bf16_t* Zbh = Z + rowbase * ZLD + h * 128;
    unsigned kog[2], vog[2];
#pragma unroll
    for (int j = 0; j < 2; ++j) { const unsigned r = 8u * wid + 4u * j + (lane >> 4), cp = lane & 15;
        kog[j] = r * ZLD + 1024u + 8u * (cp ^ (r & 15u)); vog[j] = r * ZLD + 1536u + 8u * (cp ^ (((r & 3u) << 2) | ((r >> 2) & 3u))); }
    const unsigned wbase = (unsigned)wid * 2048u;
    const unsigned lds0 = (unsigned)(uintptr_t)lds;
#define ATT_DMA(t, slot) do { const bf16_t* zt_ = Zbh + (size_t)(t) * 64 * ZLD; const unsigned d_ = (unsigned)__builtin_amdgcn_readfirstlane(lds0 + (slot) + wbase); \
        glds16(zt_ + kog[0], d_); glds16(zt_ + kog[1], d_ + 1024); glds16(zt_ + vog[0], d_ + 2 * KB); glds16(zt_ + vog[1], d_ + 2 * KB + 1024); } while (0)
    f32x16 o[4];
#pragma unroll
    for (int d = 0; d < 4; ++d)
#pragma unroll
        for (int r = 0; r < 16; ++r) o[d][r] = 0.f;
    float mref = -1e30f, lsum = 0.f;
    int koffs[4], voffs[4][2];
#pragma unroll
    for (int d0 = 0; d0 < 4; ++d0) koffs[d0] = r32 * 256 + (((m * 8 + 2 * d0 + hi) ^ (r32 & 15)) * 16);
    { const int L2 = (lane >> 2) & 3, a = (lane >> 4) & 1, bb = (lane & 3) >> 1;
#pragma unroll
      for (int d = 0; d < 4; ++d)
#pragma unroll
          for (int h2 = 0; h2 < 2; ++h2) voffs[d][h2] = 2 * KB + 256 * (8 * h2 + 4 * hi + L2) + 16 * ((((d ^ L2) & 3) << 2) | (((2 * a + bb) ^ (2 * h2 + hi)) & 3)) + 8 * (lane & 1); }
    ATT_DMA(0, 0); ATT_DMA(1, SLOT);
    asm volatile("s_waitcnt vmcnt(4)" ::: "memory");
    __syncthreads();
    int slot = 0, slot2 = 2 * SLOT;
    for (int t = 0; t < NT; ++t) {
        if (t + 2 < NT) ATT_DMA(t + 2, slot2);
        const bool band = t >= NT - 2;
        bf16x8 kf[8];
        { const LAS unsigned char* kb = lds + slot;
#pragma unroll
          for (int d0 = 0; d0 < 4; ++d0) { kf[2 * d0] = *(const LAS bf16x8*)(kb + koffs[d0]); kf[2 * d0 + 1] = *(const LAS bf16x8*)(kb + koffs[d0] + 8192); } }
        __builtin_amdgcn_sched_barrier(0);
        f32x16 p0, p1;
#pragma unroll
        for (int r = 0; r < 16; ++r) { p0[r] = 0.f; p1[r] = 0.f; }
#pragma unroll
        for (int d0 = 0; d0 < 4; ++d0) { p0 = __builtin_amdgcn_mfma_f32_32x32x16_bf16(kf[2 * d0], qr[d0], p0, 0, 0, 0); p1 = __builtin_amdgcn_mfma_f32_32x32x16_bf16(kf[2 * d0 + 1], qr[d0], p1, 0, 0, 0); }
        const LAS unsigned char* vb = lds + slot;
        s16x4 loA[8], hhA[8], loB[8], hhB[8];
#pragma unroll
        for (int i = 0; i < 8; ++i) { const int d = (i >> 2), ks = i & 3; loA[i] = vtr(vb + voffs[d][0] + ks * 4096); hhA[i] = vtr(vb + voffs[d][1] + ks * 4096); }
        __builtin_amdgcn_sched_barrier(0);
        if (band) {
            const int kb0 = 64 * t + 4 * hi;
#pragma unroll
            for (int r = 0; r < 16; ++r) { const int kv = kb0 + (r & 3) + 8 * (r >> 2); if (kv > qabs) p0[r] = -INFINITY; if (kv + 32 > qabs) p1[r] = -INFINITY; }
        }
        float ls = 0.f;
        if constexpr (BOUNDED) {
#pragma unroll
            for (int r = 0; r < 16; ++r) { p0[r] = __builtin_amdgcn_exp2f(p0[r]); p1[r] = __builtin_amdgcn_exp2f(p1[r]); ls += p0[r] + p1[r]; }
        } else {
            float rm = fmaxf(p0[0], p1[0]);
#pragma unroll
            for (int r = 1; r < 16; ++r) rm = fmaxf(rm, fmaxf(p0[r], p1[r]));
            rm = swapmax(rm);
            if (__any(rm - mref > 8.0f)) {
                const float mn = fmaxf(mref, rm), al = exp2f(mref - mn);
                mref = mn; lsum *= al;
#pragma unroll
                for (int d = 0; d < 4; ++d)
#pragma unroll
                    for (int r = 0; r < 16; ++r) o[d][r] *= al;
            }
#pragma unroll
            for (int r = 0; r < 16; ++r) { p0[r] = __builtin_amdgcn_exp2f(p0[r] - mref); p1[r] = __builtin_amdgcn_exp2f(p1[r] - mref); ls += p0[r] + p1[r]; }
        }
        lsum += ls;
        u32x4 pw[4];
        pw[0] = (u32x4){cvtpk(p0[0], p0[1]), cvtpk(p0[2], p0[3]), cvtpk(p0[4], p0[5]), cvtpk(p0[6], p0[7])};
        pw[1] = (u32x4){cvtpk(p0[8], p0[9]), cvtpk(p0[10], p0[11]), cvtpk(p0[12], p0[13]), cvtpk(p0[14], p0[15])};
        pw[2] = (u32x4){cvtpk(p1[0], p1[1]), cvtpk(p1[2], p1[3]), cvtpk(p1[4], p1[5]), cvtpk(p1[6], p1[7])};
        pw[3] = (u32x4){cvtpk(p1[8], p1[9]), cvtpk(p1[10], p1[11]), cvtpk(p1[12], p1[13]), cvtpk(p1[14], p1[15])};
        __builtin_amdgcn_sched_barrier(0);
#pragma unroll
        for (int i = 0; i < 8; ++i) { const int d = 2 + (i >> 2), ks = i & 3; loB[i] = vtr(vb + voffs[d][0] + ks * 4096); hhB[i] = vtr(vb + voffs[d][1] + ks * 4096); }
        __builtin_amdgcn_sched_barrier(0);
#pragma unroll
        for (int i = 0; i < 8; ++i) { const int d = (i >> 2), ks = i & 3;
            const bf16x8 vf = {loA[i][0], loA[i][1], loA[i][2], loA[i][3], hhA[i][0], hhA[i][1], hhA[i][2], hhA[i][3]};
            o[d] = __builtin_amdgcn_mfma_f32_32x32x16_bf16(vf, __builtin_bit_cast(bf16x8, pw[ks]), o[d], 0, 0, 0); }
#pragma unroll
        for (int i = 0; i < 8; ++i) { const int d = 2 + (i >> 2), ks = i & 3;
            const bf16x8 vf = {loB[i][0], loB[i][1], loB[i][2], loB[i][3], hhB[i][0], hhB[i][1], hhB[i][2], hhB[i][3]};
            o[d] = __builtin_amdgcn_mfma_f32_32x32x16_bf16(vf, __builtin_bit_cast(bf16x8, pw[ks]), o[d], 0, 0, 0); }
        if (t + 2 < NT) asm volatile("s_waitcnt vmcnt(4)" ::: "memory"); else asm volatile("s_waitcnt vmcnt(0)" ::: "memory");
        __syncthreads();
        slot2 = slot; slot = (slot == 2 * SLOT) ? 0 : slot + SLOT;
    }
#undef ATT_DMA
    const float inv = 1.0f / swapadd(lsum);
    LAS float* xch = (LAS float*)(lds + wq * 16384);
    if (m == 1) {
        const float sc = inv * lam;
#pragma unroll
        for (int d = 0; d < 4; ++d)
#pragma unroll
            for (int r = 0; r < 16; ++r) xch[(d * 16 + r) * 64 + lane] = o[d][r] * sc;
    }
    __syncthreads();
    if (m == 0) {
        float ss = 0.f;
#pragma unroll
        for (int d = 0; d < 4; ++d)
#pragma unroll
            for (int r = 0; r < 16; ++r) { const float v = o[d][r] * inv - xch[(d * 16 + r) * 64 + lane]; o[d][r] = v; ss += v * v; }
        ss = swapadd(ss);
        const float rn = rsqrtf(ss * (1.0f / 128.0f) + EPS) * 0.8f;
        bf16_t* yp = Y + (rowbase + qabs) * DM + 512 + h * 128;
#pragma unroll
        for (int d = 0; d < 4; ++d)
#pragma unroll
            for (int rq = 0; rq < 4; ++rq) { const int dc = 32 * d + 8 * rq + 4 * hi; const f32x4 g = *(const f32x4*)(subln + dc);
                u32x2 w; w.x = cvtpk(o[d][4 * rq] * rn * g[0], o[d][4 * rq + 1] * rn * g[1]); w.y = cvtpk(o[d][4 * rq + 2] * rn * g[2], o[d][4 * rq + 3] * rn * g[3]);
                *(u32x2*)(yp + dc) = w; }
    }
    __syncthreads();
}

__device__ __forceinline__ void attn_unit_pipe(int b, int h, int qb, const bf16_t* Z, bf16_t* Y, const float* subln, float lam, LAS unsigned char* lds) {
    int tid = threadIdx.x; asm volatile("" : "+v"(tid));
    const int lane = tid & 63, r32 = lane & 31, hi = lane >> 5; const int wid = __builtin_amdgcn_readfirstlane(tid >> 6);
    const int m = wid >> 2, wq = wid & 3;
    const size_t rowbase = (size_t)b * SEQ; const int q0 = qb * 128, NT = 2 * qb + 2;
    const int qabs = q0 + wq * 32 + r32;
    bf16x8 qr[4];
    { const bf16_t* Qw = Z + (rowbase + qabs) * ZLD + 512 + h * 128 + m * 64;
#pragma unroll
      for (int d0 = 0; d0 < 4; ++d0) qr[d0] = __builtin_nontemporal_load((const bf16x8*)(Qw + d0 * 16 + hi * 8)); }
    const bf16_t* Zbh = Z + rowbase * ZLD + h * 128;
    unsigned kog[2], vog[2];
#pragma unroll
    for (int j = 0; j < 2; ++j) { const unsigned r = 8u * wid + 4u * j + (lane >> 4), cp = lane & 15;
        kog[j] = r * ZLD + 1024u + 8u * (cp ^ (r & 15u)); vog[j] = r * ZLD + 1536u + 8u * (cp ^ (((r & 3u) << 2) | ((r >> 2) & 3u))); }
    const unsigned wbase = (unsigned)wid * 2048u;
    const unsigned lds0 = (unsigned)(uintptr_t)lds;
#define ATP_DMA(t) do { const bf16_t* zt_ = Zbh + (size_t)(t) * 64 * ZLD; const unsigned d_ = (unsigned)__builtin_amdgcn_readfirstlane(lds0 + ((t) & 3) * SLOT + wbase); \
        glds16(zt_ + kog[0], d_); glds16(zt_ + kog[1], d_ + 1024); glds16(zt_ + vog[0], d_ + 2 * KB); glds16(zt_ + vog[1], d_ + 2 * KB + 1024); } while (0)
    f32x16 o[4];
#pragma unroll
    for (int d = 0; d < 4; ++d)
#pragma unroll
        for (int r = 0; r < 16; ++r) o[d][r] = 0.f;
    float lsum = 0.f;
    const int kbase = r32 * 256 + (((m * 8 + hi) ^ (r32 & 15)) * 16);
    int vbase[2];
    { const int L2 = (lane >> 2) & 3, a = (lane >> 4) & 1, bb = (lane & 3) >> 1;
#pragma unroll
      for (int h2 = 0; h2 < 2; ++h2) vbase[h2] = 2 * KB + 256 * (8 * h2 + 4 * hi + L2) + 16 * ((L2 << 2) | (((2 * a + bb) ^ (2 * h2 + hi)) & 3)) + 8 * (lane & 1); }
#define ATP_PIN(x) asm volatile("" : "+v"(x))
#define ATP_SB() __builtin_amdgcn_sched_barrier(0)
#define ATP_MASK(C0, C1, t) do { if ((t) >= NT - 2) { const int kb0_ = 64 * (t) + 4 * hi; \
        _Pragma("unroll") for (int r = 0; r < 16; ++r) { const int kv = kb0_ + (r & 3) + 8 * (r >> 2); if (kv > qabs) C0[r] = -INFINITY; if (kv + 32 > qabs) C1[r] = -INFINITY; } } } while (0)
#define ATP_KLOAD(t) do { const LAS unsigned char* kb_ = lds + ((t) & 3) * SLOT; \
        _Pragma("unroll") for (int d0 = 0; d0 < 4; ++d0) { kf[2 * d0] = *(const LAS bf16x8*)(kb_ + (kbase ^ (32 * d0))); kf[2 * d0 + 1] = *(const LAS bf16x8*)(kb_ + (kbase ^ (32 * d0)) + 8192); } } while (0)
#define ATP_VLOAD(vf, vb, d) do { _Pragma("unroll") for (int ks = 0; ks < 4; ++ks) { const s16x4 lo_ = vtr((vb) + (vbase[0] ^ (64 * (d))) + ks * 4096), hh_ = vtr((vb) + (vbase[1] ^ (64 * (d))) + ks * 4096); \
        vf[ks] = (bf16x8){lo_[0], lo_[1], lo_[2], lo_[3], hh_[0], hh_[1], hh_[2], hh_[3]}; } } while (0)
#define ATP_WAIT(t) do { if ((t) + 2 < NT) asm volatile("s_waitcnt vmcnt(4)" ::: "memory"); else asm volatile("s_waitcnt vmcnt(0)" ::: "memory"); __syncthreads(); } while (0)
    bf16x8 kf[8], vfA[4], vfB[4]; u32x4 pw[4];
    f32x16 pA0, pA1, pB0, pB1;
    ATP_DMA(0); ATP_DMA(1);
    asm volatile("s_waitcnt vmcnt(4)" ::: "memory");
    __syncthreads();
    if (2 < NT) ATP_DMA(2);
    ATP_KLOAD(0); ATP_SB();
#pragma unroll
    for (int r = 0; r < 16; ++r) { pA0[r] = 0.f; pA1[r] = 0.f; }
#pragma unroll
    for (int d0 = 0; d0 < 4; ++d0) { pA0 = __builtin_amdgcn_mfma_f32_32x32x16_bf16(kf[2 * d0], qr[d0], pA0, 0, 0, 0); pA1 = __builtin_amdgcn_mfma_f32_32x32x16_bf16(kf[2 * d0 + 1], qr[d0], pA1, 0, 0, 0); }
    ATP_MASK(pA0, pA1, 0);
#pragma unroll
    for (int r = 0; r < 16; ++r) { pA0[r] = __builtin_amdgcn_exp2f(pA0[r]); pA1[r] = __builtin_amdgcn_exp2f(pA1[r]); }
    ATP_WAIT(0);
#define ATP_GAPA(i, C0, C1, P0, P1) do { \
        if ((i) & 1) { C1 = __builtin_amdgcn_mfma_f32_32x32x16_bf16(kf[i], qr[(i) >> 1], C1, 0, 0, 0); ATP_PIN(C1); } else { C0 = __builtin_amdgcn_mfma_f32_32x32x16_bf16(kf[i], qr[(i) >> 1], C0, 0, 0, 0); ATP_PIN(C0); } \
        if ((i) < 4) { sacc += (P0[4 * (i)] + P0[4 * (i) + 1]) + (P0[4 * (i) + 2] + P0[4 * (i) + 3]); pw[(i) >> 1][2 * ((i) & 1)] = cvtpk(P0[4 * (i)], P0[4 * (i) + 1]); pw[(i) >> 1][2 * ((i) & 1) + 1] = cvtpk(P0[4 * (i) + 2], P0[4 * (i) + 3]); } \
        else { sacc += (P1[4 * ((i) - 4)] + P1[4 * ((i) - 4) + 1]) + (P1[4 * ((i) - 4) + 2] + P1[4 * ((i) - 4) + 3]); pw[(i) >> 1][2 * ((i) & 1)] = cvtpk(P1[4 * ((i) - 4)], P1[4 * ((i) - 4) + 1]); pw[(i) >> 1][2 * ((i) & 1) + 1] = cvtpk(P1[4 * ((i) - 4) + 2], P1[4 * ((i) - 4) + 3]); } \
        ATP_PIN(sacc); ATP_PIN(pw[(i) >> 1]); ATP_SB(); } while (0)
#define ATP_GAPB(vf, d, ks, X, e0) do { o[d] = __builtin_amdgcn_mfma_f32_32x32x16_bf16(vf[ks], __builtin_bit_cast(bf16x8, pw[ks]), o[d], 0, 0, 0); \
        X[e0] = __builtin_amdgcn_exp2f(X[e0]); X[(e0) + 1] = __builtin_amdgcn_exp2f(X[(e0) + 1]); ATP_PIN(X); ATP_SB(); } while (0)
#define ATP_STEP(C0, C1, P0, P1, t) do { \
        if ((t) + 2 < NT) ATP_DMA((t) + 2); \
        ATP_KLOAD(t); ATP_SB(); \
        const LAS unsigned char* vb_ = lds + (((t) - 1) & 3) * SLOT; \
        _Pragma("unroll") for (int r = 0; r < 16; ++r) { C0[r] = 0.f; C1[r] = 0.f; } \
        float sacc = 0.f; \
        ATP_GAPA(0, C0, C1, P0, P1); ATP_GAPA(1, C0, C1, P0, P1); ATP_GAPA(2, C0, C1, P0, P1); ATP_GAPA(3, C0, C1, P0, P1); \
        ATP_GAPA(4, C0, C1, P0, P1); ATP_GAPA(5, C0, C1, P0, P1); ATP_GAPA(6, C0, C1, P0, P1); ATP_GAPA(7, C0, C1, P0, P1); \
        lsum += sacc; \
        ATP_VLOAD(vfA, vb_, 0); ATP_VLOAD(vfB, vb_, 1); ATP_SB(); \
        ATP_MASK(C0, C1, t); ATP_SB(); \
        ATP_GAPB(vfA, 0, 0, C0, 0); ATP_GAPB(vfA, 0, 1, C0, 2); ATP_GAPB(vfA, 0, 2, C0, 4); ATP_GAPB(vfA, 0, 3, C0, 6); \
        ATP_VLOAD(vfA, vb_, 2); ATP_SB(); \
        ATP_GAPB(vfB, 1, 0, C0, 8); ATP_GAPB(vfB, 1, 1, C0, 10); ATP_GAPB(vfB, 1, 2, C0, 12); ATP_GAPB(vfB, 1, 3, C0, 14); \
        ATP_VLOAD(vfB, vb_, 3); ATP_SB(); \
        ATP_GAPB(vfA, 2, 0, C1, 0); ATP_GAPB(vfA, 2, 1, C1, 2); ATP_GAPB(vfA, 2, 2, C1, 4); ATP_GAPB(vfA, 2, 3, C1, 6); \
        ATP_GAPB(vfB, 3, 0, C1, 8); ATP_GAPB(vfB, 3, 1, C1, 10); ATP_GAPB(vfB, 3, 2, C1, 12); ATP_GAPB(vfB, 3, 3, C1, 14); \
        ATP_WAIT(t); } while (0)
    int t = 1;
    for (; t + 1 < NT; t += 2) { ATP_STEP(pB0, pB1, pA0, pA1, t); ATP_STEP(pA0, pA1, pB0, pB1, t + 1); }
    ATP_STEP(pB0, pB1, pA0, pA1, t);
    { float sacc = 0.f;
#pragma unroll
      for (int r = 0; r < 16; ++r) sacc += pB0[r] + pB1[r];
      lsum += sacc;
      pw[0] = (u32x4){cvtpk(pB0[0], pB0[1]), cvtpk(pB0[2], pB0[3]), cvtpk(pB0[4], pB0[5]), cvtpk(pB0[6], pB0[7])};
      pw[1] = (u32x4){cvtpk(pB0[8], pB0[9]), cvtpk(pB0[10], pB0[11]), cvtpk(pB0[12], pB0[13]), cvtpk(pB0[14], pB0[15])};
      pw[2] = (u32x4){cvtpk(pB1[0], pB1[1]), cvtpk(pB1[2], pB1[3]), cvtpk(pB1[4], pB1[5]), cvtpk(pB1[6], pB1[7])};
      pw[3] = (u32x4){cvtpk(pB1[8], pB1[9]), cvtpk(pB1[10], pB1[11]), cvtpk(pB1[12], pB1[13]), cvtpk(pB1[14], pB1[15])};
      const LAS unsigned char* vb_ = lds + ((NT - 1) & 3) * SLOT;
#pragma unroll
      for (int d = 0; d < 4; ++d) { ATP_VLOAD(vfA, vb_, d);
#pragma unroll
          for (int ks = 0; ks < 4; ++ks) o[d] = __builtin_amdgcn_mfma_f32_32x32x16_bf16(vfA[ks], __builtin_bit_cast(bf16x8, pw[ks]), o[d], 0, 0, 0); } }
    __syncthreads();
#undef ATP_DMA
#undef ATP_PIN
#undef ATP_SB
#undef ATP_MASK
#undef ATP_KLOAD
#undef ATP_VLOAD
#undef ATP_WAIT
#undef ATP_GAPA
#undef ATP_GAPB
#undef ATP_STEP
    const float inv = 1.0f / swapadd(lsum);
    LAS float* xch = (LAS float*)(lds + wq * 16384);
    if (m == 1) {
        const float sc = inv * lam;
#pragma unroll
        for (int d = 0; d < 4; ++d)
#pragma unroll
            for (int r = 0; r < 16; ++r) xch[(d * 16 + r) * 64 + lane] = o[d][r] * sc;
    }
    __syncthreads();
    if (m == 0) {
        float ss = 0.f;
#pragma unroll
        for (int d = 0; d < 4; ++d)
#pragma unroll
            for (int r = 0; r < 16; ++r) { const float v = o[d][r] * inv - xch[(d * 16 + r) * 64 + lane]; o[d][r] = v; ss += v * v; }
        ss = swapadd(ss);
        const float rn = rsqrtf(ss * (1.0f / 128.0f) + EPS) * 0.8f;
        bf16_t* yp = Y + (rowbase + qabs) * DM + 512 + h * 128;
#pragma unroll
        for (int d = 0; d < 4; ++d)
#pragma unroll
            for (int rp = 0; rp < 2; ++rp) { u32x2 w[2];
#pragma unroll
                for (int e = 0; e < 2; ++e) { const int rq = 2 * rp + e, dc = 32 * d + 8 * rq + 4 * hi; const f32x4 g = *(const f32x4*)(subln + dc);
                    w[e].x = cvtpk(o[d][4 * rq] * rn * g[0], o[d][4 * rq + 1] * rn * g[1]); w[e].y = cvtpk(o[d][4 * rq + 2] * rn * g[2], o[d][4 * rq + 3] * rn * g[3]); }
                const auto sx = __builtin_amdgcn_permlane32_swap(w[0].x, w[1].x, false, false), sy = __builtin_amdgcn_permlane32_swap(w[0].y, w[1].y, false, false);
                *(u32x4*)(yp + 32 * d + 8 * (2 * rp + hi)) = (u32x4){sx[0], sy[0], sx[1], sy[1]}; }
    }
    __syncthreads();
}
}

__device__ __forceinline__ void phase_attn(const Ctx& C) {
    const Params& P = *C.p; unsigned char* ws = P.ws;
    const bf16_t* Z = (const bf16_t*)(ws + WS_Z); bf16_t* Y = (bf16_t*)(ws + WS_YCAT);
    const float d1 = wave_sum(P.in[I_LQ1][C.lane] * P.in[I_LK1][C.lane]), d2 = wave_sum(P.in[I_LQ2][C.lane] * P.in[I_LK2][C.lane]);
    const float lam = expf(d1) - expf(d2) + 0.2f;
    float gq = fabsf(P.in[I_QN][C.lane]), gk = fabsf(P.in[I_KN][C.lane]);
#pragma unroll
    for (int o = 1; o < 64; o <<= 1) { gq = fmaxf(gq, __shfl_xor(gq, o)); gk = fmaxf(gk, __shfl_xor(gk, o)); }
    const bool bounded = 8.0f * 1.4426950408889634f * gq * gk <= 40.0f;
#pragma unroll 1
    for (int rep = 0; rep <= PROBE_ATTN2; ++rep)
#pragma unroll 1
    for (int pi = C.vcu; pi < 512; pi += C.G) {
        const int bh = pi >> 5, s = pi & 31;
        if (bounded) {
#pragma unroll 1
            for (int u = 0; u < 2; ++u) att::attn_unit_pipe(bh >> 2, bh & 3, u ? s : 63 - s, Z, Y, P.in[I_SUBLN], lam, C.lds);
        } else {
#pragma unroll 1
            for (int u = 0; u < 2; ++u) att::attn_unit<false>(bh >> 2, bh & 3, u ? s : 63 - s, Z, Y, P.in[I_SUBLN], lam, C.lds);
        }
    }
}

__device__ __forceinline__ unsigned mono(float f) { const unsigned u = __float_as_uint(f); return (u & 0x80000000u) ? ~u : (u | 0x80000000u); }
__device__ __forceinline__ float unmono(unsigned u) { return __uint_as_float((u & 0x80000000u) ? (u & 0x7fffffffu) : ~u); }
__device__ __forceinline__ unsigned mono16hi(unsigned x) { const unsigned m = (unsigned)((int)x >> 31); return x ^ ((m & 0x7fff0000u) | 0x80000000u); }
__device__ __forceinline__ float unmono16hi(unsigned k) { const unsigned x = k & 0xffff0000u, m = (unsigned)((int)x >> 31);
    return (float)__builtin_bit_cast(_Float16, (unsigned short)((x ^ ((~m & 0x7fff0000u) | 0x80000000u)) >> 16)); }
template <class T> __device__ __forceinline__ void sort16_desc(T (&a)[16]) {
#define CE(i, j) { const T mx = a[i] > a[j] ? a[i] : a[j], mn = a[i] > a[j] ? a[j] : a[i]; a[i] = mx; a[j] = mn; }
    CE(0, 13) CE(1, 12) CE(2, 15) CE(3, 14) CE(4, 8) CE(5, 6) CE(7, 11) CE(9, 10)
    CE(0, 5) CE(1, 7) CE(2, 9) CE(3, 4) CE(6, 13) CE(8, 14) CE(10, 15) CE(11, 12)
    CE(0, 1) CE(2, 3) CE(4, 5) CE(6, 8) CE(7, 9) CE(10, 11) CE(12, 13) CE(14, 15)
    CE(0, 2) CE(1, 3) CE(4, 10) CE(5, 11) CE(6, 7) CE(8, 9) CE(12, 14) CE(13, 15)
    CE(1, 2) CE(3, 12) CE(4, 6) CE(5, 7) CE(8, 10) CE(9, 11) CE(13, 14)
    CE(1, 4) CE(2, 6) CE(5, 8) CE(7, 10) CE(9, 13) CE(11, 14)
    CE(2, 4) CE(3, 6) CE(9, 12) CE(11, 13)
    CE(3, 5) CE(6, 8) CE(7, 9) CE(10, 12)
    CE(3, 4) CE(5, 6) CE(7, 8) CE(9, 10) CE(11, 12)
    CE(6, 7) CE(8, 9)
#undef CE
}
template <class T> __device__ __forceinline__ void merge16_desc(T (&a)[16], const T (&b)[16]) {
#pragma unroll
    for (int i = 0; i < 16; ++i) a[i] = a[i] > b[15 - i] ? a[i] : b[15 - i];
#pragma unroll
    for (int j = 8; j > 0; j >>= 1)
#pragma unroll
        for (int i = 0; i < 16; ++i) { const int l = i ^ j; if (l > i) { const T mx = a[i] > a[l] ? a[i] : a[l], mn = a[i] > a[l] ? a[l] : a[i]; a[i] = mx; a[l] = mn; } }
}
__device__ __forceinline__ void top16_of_128(const _Float16* sc, unsigned (&a)[16]) {
    f16x8 n0 = *(const f16x8*)sc, n1 = *(const f16x8*)(sc + 8);
#pragma unroll 1
    for (int g = 0; g < 8; ++g) {
        const f16x8 h0 = n0, h1 = n1;
        { const int gn = g < 7 ? g + 1 : 7; n0 = *(const f16x8*)(sc + 16 * gn); n1 = *(const f16x8*)(sc + 16 * gn + 8); }
        unsigned b[16];
        { const u32x4 w0 = __builtin_bit_cast(u32x4, h0), w1 = __builtin_bit_cast(u32x4, h1);
#pragma unroll
          for (int p2 = 0; p2 < 4; ++p2) {
              b[2 * p2] = mono16hi(w0[p2] << 16) | (unsigned)(127 - (16 * g + 2 * p2)); b[2 * p2 + 1] = mono16hi(w0[p2] & 0xffff0000u) | (unsigned)(127 - (16 * g + 2 * p2 + 1));
              b[8 + 2 * p2] = mono16hi(w1[p2] << 16) | (unsigned)(127 - (16 * g + 8 + 2 * p2)); b[8 + 2 * p2 + 1] = mono16hi(w1[p2] & 0xffff0000u) | (unsigned)(127 - (16 * g + 8 + 2 * p2 + 1)); } }
        sort16_desc(b);
        if (g == 0) {
#pragma unroll
            for (int i = 0; i < 16; ++i) a[i] = b[i];
        } else merge16_desc(a, b);
    }
}
typedef unsigned long long u64;
__device__ __forceinline__ void phase_topk(const Ctx& C) {
    const Params& P = *C.p; unsigned char* ws = P.ws;
    const _Float16* SC = (const _Float16*)(ws + WS_Z); int* EI = (int*)(ws + WS_EIDX); float* GT = (float*)(ws + WS_GATE);
    const int gt = C.vcu * 512 + C.tid, NT = C.G * 512;
    for (int it = gt; it < M_TOK * 8; it += NT) {
        const _Float16* sc = SC + (size_t)it * 256;
        unsigned a0[16], a1[16];
        top16_of_128(sc, a0); top16_of_128(sc + 128, a1);
        float v0[16], v1[16]; unsigned e0[16], e1[16];
#pragma unroll
        for (int i = 0; i < 16; ++i) { v0[i] = unmono16hi(a0[i]); v1[i] = unmono16hi(a1[i]); e0[i] = (127u - (a0[i] & 127u)) << 7; e1[i] = 127u - (a1[i] & 127u); }
#define CAND(i, j) ((((u64)mono(v0[i] + v1[j])) << 32) | (u64)(((255u - (unsigned)((i) * 16 + (j))) << 16) | e0[i] | e1[j]))
        u64 a[16], bq[16];
#pragma unroll
        for (int j = 0; j < 16; ++j) a[j] = CAND(0, j);
#pragma unroll
        for (int i = 0; i < 15; ++i) bq[i] = CAND(i + 1, 0);
        bq[15] = 0ull; merge16_desc(a, bq);
#pragma unroll
        for (int i = 0; i < 16; ++i) bq[i] = 0ull;
#pragma unroll
        for (int j = 1; j < 8; ++j) bq[j - 1] = CAND(1, j);
        merge16_desc(a, bq);
#pragma unroll
        for (int i = 0; i < 16; ++i) bq[i] = 0ull;
#pragma unroll
        for (int i = 2; i < 8; ++i) bq[i - 2] = CAND(i, 1);
        merge16_desc(a, bq);
#pragma unroll
        for (int i = 0; i < 16; ++i) bq[i] = 0ull;
        bq[0] = CAND(2, 2); bq[1] = CAND(2, 3); bq[2] = CAND(2, 4); bq[3] = CAND(3, 2); bq[4] = CAND(4, 2); bq[5] = CAND(3, 3);
        sort16_desc(bq); merge16_desc(a, bq);
#undef CAND
        float sv[16]; const float smax = unmono((unsigned)(a[0] >> 32)); float den = 0.f;
#pragma unroll
        for (int i = 0; i < 16; ++i) { sv[i] = __expf(unmono((unsigned)(a[i] >> 32)) - smax); den += sv[i]; }
        const float rd = 1.0f / den;
        int* eo = EI + (size_t)it * 16;
#define PKEG(i) (((unsigned)a[i] & 0x3fffu) | ((unsigned)__builtin_bit_cast(unsigned short, (_Float16)(sv[i] * rd)) << 16))
#pragma unroll
        for (int q = 0; q < 4; ++q) *(u32x4*)(eo + 4 * q) = (u32x4){PKEG(4 * q), PKEG(4 * q + 1), PKEG(4 * q + 2), PKEG(4 * q + 3)};
#undef PKEG
    }
}

constexpr int GT_T = 8;
typedef _Float16 h16x2 __attribute__((ext_vector_type(2)));
typedef int v4i_t __attribute__((ext_vector_type(4)));
typedef int v8i_t __attribute__((ext_vector_type(8)));
__device__ __forceinline__ float gelu_erf(float a) {
    const float x = a * 0.70710678118654752f, ax = fabsf(x);
    const float t = __builtin_amdgcn_rcpf(fmaf(0.3275911f, ax, 1.0f));
    const float pl = t * fmaf(t, fmaf(t, fmaf(t, fmaf(t, 1.061405429f, -1.453152027f), 1.421413741f), -0.284496736f), 0.254829592f);
    const float er = fmaf(-pl, __builtin_amdgcn_exp2f(-1.4426950408889634f * x * x), 1.0f);
    return 0.5f * a * (1.0f + copysignf(er, x));
}
__device__ __forceinline__ f32x4 mx46(const v4i_t a, const unsigned (&b)[6], const f32x4 c) {
    const v8i_t A = {a[0], a[1], a[2], a[3], 0, 0, 0, 0}, B = {(int)b[0], (int)b[1], (int)b[2], (int)b[3], (int)b[4], (int)b[5], 0, 0};
    return __builtin_amdgcn_mfma_scale_f32_16x16x128_f8f6f4(A, B, c, 4, 2, 0, 0x7f7f7f7f, 0, 0x7f7f7f7f);
}
__device__ __forceinline__ unsigned pkmax16(unsigned a, unsigned b) { typedef unsigned short us2 __attribute__((ext_vector_type(2))); return __builtin_bit_cast(unsigned, __builtin_elementwise_max(__builtin_bit_cast(us2, a), __builtin_bit_cast(us2, b))); }
__device__ __forceinline__ void phase_gather(const Ctx& C, bool dry = false) {
    const Params& P = *C.p; unsigned char* ws = P.ws; const int lane = C.lane;
    bf16_t* HB = (bf16_t*)(ws + WS_ACTB); const float* rowss = (const float*)(ws + WS_CTL + WS_ROWSS2); float* rinv3 = (float*)(ws + WS_RINV3);
    bf16_t* HBW = dry ? (bf16_t*)(ws + WS_YCAT) : HB; float* R3W = dry ? (float*)(ws + WS_WIN) : rinv3;
    const auto rsT = __builtin_amdgcn_make_buffer_rsrc((void*)(ws + WS_UT), 0, 16 << 20, 0x00020000);
    const int* EI = (const int*)(ws + WS_EIDX); const float* GT = (const float*)(ws + WS_GATE);
    constexpr int WLDS = 9216;
    LAS u32x2* sl = (LAS u32x2*)(C.lds + C.wave * WLDS);
    LAS float* gl = (LAS float*)(C.lds + C.wave * WLDS + 1024);
    LAS int* el = (LAS int*)(C.lds + C.wave * WLDS + 5120);
    const unsigned lane16 = 16u * (unsigned)lane;
    const int mi = lane & 15, mg = lane >> 4;
    const bool xsel = mi < 8 && mg == (mi >> 1), nodd = lane & 1;
    for (int tok0 = (C.vcu * 8 + C.wave) * GT_T; tok0 < M_TOK; tok0 += C.G * 8 * GT_T) {
        h16x2 op[GT_T][8];
        const int xtok = tok0 + (lane & 7); const bf16_t* hp = HB + (size_t)xtok * DM + 32 * mg + 512 * (mi >> 3);
        u32x4 hrow[16];
#pragma unroll
        for (int i = 0; i < 16; ++i) hrow[i] = *(const u32x4*)(hp + 128 * (i >> 2) + 8 * (i & 3));
        const float xrs = rowss[xtok];
        int e0a[GT_T], e1a[GT_T]; float g0a[GT_T], g1a[GT_T];
#pragma unroll
        for (int j = 0; j < GT_T; ++j) { const size_t o_ = (size_t)(tok0 + j) * 128 + lane; const unsigned w0_ = (unsigned)__builtin_nontemporal_load(EI + o_), w1_ = (unsigned)__builtin_nontemporal_load(EI + o_ + 64); e0a[j] = (int)(w0_ & 0xffffu); e1a[j] = (int)(w1_ & 0xffffu);
            g0a[j] = (float)__builtin_bit_cast(_Float16, (unsigned short)(w0_ >> 16)); g1a[j] = (float)__builtin_bit_cast(_Float16, (unsigned short)(w1_ >> 16)); }
        __builtin_amdgcn_sched_barrier(0);
#pragma unroll
        for (int j = 0; j < GT_T; ++j) {
            const int e0 = e0a[j], e1 = e1a[j]; const float g0 = g0a[j], g1 = g1a[j];
            u32x2 a = {(unsigned)e0, __float_as_uint(g0)}, b = {(unsigned)e1, __float_as_uint(g1)};
#pragma unroll
            for (int pass = 0; pass < 2; ++pass) {
                const int d0 = (int)(a.x >> (10 + 2 * pass)) & 3, d1 = (int)(b.x >> (10 + 2 * pass)) & 3;
                int pos0 = 0, pos1 = 0, base = 0;
#pragma unroll
                for (int dg = 0; dg < 4; ++dg) {
                    const bool q0 = d0 == dg, q1 = d1 == dg;
                    const unsigned long long m0 = __ballot(q0), m1 = __ballot(q1);
                    const int c0 = __builtin_popcountll(m0), c1 = __builtin_popcountll(m1);
                    const int r0 = __builtin_amdgcn_mbcnt_hi((unsigned)(m0 >> 32), __builtin_amdgcn_mbcnt_lo((unsigned)m0, 0u));
                    const int r1 = __builtin_amdgcn_mbcnt_hi((unsigned)(m1 >> 32), __builtin_amdgcn_mbcnt_lo((unsigned)m1, 0u));
                    { const int cand0 = base + r0, cand1 = base + c0 + r1;
                      asm("v_cndmask_b32_e64 %0, %0, %1, %2" : "+v"(pos0) : "v"(cand0), "s"(m0)); asm("v_cndmask_b32_e64 %0, %0, %1, %2" : "+v"(pos1) : "v"(cand1), "s"(m1)); }
                    base += c0 + c1;
                }
                sl[pos0] = a; sl[pos1] = b;
                a = sl[lane]; b = sl[64 + lane];
            }
            gl[j * 128 + lane] = __uint_as_float(a.y); gl[j * 128 + 64 + lane] = __uint_as_float(b.y);
            el[j * 128 + lane] = (int)a.x; el[j * 128 + 64 + lane] = (int)b.x;
        }
        unsigned xb[8][6]; float ascl;
        {
            unsigned mx = 0u;
#pragma unroll
            for (int i = 0; i < 16; ++i) { const u32x4 hw = hrow[i];
                mx = pkmax16(mx, pkmax16(pkmax16(hw.x & 0x7fff7fffu, hw.y & 0x7fff7fffu), pkmax16(hw.z & 0x7fff7fffu, hw.w & 0x7fff7fffu))); }
            float am = __uint_as_float(((mx & 0xffffu) > (mx >> 16) ? (mx & 0xffffu) : (mx >> 16)) << 16);
            am = fmaxf(am, __shfl_xor(am, 8)); am = fmaxf(am, __shfl_xor(am, 16)); am = fmaxf(am, __shfl_xor(am, 32)); am = fmaxf(am, 1e-30f);
            const unsigned tb = __float_as_uint(am * (1.0f / 7.5f)); const float scl = __uint_as_float(((tb >> 23) + ((tb & 0x7fffffu) ? 1u : 0u)) << 23);
            ascl = scl * rsqrtf(xrs * (1.0f / 1024.0f) + EPS) * (1.0f / U4SCALE);
            typedef __bf16 v32bf_t __attribute__((ext_vector_type(32))); typedef unsigned v16u_t __attribute__((ext_vector_type(16))); typedef unsigned v6u_t __attribute__((ext_vector_type(6)));
#pragma unroll
            for (int st = 0; st < 4; ++st) {
                const v16u_t src = {hrow[4 * st].x, hrow[4 * st].y, hrow[4 * st].z, hrow[4 * st].w, hrow[4 * st + 1].x, hrow[4 * st + 1].y, hrow[4 * st + 1].z, hrow[4 * st + 1].w,
                                    hrow[4 * st + 2].x, hrow[4 * st + 2].y, hrow[4 * st + 2].z, hrow[4 * st + 2].w, hrow[4 * st + 3].x, hrow[4 * st + 3].y, hrow[4 * st + 3].z, hrow[4 * st + 3].w};
                const v6u_t q = __builtin_amdgcn_cvt_scalef32_pk32_fp6_bf16(__builtin_bit_cast(v32bf_t, src), XSCALE_ARG);
#pragma unroll
                for (int i = 0; i < 6; ++i) { xb[st][i] = q[i];
                    xb[4 + st][i] = (unsigned)__builtin_amdgcn_mov_dpp((int)q[i], 0x128, 0xf, 0xf, true); }
            }
        }
#pragma unroll
        for (int j = 0; j < GT_T; ++j)
#pragma unroll
            for (int i = 0; i < 8; ++i) op[j][i] = (h16x2){(_Float16)0.f, (_Float16)0.f};
        {
            const int ro = (mi >> 1) * 128 + (mi & 1);
            const LAS int* elp = el + ro; const LAS float* glw = gl + (lane & 7) * 128;
            LAS unsigned char* ul = C.lds + 8 * WLDS + C.wave * 8192;
            const unsigned ul0 = (unsigned)(uintptr_t)ul;
            const int hi5 = lane >> 5, p5 = lane & 31;
            const unsigned so_even = (unsigned)((p5 ^ (hi5 << 2)) * 16), so_odd = (unsigned)((p5 ^ ((2 + hi5) << 2)) * 16);
            const LAS unsigned char* bx[4];
#pragma unroll
            for (int j = 0; j < 4; ++j) bx[j] = ul + mi * 512 + mg * 16 + ((j ^ (mi & 3)) * 64);
            const unsigned char* tbl = ws + WS_UT;
            u32x4 srd; { const unsigned long long ta = (unsigned long long)(uintptr_t)tbl;
                srd.x = (unsigned)__builtin_amdgcn_readfirstlane((int)(unsigned)ta); srd.y = (unsigned)__builtin_amdgcn_readfirstlane((int)(unsigned)(ta >> 32)); srd.z = 16u << 20; srd.w = 0x00020000u; }
            const unsigned voffV = (lane16 >> 1) + 512u;
#define GD_EQ(kk) { const LAS int* eq_ = el + hi5 + 2 * (kk); _Pragma("unroll") for (int q = 0; q < 8; ++q) eqv[q] = (unsigned)eq_[q * 128]; }
#define GD_DMA() { _Pragma("unroll") for (int q = 0; q < 8; ++q) \
                att::glds16_sc(tbl + ((size_t)eqv[q] << 10) + ((q & 1) ? so_odd : so_even), (unsigned)__builtin_amdgcn_readfirstlane((int)(ul0 + q * 1024))); }
            unsigned eqv[8];
#define GD_VLD(r) { const int so_ = __builtin_amdgcn_readlane(ev, r) << 10; asm volatile("buffer_load_dwordx2 %0, %1, %2, %3 offen sc0 sc1" : "=v"(w[r]) : "v"(voffV), "s"(srd), "s"(so_) : "memory"); }
#define GD_ROW(r, N) { const int j = (r) >> 1; const h16x2 sc = __builtin_bit_cast(h16x2, scs[r]); asm volatile("s_waitcnt vmcnt(" #N ")" : "+v"(w[r]) :: "memory"); u32x2 ww = w[r]; \
                _Pragma("unroll") for (int c = 0; c < 2; ++c) { \
                    op[j][4 * c + 0] = __builtin_elementwise_fma(sc, __builtin_bit_cast(h16x2, __builtin_amdgcn_cvt_scalef32_pk_f16_fp4(ww[c], 1.0f, 0)), op[j][4 * c + 0]); \
                    op[j][4 * c + 1] = __builtin_elementwise_fma(sc, __builtin_bit_cast(h16x2, __builtin_amdgcn_cvt_scalef32_pk_f16_fp4(ww[c], 1.0f, 1)), op[j][4 * c + 1]); \
                    op[j][4 * c + 2] = __builtin_elementwise_fma(sc, __builtin_bit_cast(h16x2, __builtin_amdgcn_cvt_scalef32_pk_f16_fp4(ww[c], 1.0f, 2)), op[j][4 * c + 2]); \
                    op[j][4 * c + 3] = __builtin_elementwise_fma(sc, __builtin_bit_cast(h16x2, __builtin_amdgcn_cvt_scalef32_pk_f16_fp4(ww[c], 1.0f, 3)), op[j][4 * c + 3]); } \
                asm volatile("" : "+v"(op[j][0]), "+v"(op[j][1]), "+v"(op[j][2]), "+v"(op[j][3]), "+v"(op[j][4]), "+v"(op[j][5]), "+v"(op[j][6]), "+v"(op[j][7])); }
            int ev = elp[0];
            GD_EQ(0) GD_DMA()
#pragma unroll 1
            for (int k = 0; k < 64; ++k) {
                u32x2 w[16];
                GD_VLD(0) GD_VLD(1) GD_VLD(2) GD_VLD(3) GD_VLD(4) GD_VLD(5) GD_VLD(6) GD_VLD(7) GD_VLD(8) GD_VLD(9) GD_VLD(10) GD_VLD(11) GD_VLD(12) GD_VLD(13) GD_VLD(14) GD_VLD(15)
                asm volatile("s_waitcnt vmcnt(16)" ::: "memory");
                v4i_t a[8];
#pragma unroll
                for (int st = 0; st < 8; ++st) a[st] = *(const LAS v4i_t*)(bx[st & 3] + (st >> 2) * 256);
                GD_EQ((k < 63 ? k + 1 : 63))
                asm volatile("s_waitcnt lgkmcnt(0)" ::: "memory");
                __builtin_amdgcn_sched_barrier(0);
                GD_DMA()
                __builtin_amdgcn_sched_barrier(0);
                f32x4 c1 = {0.f, 0.f, 0.f, 0.f}, c2 = {0.f, 0.f, 0.f, 0.f};
#pragma unroll
                for (int st = 0; st < 8; st += 2) { c1 = mx46(a[st], xb[st], c1); c2 = mx46(a[st + 1], xb[st + 1], c2); }
                const float v0 = nodd ? c1[2] + c2[2] : c1[0] + c2[0], v1 = nodd ? c1[3] + c2[3] : c1[1] + c2[1];
                const f32x2 gt2 = *(const LAS f32x2*)(glw + 2 * k);
                const int evn = elp[k < 63 ? 2 * k + 2 : 126];
                __builtin_amdgcn_sched_barrier(0);
                const float h0 = gelu_erf(v0 * ascl) * gt2[0] * (1.0f / V4SCALE), h1 = gelu_erf(v1 * ascl) * gt2[1] * (1.0f / V4SCALE);
                const h16x2 hh0 = {(_Float16)h0, (_Float16)h0}, hh1 = {(_Float16)h1, (_Float16)h1}; const unsigned hr0 = __builtin_bit_cast(unsigned, hh0), hr1 = __builtin_bit_cast(unsigned, hh1);
                __builtin_amdgcn_sched_barrier(0);
                unsigned scs[16];
#pragma unroll
                for (int r = 0; r < 16; ++r) scs[r] = (unsigned)__builtin_amdgcn_readlane((int)((r & 1) ? hr1 : hr0), (r >> 1) + 16 * (r >> 2));
                GD_ROW(0, 23) GD_ROW(1, 22) GD_ROW(2, 21) GD_ROW(3, 20) GD_ROW(4, 19) GD_ROW(5, 18) GD_ROW(6, 17) GD_ROW(7, 16)
                GD_ROW(8, 15) GD_ROW(9, 14) GD_ROW(10, 13) GD_ROW(11, 12) GD_ROW(12, 11) GD_ROW(13, 10) GD_ROW(14, 9) GD_ROW(15, 8)
                __builtin_amdgcn_sched_barrier(0);
                ev = evn;
            }
            asm volatile("s_waitcnt vmcnt(0)" ::: "memory");
#undef GD_DMA
#undef GD_EQ
#undef GD_VLD
#undef GD_ROW
        }
#pragma unroll
        for (int j = 0; j < GT_T; ++j) {
            const int tok = tok0 + j; const bf16_t* hp0 = HB + (size_t)tok * DM + 16 * lane; f32x4 hv[4]; float ss = 0.f;
            const u32x4 hw0 = __builtin_nontemporal_load((const u32x4*)hp0), hw1 = __builtin_nontemporal_load((const u32x4*)(hp0 + 8));
            hv[0] = (f32x4){bflo(hw0.x), bfhi(hw0.x), bflo(hw0.y), bfhi(hw0.y)}; hv[1] = (f32x4){bflo(hw0.z), bfhi(hw0.z), bflo(hw0.w), bfhi(hw0.w)};
            hv[2] = (f32x4){bflo(hw1.x), bfhi(hw1.x), bflo(hw1.y), bfhi(hw1.y)}; hv[3] = (f32x4){bflo(hw1.z), bfhi(hw1.z), bflo(hw1.w), bfhi(hw1.w)};
#pragma unroll
            for (int i = 0; i < 4; ++i) { hv[i] = hv[i] + (f32x4){(float)op[j][2 * i].x, (float)op[j][2 * i].y, (float)op[j][2 * i + 1].x, (float)op[j][2 * i + 1].y};
                ss += (hv[i][0] * hv[i][0] + hv[i][1] * hv[i][1]) + (hv[i][2] * hv[i][2] + hv[i][3] * hv[i][3]); }
            ss = wave_sum(ss);
            bf16_t* bp = HBW + (size_t)tok * DM + 16 * lane;
            *(u32x4*)bp = (u32x4){cvtpk(hv[0][0], hv[0][1]), cvtpk(hv[0][2], hv[0][3]), cvtpk(hv[1][0], hv[1][1]), cvtpk(hv[1][2], hv[1][3])};
            *(u32x4*)(bp + 8) = (u32x4){cvtpk(hv[2][0], hv[2][1]), cvtpk(hv[2][2], hv[2][3]), cvtpk(hv[3][0], hv[3][1]), cvtpk(hv[3][2], hv[3][3])};
            if (lane == 0) R3W[tok] = rsqrtf(ss * (1.0f / 1024.0f) + EPS);
        }
    }
}

constexpr int N_PHASES = 9;
__global__ void __launch_bounds__(512, 2) mk_fwd(Params prm) {
    extern __shared__ __attribute__((aligned(16))) unsigned char lds_raw[];
    Ctx C; C.lds = (LAS unsigned char*)lds_raw; C.tid = threadIdx.x; C.lane = C.tid & 63; C.wave = __builtin_amdgcn_readfirstlane(C.tid >> 6);
    C.G = gridDim.x; { const int bx = blockIdx.x; C.vcu = (C.G % 8 == 0) ? (bx % 8) * (C.G / 8) + bx / 8 : bx; }
    C.p = &prm;
    unsigned char* ws = prm.ws;
    const int lo = prm.ph_lo, hi = prm.ph_hi;
#define IN(k) (lo <= (k) && (k) < hi)
    { volatile LAS unsigned* st = (volatile LAS unsigned*)(C.lds + LDS_BYTES - 64); if (C.tid < 2) st[C.tid] = 0u; __syncthreads(); }
    XcdBarrier xbar = xcd_barrier_post((unsigned*)(ws + WS_CTL) + 4096, (volatile LAS unsigned*)(C.lds + LDS_BYTES - 64));
#define SEAM(k) do { if (IN(k) && IN((k) + 1)) { xcd_barrier(xbar); } } while (0)
#if MK_COOP_SYNC0
    if (hi > N_PHASES) cg::this_grid().sync();
#endif
    bf16_t* ACTB = (bf16_t*)(ws + WS_ACTB); bf16_t* Z = (bf16_t*)(ws + WS_Z); bf16_t* YC = (bf16_t*)(ws + WS_YCAT); bf16_t* PPB = (bf16_t*)(ws + WS_PP);
    float* rowss2 = (float*)(ws + WS_CTL + WS_ROWSS2);
    if (IN(0)) { _Pragma("unroll 1") for (int rep = 0; rep <= PROBE_PREP; ++rep) { phase_prep(C); __syncthreads(); } }
    SEAM(0);
    if (IN(1)) for (int rep1 = 0; rep1 <= PROBE_G1; ++rep1) {
        { pg8::Gemm g{ACTB, (const bf16_t*)(ws + WS_WIN), M_TOK, 2048, 1024}; pg8::StaticOrder S; S.init(M_TOK, 2048, C.G, (int)blockIdx.x); pg8::EpiZ E{Z, ZLD, prm.in[I_QN], prm.in[I_KN], (const unsigned*)(ws + WS_CST)};
          pg8::gemm_phase<pg8::EpiZ, pg8::StaticOrder, true, true>(C.lds, g, S, E); }
        { pg8::Gemm g{(const bf16_t*)(ws + WS_PB), (const bf16_t*)(ws + WS_WP), M_TOK, 1024, 256}; pg8::StaticOrder S; S.init(M_TOK, 1024, C.G, (int)blockIdx.x); pg8::EpiStoreBf16 E{PPB, DM};
          pg8::gemm_phase<pg8::EpiStoreBf16, pg8::StaticOrder, true, true>(C.lds, g, S, E); }
    }
    SEAM(1);
    if (IN(2)) phase_rope_pool(C);
    for (int rep = 0; rep < PROBE_SYNC; ++rep) xcd_barrier(xbar);
    if (IN(3)) {
        if ((threadIdx.x >> 8) & 1) __builtin_amdgcn_s_setprio(1);
        _Pragma("unroll 1") for (int rep = 0; rep <= PROBE_ATTN; ++rep) phase_attn(C);
        __builtin_amdgcn_s_setprio(0);
    }
    SEAM(3);
    if (IN(4)) { pg8::Gemm g{YC, (const bf16_t*)(ws + WS_WO), M_TOK, 1024, 1024}; pg8::StaticOrder S; S.init(M_TOK, 1024, C.G, (int)blockIdx.x); pg8::EpiWo E{(const float*)(ws + WS_RINV3 + 512 * 1024), ACTB, rowss2};
        pg8::gemm_phase<pg8::EpiWo, pg8::StaticOrder, true, true>(C.lds, g, S, E); }
    SEAM(4);
    if (IN(5)) for (int rep5 = 0; rep5 <= PROBE_G5; ++rep5) { pg8::Gemm g{ACTB, (const bf16_t*)(ws + WS_WS), M_TOK, 2048, 1024}; pg8::StaticOrder S; S.init(M_TOK, 2048, C.G, (int)blockIdx.x); pg8::EpiScores E{(_Float16*)(ws + WS_Z), ZLD, rowss2};
        pg8::gemm_phase<pg8::EpiScores, pg8::StaticOrder, true, true>(C.lds, g, S, E); }
    SEAM(5);
    if (IN(6)) { _Pragma("unroll 1") for (int rep = 0; rep <= PROBE_TOPK; ++rep) phase_topk(C); }
    if (IN(6) && IN(7)) { asm volatile("s_waitcnt vmcnt(0)" ::: "memory"); __syncthreads(); } else { SEAM(6); }
    if (IN(7)) { _Pragma("unroll 1") for (int rep = 0; rep < PROBE_GATHER; ++rep) phase_gather(C, true); phase_gather(C); }
    SEAM(7);
    if (IN(8)) { pg8::Gemm g{ACTB, (const bf16_t*)(ws + WS_WG), M_TOK, 1024, 1024}; pg8::StaticOrder S; S.init(M_TOK, 1024, C.G, (int)blockIdx.x); pg8::EpiGate E{prm.out, ACTB, PPB, (const float*)(ws + WS_RINV3)};
        pg8::gemm_phase<pg8::EpiGate, pg8::StaticOrder, true, true>(C.lds, g, S, E); }
#undef IN
#undef SEAM
}

extern "C" void kernel_launch(void* const* d_in, const int* in_sizes, int n_in, void* d_out, int out_size, void* d_ws, size_t ws_size, hipStream_t stream) {
    static int grid = 0;
    if (grid == 0) {
        if (n_in != 23 || in_sizes[0] != M_TOK * DM || out_size != M_TOK * DM || ws_size < WS_END) { fprintf(stderr, "kernel_launch: unexpected shapes (n_in %d in0 %d out %d ws %zu)\n", n_in, n_in > 0 ? in_sizes[0] : -1, out_size, ws_size); grid = -1; return; }
        int dev = 0, cus = 0, per_cu = 0;
        hipGetDevice(&dev); hipDeviceGetAttribute(&cus, hipDeviceAttributeMultiprocessorCount, dev);
        hipFuncSetAttribute((const void*)mk_fwd, hipFuncAttributeMaxDynamicSharedMemorySize, LDS_BYTES);
        hipOccupancyMaxActiveBlocksPerMultiprocessor(&per_cu, (const void*)mk_fwd, 512, LDS_BYTES);
        if (per_cu < 1) { fprintf(stderr, "kernel_launch: occupancy query says %d blocks per CU\n", per_cu); per_cu = 1; }
        (void)hipGetLastError();
        grid = cus;
    }
    if (grid < 0) return;
    hipMemsetAsync((char*)d_ws + WS_CTL, 0, CTL_BYTES, stream);
    Params prm{};
    for (int i = 0; i < 23; ++i) prm.in[i] = (const float*)d_in[i];
    prm.out = (float*)d_out; prm.ws = (unsigned char*)d_ws;
#if MK_MULTI
    for (int ph = 0; ph < N_PHASES; ++ph) { prm.ph_lo = ph; prm.ph_hi = ph + 1; hipLaunchKernelGGL(mk_fwd, dim3(grid), dim3(512), LDS_BYTES, stream, prm); }
#else
    prm.ph_lo = 0; prm.ph_hi = N_PHASES;
#if MK_COOP_SYNC0
    void* args[] = {&prm};
    hipError_t e = hipLaunchCooperativeKernel((const void*)mk_fwd, dim3(grid), dim3(512), args, LDS_BYTES, stream);
    if (e != hipSuccess) fprintf(stderr, "cooperative launch failed: %s (grid %d)\n", hipGetErrorString(e), grid);
#else
    hipLaunchKernelGGL(mk_fwd, dim3(grid), dim3(512), LDS_BYTES, stream, prm);
#endif
#endif
}
```
